# Optimizing an MI355X kernel written in HIP

```python
import jax, jax.numpy as jnp
from jax import lax
import numpy as np

D_MODEL = 1024
BATCH = 2
SEQ = 16384
DEPTH = 2

N_A = (DEPTH + 1) // 2
N_B = DEPTH // 2

HEAD_DIM = 64
A_GROUPS = 3
A_HEADS_PER_GROUP = 5
A_HEADS = A_GROUPS * A_HEADS_PER_GROUP
A_WIDTH = A_HEADS * HEAD_DIM
DILATED_PATTERNS = ((128, 1), (512, 4), (2048, 16))
QUERY_BLOCK = 128
ROT_DIM = HEAD_DIM // 4
ROPE_THETA = 500000.0
NEG_INF = -1e30

CHUNK = 128
GMLP_HALF = 2 * D_MODEL
GMLP_GROUPS = 8

N_EXPERT_GROUPS = 4
EXPERTS_PER_GROUP = 4
N_EXPERTS = N_EXPERT_GROUPS * EXPERTS_PER_GROUP
TOP_K_INNER = 2
D_EXPERT = 256

EPS = 1e-6

kernel_name = "hybrid_dilated_attn_gmlp_hmoe_encoder"


def rms_norm(x, g):
    xf = x.astype(jnp.float32)
    y = xf * lax.rsqrt(jnp.mean(xf * xf, axis=-1, keepdims=True) + EPS)
    return (y * g.astype(jnp.float32)).astype(x.dtype)


def layer_norm(x, g):
    xf = x.astype(jnp.float32)
    mu = jnp.mean(xf, axis=-1, keepdims=True)
    xc = xf - mu
    y = xc * lax.rsqrt(jnp.mean(xc * xc, axis=-1, keepdims=True) + EPS)
    return (y * g.astype(jnp.float32)).astype(x.dtype)


def modulate(h, shift, scale):
    return (h * (1.0 + scale[:, None, :]) + shift[:, None, :]).astype(h.dtype)


def partial_rope(t, pos):
    inv_freq = ROPE_THETA ** (-jnp.arange(0, ROT_DIM, 2, dtype=jnp.float32) / ROT_DIM)
    ang = pos.astype(jnp.float32)[:, None] * inv_freq[None, :]
    cos = jnp.concatenate([jnp.cos(ang), jnp.cos(ang)], -1)[None, :, None, :]
    sin = jnp.concatenate([jnp.sin(ang), jnp.sin(ang)], -1)[None, :, None, :]
    rot, rest = t[..., :ROT_DIM], t[..., ROT_DIM:]
    r1, r2 = rot[..., :ROT_DIM // 2], rot[..., ROT_DIM // 2:]
    rot_half = jnp.concatenate([-r2, r1], -1)
    rot = rot * cos + rot_half * sin
    return jnp.concatenate([rot.astype(t.dtype), rest], -1)


def banded_dilated_attention(q, k, v, dilation, radius):
    B, S, H, Dh = q.shape
    L = S // dilation
    Lp = -(-L // QUERY_BLOCK) * QUERY_BLOCK
    n_blk = Lp // QUERY_BLOCK

    def to_sub(t):
        return t.reshape(B, L, dilation, H, Dh).transpose(0, 2, 1, 3, 4)

    qs = jnp.pad(to_sub(q), ((0, 0), (0, 0), (0, Lp - L), (0, 0), (0, 0)))
    qs = qs.reshape(B, dilation, n_blk, QUERY_BLOCK, H, Dh)

    def key_blocks(t):
        tp = jnp.pad(to_sub(t), ((0, 0), (0, 0), (radius, Lp + QUERY_BLOCK - L - radius), (0, 0), (0, 0)))
        tp = tp.reshape(B, dilation, n_blk + 1, QUERY_BLOCK, H, Dh)
        return jnp.concatenate([tp[:, :, :-1], tp[:, :, 1:]], axis=3)

    kb, vb = key_blocks(k), key_blocks(v)
    s = jnp.einsum('bdnqhc,bdnkhc->bdnqhk', qs, kb).astype(jnp.float32) * (Dh ** -0.5)

    t_idx = jnp.arange(QUERY_BLOCK)[:, None]
    k_idx = jnp.arange(2 * QUERY_BLOCK)[None, :]
    rel = k_idx - t_idx
    band = (rel >= 0) & (rel <= 2 * radius)
    key_pos = jnp.arange(n_blk)[:, None] * QUERY_BLOCK + jnp.arange(2 * QUERY_BLOCK)[None, :] - radius
    kvalid = (key_pos >= 0) & (key_pos < L)
    mask = band[None, :, :] & kvalid[:, None, :]
    s = jnp.where(mask[None, None, :, :, None, :], s, NEG_INF)

    m = jnp.max(s, axis=-1, keepdims=True)
    p = jnp.exp(s - m)
    denom = jnp.sum(p, axis=-1)
    o = jnp.einsum('bdnqhk,bdnkhc->bdnqhc', p, vb.astype(jnp.float32)) / denom[..., None]
    lse = m[..., 0] + jnp.log(denom)

    o = o.reshape(B, dilation, Lp, H, Dh)[:, :, :L].transpose(0, 2, 1, 3, 4).reshape(B, S, H, Dh)
    lse = lse.reshape(B, dilation, Lp, H)[:, :, :L].transpose(0, 2, 1, 3).reshape(B, S, H)
    return o, lse


def mixer_dilated_attention(h, w_qkv, w_o):
    B, S, _ = h.shape
    qkv = (h @ w_qkv).reshape(B, S, 3, A_HEADS, HEAD_DIM)
    pos = jnp.arange(S)
    q = partial_rope(qkv[:, :, 0], pos)
    k = partial_rope(qkv[:, :, 1], pos)
    v = qkv[:, :, 2]
    outs, lses = [], []
    for g, (window, dil) in enumerate(DILATED_PATTERNS):
        sl = slice(g * A_HEADS_PER_GROUP, (g + 1) * A_HEADS_PER_GROUP)
        o, l = banded_dilated_attention(q[:, :, sl], k[:, :, sl], v[:, :, sl], dil, window // (2 * dil))
        outs.append(o)
        lses.append(l)
    o = jnp.stack(outs, axis=2)
    lse = jnp.stack(lses, axis=2)
    alpha = jax.nn.softmax(lse, axis=2)
    o = (o * alpha[..., None]).astype(h.dtype).reshape(B, S, A_WIDTH)
    return o @ w_o


def mixer_spatial_gating(h, w_in, v_gain, w_s, b_s, w_o):
    B, S, _ = h.shape
    z = jax.nn.gelu(h @ w_in, approximate=False)
    u, v = z[..., :GMLP_HALF], z[..., GMLP_HALF:]
    v = layer_norm(v, v_gain)
    vc = v.reshape(B, S // CHUNK, CHUNK, GMLP_GROUPS, GMLP_HALF // GMLP_GROUPS)
    vs = jnp.einsum('gpq,bnqgc->bnpgc', w_s, vc) + jnp.transpose(b_s)[None, None, :, :, None]
    return (u * vs.reshape(B, S, GMLP_HALF).astype(u.dtype)) @ w_o


def hierarchical_moe(h, w_group, b_group, w_expert, b_expert, w_gate, w_up, w_down):
    B, S, D = h.shape
    T = B * S
    ht = h.reshape(T, D)
    g_logits = (ht @ w_group + b_group).astype(jnp.float32)
    g_prob = jax.nn.softmax(g_logits, axis=-1)
    g_val, g_idx = lax.top_k(g_prob, 1)
    e_all = (jnp.einsum('td,gde->tge', ht, w_expert) + b_expert).astype(jnp.float32)
    e_logits = jnp.take_along_axis(e_all, g_idx[:, :, None], axis=1)[:, 0]
    top_v, top_i = lax.top_k(e_logits, TOP_K_INNER)
    top_p = jax.nn.softmax(top_v, axis=-1)
    w_inner = jnp.sum(jax.nn.one_hot(top_i, EXPERTS_PER_GROUP, dtype=jnp.float32) * top_p[..., None], axis=1)
    gate = jax.nn.one_hot(g_idx[:, 0], N_EXPERT_GROUPS, dtype=jnp.float32)[:, :, None] * (g_val[:, :, None] * w_inner[:, None, :])
    gate = gate.reshape(T, N_EXPERTS)
    hg = jnp.einsum('td,edf->tef', ht, w_gate)
    hu = jnp.einsum('td,edf->tef', ht, w_up)
    act = (jax.nn.silu(hg) * hu * gate[..., None]).astype(h.dtype)
    y = jnp.einsum('tef,efd->td', act, w_down)
    return y.reshape(B, S, D)


def setup_inputs(seed: int = 0) -> dict:
    key = jax.random.key(seed)
    ks = jax.random.split(key, 24)
    f32 = jnp.float32

    def nrm(k, shape, fan_in, s=1.0):
        return jax.random.normal(k, shape, f32) * (s * fan_in ** -0.5)

    def gain(k, shape):
        return 1.0 + 0.02 * jax.random.normal(k, shape, f32)

    D = D_MODEL
    return {
        "x": jax.random.normal(ks[0], (BATCH, SEQ, D), f32),
        "c": jax.random.normal(ks[1], (BATCH, D), f32),
        "norm_mix": gain(ks[2], (DEPTH, D)),
        "norm_ffn": gain(ks[3], (DEPTH, D)),
        "w_ada": nrm(ks[4], (DEPTH, D, 6 * D), D, 0.5),
        "b_ada": 0.01 * jax.random.normal(ks[5], (DEPTH, 6 * D), f32),
        "a_w_qkv": nrm(ks[6], (N_A, D, 3 * A_WIDTH), D),
        "a_w_o": nrm(ks[7], (N_A, A_WIDTH, D), A_WIDTH),
        "b_w_in": nrm(ks[8], (N_B, D, 2 * GMLP_HALF), D),
        "b_v_gain": gain(ks[9], (N_B, GMLP_HALF)),
        "b_w_s": nrm(ks[10], (N_B, GMLP_GROUPS, CHUNK, CHUNK), CHUNK),
        "b_b_s": 1.0 + 0.01 * jax.random.normal(ks[11], (N_B, GMLP_GROUPS, CHUNK), f32),
        "b_w_o": nrm(ks[12], (N_B, GMLP_HALF, D), GMLP_HALF),
        "r_w_group": nrm(ks[13], (DEPTH, D, N_EXPERT_GROUPS), D),
        "r_b_group": 0.01 * jax.random.normal(ks[14], (DEPTH, N_EXPERT_GROUPS), f32),
        "r_w_expert": nrm(ks[15], (DEPTH, N_EXPERT_GROUPS, D, EXPERTS_PER_GROUP), D),
        "r_b_expert": 0.01 * jax.random.normal(ks[16], (DEPTH, N_EXPERT_GROUPS, EXPERTS_PER_GROUP), f32),
        "e_w_gate": nrm(ks[17], (DEPTH, N_EXPERTS, D, D_EXPERT), D),
        "e_w_up": nrm(ks[18], (DEPTH, N_EXPERTS, D, D_EXPERT), D),
        "e_w_down": nrm(ks[19], (DEPTH, N_EXPERTS, D_EXPERT, D), D_EXPERT),
        "final_norm": gain(ks[20], (D,)),
    }


def reference(x, c, norm_mix, norm_ffn, w_ada, b_ada, a_w_qkv, a_w_o, b_w_in, b_v_gain, b_w_s, b_b_s, b_w_o,
              r_w_group, r_b_group, r_w_expert, r_b_expert, e_w_gate, e_w_up, e_w_down, final_norm):
    c_act = jax.nn.silu(c)
    for l in range(DEPTH):
        mod = c_act @ w_ada[l] + b_ada[l]
        sh_m, sc_m, gt_m, sh_f, sc_f, gt_f = jnp.split(mod, 6, axis=-1)
        h = modulate(rms_norm(x, norm_mix[l]), sh_m, sc_m)
        j = l // 2
        if l % 2 == 0:
            y = mixer_dilated_attention(h, a_w_qkv[j], a_w_o[j])
        else:
            y = mixer_spatial_gating(h, b_w_in[j], b_v_gain[j], b_w_s[j], b_b_s[j], b_w_o[j])
        x = x + (gt_m[:, None, :] * y).astype(x.dtype)
        h = modulate(rms_norm(x, norm_ffn[l]), sh_f, sc_f)
        y = hierarchical_moe(h, r_w_group[l], r_b_group[l], r_w_expert[l], r_b_expert[l],
                             e_w_gate[l], e_w_up[l], e_w_down[l])
        x = x + (gt_f[:, None, :] * y).astype(x.dtype)
    return rms_norm(x, final_norm)
```

```cpp
#include <hip/hip_runtime.h>
#include <hip/hip_cooperative_groups.h>
#include <cstdio>
#include <cstdint>
namespace cg = cooperative_groups;

#ifndef MK_PER_PHASE
#define MK_PER_PHASE 0
#endif

#define GAS __attribute__((address_space(1)))
#define LAS __attribute__((address_space(3)))
typedef unsigned short bf16_t;
typedef short bf16x8 __attribute__((ext_vector_type(8)));
typedef short s16x4 __attribute__((ext_vector_type(4)));
typedef float f32x2 __attribute__((ext_vector_type(2)));
typedef float f32x4 __attribute__((ext_vector_type(4)));
typedef float f32x16 __attribute__((ext_vector_type(16)));
typedef unsigned u32x2 __attribute__((ext_vector_type(2)));
typedef unsigned u32x4 __attribute__((ext_vector_type(4)));

constexpr int NWAVES = 8, NTHR = 512;
constexpr int BATCH = 2, SEQ = 16384, T = BATCH * SEQ, D = 1024;
constexpr int NH = 15, HD = 64, AW = 960, NQKV = 2880, NQKVP = 3072;
constexpr int GH = 2048, FF = 4096, CHUNK = 128, NGRP = 8;
constexpr int NEXP = 16, DE = 256, NBUCK = 24, MAXTILES = 152;
constexpr float EPS = 1e-6f;
constexpr float C2 = 0.125f * 1.4426950408889634f;
constexpr int NPHASE = 19;

constexpr size_t MiB = 1u << 20;
constexpr size_t WS_CTL = 0, CTL_ZERO_BYTES = 1 * MiB;
constexpr size_t WS_MOD = 1 * MiB;
constexpr size_t WS_ROPE = 2 * MiB;
constexpr size_t WS_WR = 3 * MiB;
constexpr size_t WS_WQKV = 4 * MiB;
constexpr size_t WS_WO = 10 * MiB;
constexpr size_t WS_WIN = 12 * MiB;
constexpr size_t WS_WO2 = 20 * MiB;
constexpr size_t WS_BGU = 24 * MiB;
constexpr size_t WS_BDP = 56 * MiB;
constexpr size_t WS_H = 104 * MiB;
constexpr size_t WS_LIST = 168 * MiB;
constexpr size_t WS_STATS = 178 * MiB;
constexpr size_t WS_LSE = 186 * MiB;
constexpr size_t WS_BIG = 192 * MiB;
constexpr size_t WS_Q = WS_BIG, WS_K = WS_BIG + 60 * MiB, WS_V = WS_BIG + 120 * MiB, WS_O = WS_BIG + 180 * MiB;
constexpr size_t WS_HP = WS_BIG, WS_ACT = WS_BIG + 80 * MiB;
constexpr size_t WS_U = WS_BIG, WS_VV = WS_BIG + 128 * MiB;
constexpr size_t WS_END = 448 * MiB;
constexpr int CW_BAR = 4096;
constexpr int CW_CNT = 16384;

constexpr int RING_BYTES = 131072;
constexpr int LDSCTL_OFF = RING_BYTES, MISC_OFF = LDSCTL_OFF + 320, TAB_OFF = LDSCTL_OFF + 1024;
constexpr int LDS_BYTES = 147456;

__device__ __forceinline__ unsigned f2bf(float f) { unsigned u = __builtin_bit_cast(unsigned, f); return (u + 0x7fffu + ((u >> 16) & 1u)) >> 16; }
__device__ __forceinline__ unsigned pk2(float lo, float hi) { return f2bf(lo) | (f2bf(hi) << 16); }
__device__ __forceinline__ float bf2f(unsigned short v) { return __builtin_bit_cast(float, (unsigned)v << 16); }
__device__ __forceinline__ float bflo(unsigned w) { return __builtin_bit_cast(float, w << 16); }
__device__ __forceinline__ float bfhi(unsigned w) { return __builtin_bit_cast(float, w & 0xffff0000u); }
__device__ __forceinline__ float wave_sum(float v) {
#pragma unroll
    for (int o = 1; o < 64; o <<= 1) v += __shfl_xor(v, o);
    return v;
}
__device__ __forceinline__ float sum16(float v) {
#pragma unroll
    for (int o = 1; o < 16; o <<= 1) v += __shfl_xor(v, o);
    return v;
}
#define LDS_WAIT() asm volatile("s_waitcnt lgkmcnt(0)" ::: "memory")

#define XB_TMO      128
#define XB_XCNT(j)  (256  + 64 * (j))
#define XB_XSUB(j)  (1280 + 64 * (j))
#define XB_XGEN(j)  (2304 + 64 * (j))
#define XB_TOP      3328
#define XB_TOPGEN   3392
#define XCD_BAR_WORDS 3456
#define XB_SPIN_CAP (1u << 22)
__device__ __forceinline__ unsigned xb_ld(unsigned* p)              { return __hip_atomic_load(p, __ATOMIC_RELAXED, __HIP_MEMORY_SCOPE_AGENT); }
__device__ __forceinline__ unsigned xb_add(unsigned* p, unsigned v) { return __hip_atomic_fetch_add(p, v, __ATOMIC_RELAXED, __HIP_MEMORY_SCOPE_AGENT); }
__device__ __forceinline__ unsigned xb_xcc_id() { return (unsigned)__builtin_amdgcn_s_getreg((3 << 11) | 20) & 0xFu; }
#define XB_SPIN(cond, bar) do { unsigned _sp = 0; while (cond) { __builtin_amdgcn_s_sleep(1); \
    if ((++_sp & 255u) == 0u) { if (xb_ld(&(bar)[XB_TMO])) break; if (_sp > XB_SPIN_CAP) { atomicAdd(&(bar)[XB_TMO], 1u); break; } } } } while (0)
struct XcdBarrier { unsigned* bar; unsigned x; volatile LAS unsigned* st; };
__device__ __forceinline__ XcdBarrier xcd_barrier_post(unsigned* bar, volatile LAS unsigned* st) {
    XcdBarrier b; b.bar = bar; b.x = xb_xcc_id(); b.st = st;
    if (threadIdx.x == 0) (void)xb_add(&bar[XB_XCNT(b.x)], 1u);
    return b;
}
__device__ __forceinline__ void xcd_barrier_complete(unsigned* bar, unsigned x, unsigned& nloc, unsigned& nx) {
    const unsigned G = gridDim.x * gridDim.y * gridDim.z;
    unsigned sum, cnt, mine, sp = 0u;
    for (;;) {
        sum = 0u; cnt = 0u; mine = 0u;
#pragma unroll
        for (unsigned j = 0; j < 16; ++j) { const unsigned c = xb_ld(&bar[XB_XCNT(j)]); sum += c; cnt += (c > 0u) ? 1u : 0u; mine = (j == x) ? c : mine; }
        if (sum == G) break;
        __builtin_amdgcn_s_sleep(1);
        if ((++sp & 255u) == 0u) { if (xb_ld(&bar[XB_TMO])) break; if (sp > XB_SPIN_CAP) { atomicAdd(&bar[XB_TMO], 1u); break; } }
    }
    nloc = mine > 0u ? mine : 1u; nx = cnt > 0u ? cnt : 1u;
}
__device__ __forceinline__ void xcd_barrier(const XcdBarrier& b) {
    asm volatile("s_waitcnt vmcnt(0)" ::: "memory");
    __syncthreads();
    if (threadIdx.x == 0) {
        unsigned* bar = b.bar;
        __builtin_amdgcn_s_waitcnt(0);
        unsigned nloc = b.st[0], nx = b.st[1];
        if (nloc == 0u) { xcd_barrier_complete(bar, b.x, nloc, nx); b.st[0] = nloc; b.st[1] = nx; }
        const unsigned old = xb_add(&bar[XB_XSUB(b.x)], 1u);
        const unsigned gen = old / nloc;
        if (old + 1u == (gen + 1u) * nloc) {
            __builtin_amdgcn_fence(__ATOMIC_RELEASE, "agent");
            asm volatile("s_waitcnt vmcnt(0)" ::: "memory");
            const unsigned og = xb_add(&bar[XB_TOP], 1u);
            const unsigned tg = og / nx;
            if (og + 1u == (tg + 1u) * nx) xb_add(&bar[XB_TOPGEN], 1u);
            else XB_SPIN(xb_ld(&bar[XB_TOPGEN]) == tg, bar);
            __builtin_amdgcn_fence(__ATOMIC_ACQUIRE, "agent");
            xb_add(&bar[XB_XGEN(b.x)], 1u);
            asm volatile("s_waitcnt vmcnt(0)" ::: "memory");
        } else {
            XB_SPIN(xb_ld(&bar[XB_XGEN(b.x)]) == gen, bar);
            __builtin_amdgcn_fence(__ATOMIC_ACQUIRE, "agent");
            asm volatile("s_waitcnt vmcnt(0)" ::: "memory");
        }
    }
    __syncthreads();
}

namespace pg8 {
constexpr int BM = 256, BK = 64, HALF = 128, HTB = HALF * BK * 2, NXCD = 8, WGM = 8;
__host__ __device__ __forceinline__ int lds_byte(int r, int c) { const int st = (r >> 4) * 2 + (c >> 5), rr = r & 15, cc = c & 31, ob = rr * 64 + cc * 2; return st * 1024 + (ob ^ (((ob >> 9) & 1) << 5)); }
__host__ __device__ __forceinline__ void stage_rc(int b, int& R, int& C) { const int st = b / 1024, sb = b % 1024, swz = sb ^ (((sb >> 9) & 1) << 5); R = (st >> 1) * 16 + swz / 64; C = (st & 1) * 32 + (swz % 64) / 2; }
__host__ __device__ __forceinline__ int perm32(int rho) { const int n = rho >> 4, i = rho & 15; return 8 * (i >> 2) + 4 * n + (i & 3); }
struct Unit { int pm, pn; };
__device__ __forceinline__ int xcd_remap(int L, int nwg) { const int q = nwg / NXCD, r = nwg % NXCD, xcd = L % NXCD, off = L / NXCD; return (xcd < r ? xcd * (q + 1) : r * (q + 1) + (xcd - r) * q) + off; }

struct DenseOrder {
    const char* A; const char* Bt; size_t tstep; int nM, nN, nwg, G, c;
    __device__ void init(const void* A_, const void* Bt_, int M, int N, int K, int G_, int c_) { A = (const char*)A_; Bt = (const char*)Bt_; tstep = (size_t)BM * K * 2; nM = M / BM; nN = N / BM; nwg = nM * nN; G = G_; c = c_; }
    __device__ bool next(int i, Unit& u) const {
        const long L = (long)i * G + c; if (L >= nwg) return false;
        const int wgid = xcd_remap((int)L, nwg);
        const int nig = WGM * nN, gid = wgid / nig, fm = gid * WGM, gsz = (nM - fm) < WGM ? (nM - fm) : WGM;
        u.pm = fm + ((wgid % nig) % gsz); u.pn = (wgid % nig) / gsz; return true;
    }
    __device__ __forceinline__ const char* aptr(const Unit& u) const { return A + (size_t)u.pm * tstep; }
    __device__ __forceinline__ const char* bptr(const Unit& u) const { return Bt + (size_t)u.pn * tstep; }
};

__device__ __forceinline__ unsigned cvt_pk_bf16(float lo, float hi) { unsigned r; asm volatile("v_cvt_pk_bf16_f32 %0, %1, %2" : "=v"(r) : "v"(lo), "v"(hi)); return r; }
__device__ __forceinline__ f32x2 gelu_pk(f32x2 v) {
    const f32x2 av = __builtin_elementwise_abs(v), d = av * 0.2316418882f + 1.0f;
    f32x2 t; t.x = __builtin_amdgcn_rcpf(d.x); t.y = __builtin_amdgcn_rcpf(d.y);
    f32x2 q = t * 0.5307027145f + (-0.7265760135f); q = q * t + 0.7107068705f; q = q * t + (-0.142248368f); q = q * t + 0.127414796f; q = q * t;
    const f32x2 s = (v * v) * (-0.72134752044f);
    f32x2 e; e.x = __builtin_amdgcn_exp2f(s.x); e.y = __builtin_amdgcn_exp2f(s.y);
    const f32x2 m = v * (q * e), r = v - m;
    f32x2 o; o.x = v.x < 0.f ? m.x : r.x; o.y = v.y < 0.f ? m.y : r.y; return o;
}

template <class Epi, class Sched, bool ALIGN_EPI = true, bool SP2 = true>
__device__ __forceinline__ void gemm_phase(LAS unsigned char* lds, const int K, const Sched& S, const Epi& E) {
    int tid_ = threadIdx.x; asm volatile("" : "+v"(tid_));
    const int tid = tid_, wid = __builtin_amdgcn_readfirstlane(tid >> 6), lane = tid & 63, wr = wid >> 2, wc = wid & 3, fr = lane & 15, fq = lane >> 4;
    const int nt = K / BK;
    unsigned voffA[2], voffB[2];
#pragma unroll
    for (int i = 0; i < 2; ++i) { int R, C; stage_rc(tid * 16 + i * 8192, R, C); const int Rb = Epi::PERM ? ((R & ~31) + perm32(R & 31)) : R;
        voffA[i] = (unsigned)(R * K + C) * 2u; voffB[i] = (unsigned)(Rb * K + C) * 2u; }
    const size_t kstep = (size_t)(BK * 2);
    const size_t hstep = (size_t)HALF * K * 2;
    const unsigned ldsw = (unsigned)wid * 1024u;
    const int aoff = lds_byte(wr * 64 + fr, fq * 8), boff = lds_byte(wc * 32 + fr, fq * 8);
#define PG8_SA(b, h) (((b) * 2 + (h)) * HTB)
#define PG8_SB(b, h) ((4 + (b) * 2 + (h)) * HTB)
#define PG8_STAGE(bufoff, gbase, voff) do { _Pragma("unroll") for (int _i = 0; _i < 2; ++_i) \
        __builtin_amdgcn_global_load_lds((const unsigned*)((const char*)(gbase) + (voff)[_i]), (LAS unsigned*)(lds + (bufoff) + ldsw + _i * 8192), 16, 0, 0); } while (0)
#define PG8_LDA(dst, b, h) do { _Pragma("unroll") for (int m = 0; m < 4; ++m) _Pragma("unroll") for (int k = 0; k < 2; ++k) dst[m][k] = *(const LAS bf16x8*)(lds + PG8_SA(b, h) + aoff + m * 2048 + k * 1024); } while (0)
#define PG8_LDB(dst, b, h) do { _Pragma("unroll") for (int n = 0; n < 2; ++n) _Pragma("unroll") for (int k = 0; k < 2; ++k) dst[n][k] = *(const LAS bf16x8*)(lds + PG8_SB(b, h) + boff + n * 2048 + k * 1024); } while (0)
#define PG8_MMA(ai, bj, At, Bt) do { __builtin_amdgcn_s_setprio(1); _Pragma("unroll") for (int m = 0; m < 4; ++m) _Pragma("unroll") for (int n = 0; n < 2; ++n) _Pragma("unroll") for (int k = 0; k < 2; ++k) \
        acc[ai][bj][m][n] = __builtin_amdgcn_mfma_f32_16x16x32_bf16(Bt[n][k], At[m][k], acc[ai][bj][m][n], 0, 0, 0); __builtin_amdgcn_s_setprio(0); } while (0)
#define PG8_WAIT_V(n) asm volatile("s_waitcnt vmcnt(" #n ")" ::: "memory")
#define PG8_WAIT_L(n) asm volatile("s_waitcnt lgkmcnt(" #n ")" ::: "memory")
#define PG8_BAR __builtin_amdgcn_s_barrier()
#define PG8_SCHED __builtin_amdgcn_sched_barrier(0)
    Unit cur, nxt; int ui = 0;
    if (!S.next(0, cur)) return;
    f32x4 acc[2][2][4][2];
#pragma unroll
    for (int a = 0; a < 2; ++a)
#pragma unroll
        for (int b = 0; b < 2; ++b)
#pragma unroll
            for (int m = 0; m < 4; ++m)
#pragma unroll
                for (int n = 0; n < 2; ++n) acc[a][b][m][n] = (f32x4){0.f, 0.f, 0.f, 0.f};
    bf16x8 At[4][2], B0[2][2], B1[2][2];
    const char* cA = S.aptr(cur); const char* cB = S.bptr(cur);
    if constexpr (SP2) {
        PG8_STAGE(PG8_SB(0, 0), cB, voffB); PG8_STAGE(PG8_SB(0, 1), cB + hstep, voffB); PG8_STAGE(PG8_SA(0, 0), cA, voffA); PG8_STAGE(PG8_SA(0, 1), cA + hstep, voffA);
        if (wr == 1) PG8_BAR;
        PG8_WAIT_V(2); PG8_BAR;
        PG8_STAGE(PG8_SB(1, 0), cB + kstep, voffB); PG8_STAGE(PG8_SA(1, 0), cA + kstep, voffA); PG8_STAGE(PG8_SB(1, 1), cB + hstep + kstep, voffB);
        PG8_WAIT_V(6); PG8_BAR;
    } else {
        PG8_STAGE(PG8_SB(0, 0), cB, voffB); PG8_STAGE(PG8_SA(0, 0), cA, voffA); PG8_STAGE(PG8_SB(0, 1), cB + hstep, voffB); PG8_STAGE(PG8_SA(0, 1), cA + hstep, voffA);
        if (wr == 1) PG8_BAR;
        PG8_WAIT_V(4); PG8_BAR;
        PG8_STAGE(PG8_SB(1, 0), cB + kstep, voffB); PG8_STAGE(PG8_SA(1, 0), cA + kstep, voffA); PG8_STAGE(PG8_SB(1, 1), cB + hstep + kstep, voffB);
        PG8_WAIT_V(6); PG8_BAR;
    }
    for (;;) {
        const bool has_next = S.next(ui + 1, nxt);
        const char* nA = has_next ? S.aptr(nxt) : cA; const char* nB = has_next ? S.bptr(nxt) : cB;
        for (int t = 0; t < nt; t += 2) {
            const bool last = (t == nt - 2);
            const char* a1 = cA + (size_t)(t + 1) * kstep;
            const char* a2 = last ? nA : cA + (size_t)(t + 2) * kstep; const char* b2 = last ? nB : cB + (size_t)(t + 2) * kstep;
            const char* a3 = a2 + kstep; const char* b3 = b2 + kstep;
            if constexpr (SP2) {
            PG8_LDB(B0, 0, 0); PG8_LDB(B1, 0, 1); PG8_SCHED; PG8_LDA(At, 0, 0); PG8_STAGE(PG8_SA(1, 1), a1 + hstep, voffA);
            PG8_WAIT_V(8); PG8_WAIT_L(0); PG8_BAR; PG8_MMA(0, 0, At, B0); PG8_MMA(0, 1, At, B1); PG8_BAR; PG8_SCHED;
            PG8_LDA(At, 0, 1); PG8_STAGE(PG8_SB(0, 0), b2, voffB); PG8_STAGE(PG8_SB(0, 1), b2 + hstep, voffB); PG8_STAGE(PG8_SA(0, 0), a2, voffA);
            PG8_WAIT_V(8); PG8_WAIT_L(0); PG8_BAR; PG8_MMA(1, 0, At, B0); PG8_MMA(1, 1, At, B1); PG8_BAR; PG8_SCHED;
            PG8_LDB(B0, 1, 0); PG8_LDB(B1, 1, 1); PG8_SCHED; PG8_LDA(At, 1, 0); PG8_STAGE(PG8_SA(0, 1), a2 + hstep, voffA);
            PG8_WAIT_V(8); PG8_WAIT_L(0); PG8_BAR; PG8_MMA(0, 0, At, B0); PG8_MMA(0, 1, At, B1); PG8_BAR; PG8_SCHED;
            PG8_LDA(At, 1, 1); PG8_STAGE(PG8_SB(1, 0), b3, voffB); PG8_STAGE(PG8_SB(1, 1), b3 + hstep, voffB); PG8_STAGE(PG8_SA(1, 0), a3, voffA);
            PG8_WAIT_V(8); PG8_WAIT_L(0); PG8_BAR; PG8_MMA(1, 0, At, B0); PG8_MMA(1, 1, At, B1); PG8_BAR; PG8_SCHED;
            } else {
            PG8_LDB(B0, 0, 0); PG8_SCHED; PG8_LDA(At, 0, 0); PG8_STAGE(PG8_SA(1, 1), a1 + hstep, voffA);
            PG8_WAIT_L(8); PG8_BAR; PG8_WAIT_L(0); PG8_MMA(0, 0, At, B0); PG8_BAR; PG8_SCHED;
            PG8_LDB(B1, 0, 1); PG8_STAGE(PG8_SB(0, 0), b2, voffB);
            PG8_BAR; PG8_WAIT_L(0); PG8_MMA(0, 1, At, B1); PG8_BAR;
            PG8_LDA(At, 0, 1); PG8_STAGE(PG8_SA(0, 0), a2, voffA);
            PG8_BAR; PG8_WAIT_L(0); PG8_MMA(1, 0, At, B0); PG8_BAR; PG8_SCHED;
            PG8_STAGE(PG8_SB(0, 1), b2 + hstep, voffB);
            PG8_WAIT_V(6); PG8_BAR; PG8_MMA(1, 1, At, B1); PG8_BAR;
            PG8_LDB(B0, 1, 0); PG8_SCHED; PG8_LDA(At, 1, 0); PG8_STAGE(PG8_SA(0, 1), a2 + hstep, voffA);
            PG8_WAIT_L(8); PG8_BAR; PG8_WAIT_L(0); PG8_MMA(0, 0, At, B0); PG8_BAR; PG8_SCHED;
            PG8_LDB(B1, 1, 1); PG8_STAGE(PG8_SB(1, 0), b3, voffB);
            PG8_BAR; PG8_WAIT_L(0); PG8_MMA(0, 1, At, B1); PG8_BAR;
            PG8_LDA(At, 1, 1); PG8_STAGE(PG8_SA(1, 0), a3, voffA);
            PG8_BAR; PG8_WAIT_L(0); PG8_MMA(1, 0, At, B0); PG8_BAR; PG8_SCHED;
            PG8_STAGE(PG8_SB(1, 1), b3 + hstep, voffB);
            PG8_WAIT_V(6); PG8_BAR; PG8_MMA(1, 1, At, B1); PG8_BAR;
            }
        }
        if constexpr (ALIGN_EPI) { if (wr == 0) PG8_BAR; }
        E(acc, cur, wr, wc, fr, fq);
        if (!has_next) break;
#pragma unroll
        for (int a = 0; a < 2; ++a)
#pragma unroll
            for (int b = 0; b < 2; ++b)
#pragma unroll
                for (int m = 0; m < 4; ++m)
#pragma unroll
                    for (int n = 0; n < 2; ++n) acc[a][b][m][n] = (f32x4){0.f, 0.f, 0.f, 0.f};
        cur = nxt; cA = nA; cB = nB; ++ui;
        if constexpr (ALIGN_EPI) { if (wr == 1) PG8_BAR; }
    }
    PG8_WAIT_V(0);
    if constexpr (!ALIGN_EPI) { if (wr == 0) PG8_BAR; }
    PG8_BAR;
#undef PG8_SA
#undef PG8_SB
#undef PG8_STAGE
#undef PG8_LDA
#undef PG8_LDB
#undef PG8_MMA
#undef PG8_WAIT_V
#undef PG8_WAIT_L
#undef PG8_BAR
#undef PG8_SCHED
}
}
using pg8::Unit;
using pg8::cvt_pk_bf16;


struct EpiQKV {
    static constexpr bool PERM = true;
    bf16_t* Q; bf16_t* Kk; bf16_t* V; const float* rope;
    __device__ __forceinline__ void operator()(const f32x4 (&acc)[2][2][4][2], const Unit& u, int wr, int wc, int fr, int fq) const {
#pragma unroll
        for (int bj = 0; bj < 2; ++bj) {
            const int colbase = u.pn * 256 + bj * 128 + wc * 32;
            const int hs = colbase >> 6, half = (colbase >> 5) & 1;
            const int type = hs / NH, head = hs - type * NH;
            if (type >= 3) continue;
            const int grp = head / 5, shift = 2 * grp, L = SEQ >> shift, dmask = (1 << shift) - 1;
            bf16_t* dst = Q + (size_t)type * (60u * 1024u * 1024u / 2u);
            const bool do_rope = (type < 2) && (half == 0) && (fq < 2);
            const float sc = (type == 0) ? C2 : 1.0f;
#pragma unroll
            for (int ai = 0; ai < 2; ++ai)
#pragma unroll
                for (int m = 0; m < 4; ++m) {
                    const int row = u.pm * 256 + ai * 128 + wr * 64 + m * 16 + fr;
                    const int b = row >> 14, s = row & (SEQ - 1);
                    const int r = s & dmask, i = s >> shift;
                    const size_t drow = (size_t)(b * NH + head) * SEQ + (size_t)r * L + i;
                    f32x4 v0 = acc[ai][bj][m][0], v1 = acc[ai][bj][m][1];
                    if (do_rope) {
                        const f32x4 cs0 = *(const f32x4*)(rope + (size_t)s * 16 + fq * 8), cs1 = *(const f32x4*)(rope + (size_t)s * 16 + fq * 8 + 4);
                        const f32x4 c = (f32x4){cs0[0], cs0[2], cs1[0], cs1[2]}, sn = (f32x4){cs0[1], cs0[3], cs1[1], cs1[3]};
                        const f32x4 lo = v0 * c - v1 * sn, hi = v1 * c + v0 * sn;
                        v0 = lo; v1 = hi;
                    }
                    v0 = v0 * sc; v1 = v1 * sc;
                    u32x4 w; w.x = cvt_pk_bf16(v0[0], v0[1]); w.y = cvt_pk_bf16(v0[2], v0[3]); w.z = cvt_pk_bf16(v1[0], v1[1]); w.w = cvt_pk_bf16(v1[2], v1[3]);
                    *(u32x4*)(dst + drow * 64 + half * 32 + fq * 8) = w;
                }
        }
    }
};

struct EpiResid {
    static constexpr bool PERM = false;
    const float* base; float* out; const float* gate;
    __device__ __forceinline__ void operator()(const f32x4 (&acc)[2][2][4][2], const Unit& u, int wr, int wc, int fr, int fq) const {
        const int row0 = u.pm * 256 + wr * 64 + fr, col0 = u.pn * 256 + wc * 32 + 4 * fq;
        const int b = (u.pm * 256) >> 14;
        f32x4 gv[2][2];
#pragma unroll
        for (int bj = 0; bj < 2; ++bj)
#pragma unroll
            for (int n = 0; n < 2; ++n) gv[bj][n] = *(const f32x4*)(gate + b * 6144 + col0 + bj * 128 + n * 16);
#pragma unroll
        for (int ai = 0; ai < 2; ++ai)
#pragma unroll
            for (int m = 0; m < 4; ++m) { const size_t off = (size_t)(row0 + ai * 128 + m * 16) * D + col0;
#pragma unroll
                for (int bj = 0; bj < 2; ++bj)
#pragma unroll
                    for (int n = 0; n < 2; ++n) { const f32x4 bs = *(const f32x4*)(base + off + bj * 128 + n * 16); *(f32x4*)(out + off + bj * 128 + n * 16) = bs + gv[bj][n] * acc[ai][bj][m][n]; } }
    }
};

struct EpiGelu {
    static constexpr bool PERM = true;
    bf16_t* U; bf16_t* V; float* stats;
    __device__ __forceinline__ void operator()(const f32x4 (&acc)[2][2][4][2], const Unit& u, int wr, int wc, int fr, int fq) const {
        const bool isv = u.pn >= 8;
        bf16_t* dst = isv ? V : U;
        const int colt = (isv ? u.pn - 8 : u.pn) * 256 + wc * 32 + 8 * fq;
#pragma unroll
        for (int ai = 0; ai < 2; ++ai)
#pragma unroll
            for (int m = 0; m < 4; ++m) {
                const int row = u.pm * 256 + ai * 128 + wr * 64 + m * 16 + fr;
                float s1 = 0.f, s2 = 0.f;
#pragma unroll
                for (int bj = 0; bj < 2; ++bj) {
                    const f32x4 v0 = acc[ai][bj][m][0], v1 = acc[ai][bj][m][1];
                    const f32x2 a = pg8::gelu_pk((f32x2){v0[0], v0[1]}), bq = pg8::gelu_pk((f32x2){v0[2], v0[3]}), c = pg8::gelu_pk((f32x2){v1[0], v1[1]}), d = pg8::gelu_pk((f32x2){v1[2], v1[3]});
                    s1 += (a.x + a.y) + (bq.x + bq.y) + (c.x + c.y) + (d.x + d.y);
                    s2 += (a.x * a.x + a.y * a.y) + (bq.x * bq.x + bq.y * bq.y) + (c.x * c.x + c.y * c.y) + (d.x * d.x + d.y * d.y);
                    u32x4 w; w.x = cvt_pk_bf16(a.x, a.y); w.y = cvt_pk_bf16(bq.x, bq.y); w.z = cvt_pk_bf16(c.x, c.y); w.w = cvt_pk_bf16(d.x, d.y);
                    *(u32x4*)(dst + (size_t)row * GH + colt + bj * 128) = w;
                }
                if (isv) {
                    s1 += __shfl_xor(s1, 16); s1 += __shfl_xor(s1, 32); s2 += __shfl_xor(s2, 16); s2 += __shfl_xor(s2, 32);
                    if (fq == 0) *(f32x2*)(stats + ((size_t)row * 32 + (u.pn - 8) * 4 + wc) * 2) = (f32x2){s1, s2};
                }
            }
    }
};

struct MoeTab { LAS unsigned char* lds; int ntiles;
    __device__ __forceinline__ int cnt(int b) const { return __builtin_amdgcn_readfirstlane(((const LAS int*)(lds + TAB_OFF))[b]); }
    __device__ __forceinline__ int tpre(int b) const { return __builtin_amdgcn_readfirstlane(((const LAS int*)(lds + TAB_OFF + 128))[b]); }
    __device__ __forceinline__ int tileb(int t) const { return __builtin_amdgcn_readfirstlane((int)((const LAS unsigned char*)(lds + TAB_OFF + 256))[t]); }
};
__device__ __forceinline__ MoeTab moe_tab(LAS unsigned char* lds) {
    MoeTab t; t.lds = lds; t.ntiles = __builtin_amdgcn_readfirstlane(((const LAS int*)(lds + TAB_OFF + 128))[24]); return t;
}
__device__ __forceinline__ void moe_tab_build(LAS unsigned char* lds, const unsigned* gcnt) {
    LAS int* cnt = (LAS int*)(lds + TAB_OFF); LAS int* tpre = (LAS int*)(lds + TAB_OFF + 128); LAS unsigned char* tileb = (LAS unsigned char*)(lds + TAB_OFF + 256);
    const int t = threadIdx.x;
    __syncthreads();
    if (t < NBUCK) cnt[t] = (int)__hip_atomic_load(gcnt + t, __ATOMIC_RELAXED, __HIP_MEMORY_SCOPE_AGENT);
    __syncthreads();
    if (t <= NBUCK) { int p = 0;
#pragma unroll 1
        for (int j = 0; j < t; ++j) p += (cnt[j] + 255) >> 8;
        tpre[t] = p; }
    __syncthreads();
    if (t < 160) { int b = 0;
#pragma unroll 1
        for (int j = 1; j < NBUCK; ++j) b += (tpre[j] <= t) ? 1 : 0;
        tileb[t] = (unsigned char)b; }
    __syncthreads();
}
__device__ __forceinline__ int pair_a(int p) { return p < 3 ? 0 : (p < 5 ? 1 : 2); }
__device__ __forceinline__ int pair_b(int p) { return p == 0 ? 1 : ((p == 1 || p == 3) ? 2 : 3); }

struct MoeOrder {
    const char* A; size_t tstepA; const char* B; int mode  ; int layer; MoeTab tab; int nwg, G, c;
    __device__ bool next(int i, Unit& u) const {
        const long L = (long)i * G + c; if (L >= nwg) return false;
        const int wgid = pg8::xcd_remap((int)L, nwg); u.pm = wgid >> 2; u.pn = wgid & 3; return true;
    }
    __device__ __forceinline__ const char* aptr(const Unit& u) const { return A + (size_t)u.pm * tstepA; }
    __device__ __forceinline__ const char* bptr(const Unit& u) const {
        const int bk = tab.tileb(u.pm);
        if (mode == 0) { const int g = bk / 6, p = bk - g * 6; const int e = 4 * g + ((u.pn >> 1) ? pair_b(p) : pair_a(p));
            return B + ((size_t)((layer * NEXP + e) * 512 + (u.pn & 1) * 256)) * 1024 * 2; }
        return B + ((size_t)((layer * NBUCK + bk) * 1024 + u.pn * 256)) * 512 * 2;
    }
};

struct EpiAct {
    static constexpr bool PERM = true;
    bf16_t* ACT; const float* lwa; const float* lwb; MoeTab tab;
    __device__ __forceinline__ void operator()(const f32x4 (&acc)[2][2][4][2], const Unit& u, int wr, int wc, int fr, int fq) const {
        const int bk = tab.tileb(u.pm), idx0 = (u.pm - tab.tpre(bk)) * 256, cnt = tab.cnt(bk);
        const float* lw = ((u.pn >> 1) ? lwb : lwa) + (size_t)bk * T;
        const int col = u.pn * 128 + wc * 32 + 8 * fq;
#pragma unroll
        for (int ai = 0; ai < 2; ++ai)
#pragma unroll
            for (int m = 0; m < 4; ++m) {
                const int rl = ai * 128 + wr * 64 + m * 16 + fr, idx = idx0 + rl;
                const float w = idx < cnt ? lw[idx] : 0.f;
                float o[8];
#pragma unroll
                for (int n = 0; n < 2; ++n)
#pragma unroll
                    for (int j = 0; j < 4; ++j) { const float g = acc[ai][0][m][n][j], up = acc[ai][1][m][n][j];
                        const float sg = g * __builtin_amdgcn_rcpf(1.0f + __builtin_amdgcn_exp2f(-1.4426950408889634f * g));
                        o[n * 4 + j] = sg * up * w; }
                u32x4 pw; pw.x = cvt_pk_bf16(o[0], o[1]); pw.y = cvt_pk_bf16(o[2], o[3]); pw.z = cvt_pk_bf16(o[4], o[5]); pw.w = cvt_pk_bf16(o[6], o[7]);
                *(u32x4*)(ACT + (size_t)(u.pm * 256 + rl) * 512 + col) = pw;
            }
    }
};

struct EpiDown {
    static constexpr bool PERM = false;
    float* XR; const float* gate; const int* ltok; MoeTab tab;
    __device__ __forceinline__ void operator()(const f32x4 (&acc)[2][2][4][2], const Unit& u, int wr, int wc, int fr, int fq) const {
        const int bk = tab.tileb(u.pm), idx0 = (u.pm - tab.tpre(bk)) * 256, cnt = tab.cnt(bk);
        const int* lt = ltok + (size_t)bk * T;
        const int col0 = u.pn * 256 + wc * 32 + 4 * fq;
#pragma unroll
        for (int ai = 0; ai < 2; ++ai)
#pragma unroll
            for (int m = 0; m < 4; ++m) {
                const int idx = idx0 + ai * 128 + wr * 64 + m * 16 + fr;
                if (idx < cnt) {
                    const int tok = lt[idx]; const float* gp = gate + (tok >> 14) * 6144 + col0; float* xp = XR + (size_t)tok * D + col0;
#pragma unroll
                    for (int bj = 0; bj < 2; ++bj)
#pragma unroll
                        for (int n = 0; n < 2; ++n) { const f32x4 gv = *(const f32x4*)(gp + bj * 128 + n * 16); const f32x4 bs = *(const f32x4*)(xp + bj * 128 + n * 16); *(f32x4*)(xp + bj * 128 + n * 16) = bs + gv * acc[ai][bj][m][n]; }
                }
            }
    }
};

struct Args { const float* in[21]; float* out; unsigned char* ws; int ph_lo, ph_hi; };
struct Ctx {
    LAS unsigned char* lds; int tid, lane, wave, G, bx;
    float* out; unsigned char* ws;
};
enum { I_X = 0, I_C, I_NMIX, I_NFFN, I_WADA, I_BADA, I_WQKV, I_AWO, I_WIN, I_VGAIN, I_WS, I_BS, I_BWO, I_RWG, I_RBG, I_RWE, I_RBE, I_EWG, I_EWU, I_EWD, I_FNORM };

__device__ __forceinline__ void tr_load(const float* W, int ldw, int k0, int n0, LAS float* scr, int lane) {
#pragma unroll 8
    for (int i = 0; i < 32; ++i) { const int kk = 2 * i + (lane >> 5); scr[kk * 33 + (lane & 31)] = W[(size_t)(k0 + kk) * ldw + n0 + (lane & 31)]; }
    LDS_WAIT(); asm volatile("" ::: "memory");
}
template <class RowFn> __device__ __forceinline__ void tr_store(LAS float* scr, int lane, RowFn rowfn) {
    const int c = lane & 7;
#pragma unroll
    for (int j = 0; j < 4; ++j) { const int n = (lane >> 3) + 8 * j; const LAS float* s = scr + (8 * c) * 33 + n;
        u32x4 o; o.x = pk2(s[0 * 33], s[1 * 33]); o.y = pk2(s[2 * 33], s[3 * 33]); o.z = pk2(s[4 * 33], s[5 * 33]); o.w = pk2(s[6 * 33], s[7 * 33]);
        bf16_t* p = rowfn(n); if (p) *(u32x4*)(p + 8 * c) = o; }
    LDS_WAIT(); asm volatile("" ::: "memory");
}
__device__ __forceinline__ int qk_perm_row(int n) {
    if (n >= 2 * AW) return n;
    const int d = n & 63; if (d >= 16) return n;
    const int b = d >> 3, rem = d & 7, a = rem >> 2, c = rem & 3;
    return (n & ~63) + 8 * a + 4 * b + c;
}
__device__ __forceinline__ void p0_prep(Ctx& F, const Args& A) {
    unsigned char* ws = F.ws;
    {
        LAS float* CA = (LAS float*)F.lds;
        LAS float* RED = (LAS float*)(F.lds + 8192);
        for (int i = F.tid; i < 2 * D; i += NTHR) { const float v = A.in[I_C][i]; CA[i] = v / (1.0f + __expf(-v)); }
        __syncthreads();
        float* mod = (float*)(ws + WS_MOD);
        for (int task = F.bx; task < 192; task += F.G) {
            const int l = task / 96, j0 = (task % 96) * 64;
            const float* W = A.in[I_WADA] + (size_t)l * D * 6144 + j0 + F.lane;
            float a0 = 0.f, a1 = 0.f;
#pragma unroll 8
            for (int k = F.wave * 128; k < F.wave * 128 + 128; ++k) { const float w = W[(size_t)k * 6144]; a0 += CA[k] * w; a1 += CA[D + k] * w; }
            RED[(F.wave * 2 + 0) * 64 + F.lane] = a0; RED[(F.wave * 2 + 1) * 64 + F.lane] = a1;
            __syncthreads();
            if (F.wave < 2) { float s = 0.f;
#pragma unroll
                for (int w = 0; w < 8; ++w) s += RED[(w * 2 + F.wave) * 64 + F.lane];
                mod[(l * 2 + F.wave) * 6144 + j0 + F.lane] = s + A.in[I_BADA][l * 6144 + j0 + F.lane]; }
            __syncthreads();
        }
    }
    {
        LAS float* scr = (LAS float*)(F.lds + F.wave * 16384);
        const int gw = F.bx * NWAVES + F.wave, NGW = F.G * NWAVES;
        constexpr int I_A = 16 * 90, I_B = 15 * 32, I_C2 = 16 * 128, I_D = 32 * 32, I_E = 32 * 16 * 8, I_F = I_E, I_G = 32 * 4 * 32;
        constexpr int NITEMS = I_A + I_B + I_C2 + I_D + I_E + I_F + I_G;
        bf16_t* Wqkv = (bf16_t*)(ws + WS_WQKV); bf16_t* Wo = (bf16_t*)(ws + WS_WO); bf16_t* Win = (bf16_t*)(ws + WS_WIN); bf16_t* Wo2 = (bf16_t*)(ws + WS_WO2);
        bf16_t* Bgu = (bf16_t*)(ws + WS_BGU); bf16_t* Bdp = (bf16_t*)(ws + WS_BDP);
        for (int it = gw; it < NITEMS; it += NGW) {
            int r = it;
            if (r < I_A) { const int kb = r / 90, nb = r % 90, k0 = kb * 64, n0 = nb * 32; tr_load(A.in[I_WQKV], NQKV, k0, n0, scr, F.lane);
                tr_store(scr, F.lane, [&](int n) { return Wqkv + (size_t)qk_perm_row(n0 + n) * D + k0; }); continue; } r -= I_A;
            if (r < I_B) { const int kb = r / 32, nb = r % 32, k0 = kb * 64, n0 = nb * 32; tr_load(A.in[I_AWO], D, k0, n0, scr, F.lane);
                tr_store(scr, F.lane, [&](int n) { return Wo + (size_t)(n0 + n) * D + k0; }); continue; } r -= I_B;
            if (r < I_C2) { const int kb = r / 128, nb = r % 128, k0 = kb * 64, n0 = nb * 32; tr_load(A.in[I_WIN], FF, k0, n0, scr, F.lane);
                tr_store(scr, F.lane, [&](int n) { return Win + (size_t)(n0 + n) * D + k0; }); continue; } r -= I_C2;
            if (r < I_D) { const int kb = r / 32, nb = r % 32, k0 = kb * 64, n0 = nb * 32; tr_load(A.in[I_BWO], D, k0, n0, scr, F.lane);
                tr_store(scr, F.lane, [&](int n) { return Wo2 + (size_t)(n0 + n) * GH + k0; }); continue; } r -= I_D;
            if (r < I_E + I_F) { const bool up = r >= I_E; if (up) r -= I_E;
                const int le = r / 128, q = r % 128, kb = q / 8, nb = q % 8, k0 = kb * 64, n0 = nb * 32;
                tr_load(A.in[up ? I_EWU : I_EWG] + (size_t)le * D * DE, DE, k0, n0, scr, F.lane);
                tr_store(scr, F.lane, [&](int n) { const int j = n0 + n; return Bgu + ((size_t)le * 512 + (j >> 7) * 256 + (up ? 128 : 0) + (j & 127)) * D + k0; }); continue; } r -= I_E + I_F;
            { const int le = r / 128, q = r % 128, kb = q / 32, nb = q % 32, k0 = kb * 64, n0 = nb * 32;
                const int l = le >> 4, e = le & 15, g = e >> 2, li = e & 3;
                tr_load(A.in[I_EWD] + (size_t)le * DE * D, D, k0, n0, scr, F.lane);
#pragma unroll
                for (int p = 0; p < 6; ++p) { const int pa = pair_a(p), pb = pair_b(p); if (pa != li && pb != li) continue;
                    const int koff = (pa == li ? 0 : 256) + k0; bf16_t* base = Bdp + ((size_t)(l * NBUCK + g * 6 + p) * D) * 512 + koff;
                    const int c = F.lane & 7;
#pragma unroll
                    for (int j = 0; j < 4; ++j) { const int n = (F.lane >> 3) + 8 * j; const LAS float* s = scr + (8 * c) * 33 + n;
                        u32x4 o; o.x = pk2(s[0 * 33], s[1 * 33]); o.y = pk2(s[2 * 33], s[3 * 33]); o.z = pk2(s[4 * 33], s[5 * 33]); o.w = pk2(s[6 * 33], s[7 * 33]);
                        *(u32x4*)(base + (size_t)(n0 + n) * 512 + 8 * c) = o; }
                }
                LDS_WAIT(); asm volatile("" ::: "memory");
            }
        }
        const int gt = F.bx * NTHR + F.tid, NGT = F.G * NTHR;
        for (int i = gt; i < 192 * 128; i += NGT) *(u32x4*)(Wqkv + (size_t)NQKV * D + (size_t)i * 8) = (u32x4){0u, 0u, 0u, 0u};
        for (int i = gt; i < 1024 * 8; i += NGT) *(u32x4*)(Wo + (size_t)(i >> 3) * D + AW + (i & 7) * 8) = (u32x4){0u, 0u, 0u, 0u};
        float* rope = (float*)(ws + WS_ROPE);
        for (int i = gt; i < SEQ * 8; i += NGT) { const int pos = i >> 3, j = i & 7; const double inv = pow(500000.0, -(double)j / 8.0); const double ang = (double)pos * inv;
            rope[i * 2] = (float)cos(ang); rope[i * 2 + 1] = (float)sin(ang); }
        float* WR = (float*)(ws + WS_WR); float* WRB = (float*)(ws + WS_WR + 512 * 1024);
        for (int i = gt; i < 2 * D * 20; i += NGT) { const int l = i / (D * 20), rem = i % (D * 20), k = rem / 20, j = rem % 20;
            WR[i] = j < 4 ? A.in[I_RWG][((size_t)l * D + k) * 4 + j] : A.in[I_RWE][(((size_t)l * 4 + ((j - 4) >> 2)) * D + k) * 4 + ((j - 4) & 3)]; }
        for (int i = gt; i < 2 * 20; i += NGT) { const int l = i / 20, j = i % 20; WRB[l * 32 + j] = j < 4 ? A.in[I_RBG][l * 4 + j] : A.in[I_RBE][l * 16 + (j - 4)]; }
    }
}

__device__ __forceinline__ void norm_rows(Ctx& F, const float* src, const float* gamma, const float* sh, const float* sc, bf16_t* dst) {
    const int gw = F.bx * NWAVES + F.wave, NGW = F.G * NWAVES;
    f32x4 gs[4], shv[4]; int curb = -1;
    for (int m = gw; m < T; m += NGW) {
        const int b = m >> 14;
        if (b != curb) { curb = b;
#pragma unroll
            for (int j = 0; j < 4; ++j) { const int k = 4 * F.lane + 256 * j; const f32x4 g = *(const f32x4*)(gamma + k), s = *(const f32x4*)(sc + b * 6144 + k); gs[j] = g * (s + 1.0f); shv[j] = *(const f32x4*)(sh + b * 6144 + k); } }
        const f32x4* xr = (const f32x4*)(src + (size_t)m * D) + F.lane;
        f32x4 v[4]; float ss = 0.f;
#pragma unroll
        for (int j = 0; j < 4; ++j) { v[j] = xr[64 * j]; ss += (v[j].x * v[j].x + v[j].y * v[j].y) + (v[j].z * v[j].z + v[j].w * v[j].w); }
        const float r = 1.0f / sqrtf(wave_sum(ss) * (1.0f / D) + EPS);
        u32x2* o8 = (u32x2*)(dst + (size_t)m * D) + F.lane;
#pragma unroll
        for (int j = 0; j < 4; ++j) { const f32x4 h = v[j] * r * gs[j] + shv[j]; o8[64 * j] = (u32x2){pk2(h.x, h.y), pk2(h.z, h.w)}; }
    }
}
__device__ __forceinline__ void final_norm(Ctx& F, float* xr_, const float* gamma) {
    const int gw = F.bx * NWAVES + F.wave, NGW = F.G * NWAVES;
    f32x4 gs[4];
#pragma unroll
    for (int j = 0; j < 4; ++j) gs[j] = *(const f32x4*)(gamma + 4 * F.lane + 256 * j);
    for (int m = gw; m < T; m += NGW) {
        f32x4* xr = (f32x4*)(xr_ + (size_t)m * D) + F.lane;
        f32x4 v[4]; float ss = 0.f;
#pragma unroll
        for (int j = 0; j < 4; ++j) { v[j] = xr[64 * j]; ss += (v[j].x * v[j].x + v[j].y * v[j].y) + (v[j].z * v[j].z + v[j].w * v[j].w); }
        const float r = 1.0f / sqrtf(wave_sum(ss) * (1.0f / D) + EPS);
#pragma unroll
        for (int j = 0; j < 4; ++j) xr[64 * j] = v[j] * r * gs[j];
    }
}

__device__ __forceinline__ int crow(int r, int hi) { return (r & 3) + 8 * (r >> 2) + 4 * hi; }
__device__ __forceinline__ s16x4 vtr(const LAS unsigned char* p) { typedef short v4i16_t __attribute__((ext_vector_type(4))); return __builtin_bit_cast(s16x4, __builtin_amdgcn_ds_read_tr16_b64_v4i16((LAS v4i16_t*)p)); }
__device__ __forceinline__ void attn_unit(Ctx& F, int bh, int blk, const bf16_t* Q, const bf16_t* Kk, const bf16_t* V, bf16_t* O, float* LSE) {
    const int head = bh % NH, b = bh / NH, grp = head / 5, shift = 2 * grp, L = SEQ >> shift;
    const int row0 = blk * 256, seg = row0 / L, i0 = row0 - seg * L;
    const size_t hbase = ((size_t)bh * SEQ + (size_t)seg * L) * 64;
    const bf16_t* Kh = Kk + hbase; const bf16_t* Vh = V + hbase; const bf16_t* Qh = Q + hbase;
    LAS unsigned char* KL = F.lds; LAS unsigned char* VL = F.lds + 49152;
    __syncthreads();
#pragma unroll
    for (int pass = 0; pass < 6; ++pass) {
        const int idx = pass * NTHR + F.tid, row = idx >> 3, ch = idx & 7;
        int i = i0 - 64 + row; i = i < 0 ? 0 : (i > L - 1 ? L - 1 : i);
        const u32x4 kv = *(const u32x4*)(Kh + (size_t)i * 64 + ch * 8), vv = *(const u32x4*)(Vh + (size_t)i * 64 + ch * 8);
        *(LAS u32x4*)(KL + row * 128 + ((ch ^ ((row >> 1) & 7)) << 4)) = kv;
        *(LAS u32x4*)(VL + row * 128 + ((((ch >> 2) ^ ((row >> 1) & 1))) << 6) + (ch & 3) * 16) = vv;
    }
    const int w = F.wave, r32 = F.lane & 31, hi = F.lane >> 5;
    const int qi = i0 + 32 * w + r32;
    bf16x8 qf[4];
#pragma unroll
    for (int ks = 0; ks < 4; ++ks) qf[ks] = *(const bf16x8*)(Qh + (size_t)qi * 64 + 16 * ks + 8 * hi);
    __syncthreads();
    f32x16 st[5];
#pragma unroll
    for (int j = 0; j < 5; ++j) {
        st[j] = (f32x16){0.f, 0.f, 0.f, 0.f, 0.f, 0.f, 0.f, 0.f, 0.f, 0.f, 0.f, 0.f, 0.f, 0.f, 0.f, 0.f};
        const int row = 32 * w + 32 * j + r32;
#pragma unroll
        for (int ks = 0; ks < 4; ++ks) {
            const bf16x8 kf = *(const LAS bf16x8*)(KL + row * 128 + (((2 * ks + hi) ^ ((row >> 1) & 7)) << 4));
            st[j] = __builtin_amdgcn_mfma_f32_32x32x16_bf16(kf, qf[ks], st[j], 0, 0, 0);
        }
    }
    float mx = -INFINITY;
#pragma unroll
    for (int j = 0; j < 5; ++j)
#pragma unroll
        for (int r = 0; r < 16; ++r) {
            const int cr = crow(r, hi), ki = i0 + 32 * w - 64 + 32 * j + cr;
            bool ok = (ki >= 0) && (ki < L);
            if (j == 0) ok = ok && (cr >= r32);
            if (j == 4) ok = ok && (cr <= r32);
            st[j][r] = ok ? st[j][r] : -INFINITY;
            mx = fmaxf(mx, st[j][r]);
        }
    mx = fmaxf(mx, __shfl_xor(mx, 32));
    float sum = 0.f;
#pragma unroll
    for (int j = 0; j < 5; ++j)
#pragma unroll
        for (int r = 0; r < 16; ++r) { const float p = __builtin_amdgcn_exp2f(st[j][r] - mx); st[j][r] = p; sum += p; }
    sum += __shfl_xor(sum, 32);
    f32x16 o[2];
    o[0] = (f32x16){0.f, 0.f, 0.f, 0.f, 0.f, 0.f, 0.f, 0.f, 0.f, 0.f, 0.f, 0.f, 0.f, 0.f, 0.f, 0.f}; o[1] = o[0];
    const int G4 = F.lane >> 4, li = F.lane & 15, qq = li >> 2, pp = li & 3;
#pragma unroll
    for (int j = 0; j < 5; ++j)
#pragma unroll
        for (int s = 0; s < 2; ++s) {
            u32x4 pw; pw.x = cvt_pk_bf16(st[j][8 * s + 0], st[j][8 * s + 1]); pw.y = cvt_pk_bf16(st[j][8 * s + 2], st[j][8 * s + 3]);
            pw.z = cvt_pk_bf16(st[j][8 * s + 4], st[j][8 * s + 5]); pw.w = cvt_pk_bf16(st[j][8 * s + 6], st[j][8 * s + 7]);
            const bf16x8 pf = __builtin_bit_cast(bf16x8, pw);
#pragma unroll
            for (int dt = 0; dt < 2; ++dt) {
                const int rowA = 32 * w + 32 * j + 16 * s + 4 * hi + qq, rowB = rowA + 8;
                const int cb = (16 * (G4 & 1) + 4 * pp) * 2;
                const s16x4 lo = vtr(VL + rowA * 128 + ((dt ^ ((rowA >> 1) & 1)) << 6) + cb);
                const s16x4 hh = vtr(VL + rowB * 128 + ((dt ^ ((rowB >> 1) & 1)) << 6) + cb);
                const bf16x8 vf = (bf16x8){lo[0], lo[1], lo[2], lo[3], hh[0], hh[1], hh[2], hh[3]};
                o[dt] = __builtin_amdgcn_mfma_f32_32x32x16_bf16(vf, pf, o[dt], 0, 0, 0);
            }
        }
    const float inv = 1.0f / sum;
    const size_t tok = (size_t)b * SEQ + ((size_t)qi << shift) + seg;
    bf16_t* op = O + tok * D + head * 64;
#pragma unroll
    for (int dt = 0; dt < 2; ++dt)
#pragma unroll
        for (int g = 0; g < 4; ++g) {
            u32x2 w2; w2.x = cvt_pk_bf16(o[dt][4 * g + 0] * inv, o[dt][4 * g + 1] * inv); w2.y = cvt_pk_bf16(o[dt][4 * g + 2] * inv, o[dt][4 * g + 3] * inv);
            *(u32x2*)(op + 32 * dt + 8 * g + 4 * hi) = w2;
        }
    if (hi == 0) LSE[tok * 16 + head] = (mx + __builtin_amdgcn_logf(sum)) * 0.6931471805599453f;
}
__device__ __forceinline__ void attn_phase(Ctx& F) {
    const bf16_t* Q = (const bf16_t*)(F.ws + WS_Q); const bf16_t* Kk = (const bf16_t*)(F.ws + WS_K); const bf16_t* V = (const bf16_t*)(F.ws + WS_V);
    bf16_t* O = (bf16_t*)(F.ws + WS_O); float* LSE = (float*)(F.ws + WS_LSE);
    const int nunits = BATCH * NH * 64;
    for (int u = F.bx; u < nunits; u += F.G) attn_unit(F, u >> 6, u & 63, Q, Kk, V, O, LSE);
    const int gt = F.bx * NTHR + F.tid, NGT = F.G * NTHR;
    for (int i = gt; i < T * 8; i += NGT) *(u32x4*)(O + (size_t)(i >> 3) * D + AW + (i & 7) * 8) = (u32x4){0u, 0u, 0u, 0u};
}
__device__ __forceinline__ void combine_phase(Ctx& F) {
    bf16_t* O = (bf16_t*)(F.ws + WS_O); const float* LSE = (const float*)(F.ws + WS_LSE);
    const int gt = F.bx * NTHR + F.tid, NGT = F.G * NTHR;
    for (int i = gt; i < T * 120; i += NGT) {
        const int tok = i / 120, rem = i - tok * 120, head = rem >> 3, ch = rem & 7, hg = head % 5;
        const float l0 = LSE[tok * 16 + hg], l1 = LSE[tok * 16 + hg + 5], l2 = LSE[tok * 16 + hg + 10], lm = LSE[tok * 16 + head];
        const float mx = fmaxf(l0, fmaxf(l1, l2));
        const float a = __expf(lm - mx) / (__expf(l0 - mx) + __expf(l1 - mx) + __expf(l2 - mx));
        u32x4* p = (u32x4*)(O + (size_t)tok * D + head * 64 + ch * 8);
        u32x4 v = *p;
        v.x = pk2(bflo(v.x) * a, bfhi(v.x) * a); v.y = pk2(bflo(v.y) * a, bfhi(v.y) * a); v.z = pk2(bflo(v.z) * a, bfhi(v.z) * a); v.w = pk2(bflo(v.w) * a, bfhi(v.w) * a);
        *p = v;
    }
}

__device__ __forceinline__ void route_phase(Ctx& F, int layer, const float* gamma_all) {
    const float* XR = F.out; bf16_t* H = (bf16_t*)(F.ws + WS_H);
    const float* mod = (const float*)(F.ws + WS_MOD) + layer * 2 * 6144;
    const float* gamma = gamma_all + layer * D;
    const float* WRg = (const float*)(F.ws + WS_WR) + (size_t)layer * D * 20; const float* WRB = (const float*)(F.ws + WS_WR + 512 * 1024) + layer * 32;
    unsigned* gcnt = (unsigned*)(F.ws + WS_CTL) + CW_CNT + layer * 32;
    int* ltok = (int*)(F.ws + WS_LIST); float* lwa = (float*)(F.ws + WS_LIST + 3 * MiB); float* lwb = (float*)(F.ws + WS_LIST + 6 * MiB);
    LAS float* WRL = (LAS float*)F.lds;
    LAS float* GS = (LAS float*)(F.lds + 81920); LAS float* SH = (LAS float*)(F.lds + 86016);
    LAS int* TB = (LAS int*)(F.lds + 90112); LAS float* TWA = (LAS float*)(F.lds + 90624); LAS float* TWB = (LAS float*)(F.lds + 91136);
    LAS int* TRK = (LAS int*)(F.lds + 91648); LAS int* CNT = (LAS int*)(F.lds + 92160); LAS int* BASE = (LAS int*)(F.lds + 92288);
    __syncthreads();
    for (int i = F.tid; i < D * 20 / 4; i += NTHR) ((LAS f32x4*)WRL)[i] = ((const f32x4*)WRg)[i];
    for (int rb = F.bx; rb < T / 128; rb += F.G) {
        const int b = (rb * 128) >> 14;
        __syncthreads();
        for (int k = F.tid; k < D; k += NTHR) { GS[k] = gamma[k] * (1.0f + mod[b * 6144 + 4 * D + k]); SH[k] = mod[b * 6144 + 3 * D + k]; }
        if (F.tid < 32) CNT[F.tid] = 0;
        __syncthreads();
        for (int it = 0; it < 4; ++it) {
            const int lrow = it * 32 + F.wave * 4 + (F.lane >> 4), row = rb * 128 + lrow, c16 = F.lane & 15;
            const f32x4* xr = (const f32x4*)(XR + (size_t)row * D) + c16;
            f32x4 xv[16]; float ss = 0.f;
#pragma unroll
            for (int i = 0; i < 16; ++i) { xv[i] = xr[16 * i]; ss += (xv[i].x * xv[i].x + xv[i].y * xv[i].y) + (xv[i].z * xv[i].z + xv[i].w * xv[i].w); }
            const float r = 1.0f / sqrtf(sum16(ss) * (1.0f / D) + EPS);
            float a[20];
#pragma unroll
            for (int j = 0; j < 20; ++j) a[j] = 0.f;
            u32x2* hp = (u32x2*)(H + (size_t)row * D) + c16;
#pragma unroll
            for (int i = 0; i < 16; ++i) {
                const int k = 4 * c16 + 64 * i;
                const f32x4 g = *(const LAS f32x4*)(GS + k), s = *(const LAS f32x4*)(SH + k);
                const f32x4 h = xv[i] * r * g + s;
                hp[16 * i] = (u32x2){pk2(h.x, h.y), pk2(h.z, h.w)};
#pragma unroll
                for (int kk = 0; kk < 4; ++kk)
#pragma unroll
                    for (int j5 = 0; j5 < 5; ++j5) { const f32x4 wv = *(const LAS f32x4*)(WRL + (k + kk) * 20 + 4 * j5);
                        a[4 * j5 + 0] += h[kk] * wv.x; a[4 * j5 + 1] += h[kk] * wv.y; a[4 * j5 + 2] += h[kk] * wv.z; a[4 * j5 + 3] += h[kk] * wv.w; }
            }
#pragma unroll
            for (int j = 0; j < 20; ++j) a[j] = sum16(a[j]) + WRB[j];
            if (c16 == 0) {
                int g = 0; float gm = a[0];
#pragma unroll
                for (int j = 1; j < 4; ++j) if (a[j] > gm) { gm = a[j]; g = j; }
                float den = 0.f;
#pragma unroll
                for (int j = 0; j < 4; ++j) den += __expf(a[j] - gm);
                const float gval = 1.0f / den;
                float el[4];
#pragma unroll
                for (int e = 0; e < 4; ++e) el[e] = g == 0 ? a[4 + e] : (g == 1 ? a[8 + e] : (g == 2 ? a[12 + e] : a[16 + e]));
                int i1 = 0; float v1 = el[0];
#pragma unroll
                for (int e = 1; e < 4; ++e) if (el[e] > v1) { v1 = el[e]; i1 = e; }
                int i2 = -1; float v2 = -INFINITY;
#pragma unroll
                for (int e = 0; e < 4; ++e) if (e != i1 && el[e] > v2) { v2 = el[e]; i2 = e; }
                const float p1 = 1.0f / (1.0f + __expf(v2 - v1)), p2 = 1.0f - p1;
                const float w1 = gval * p1, w2 = gval * p2;
                const int pa = i1 < i2 ? i1 : i2, pb = i1 < i2 ? i2 : i1;
                const int pair = pa == 0 ? pb - 1 : (pa == 1 ? pb + 1 : 5);
                TB[lrow] = g * 6 + pair; TWA[lrow] = (i1 == pa) ? w1 : w2; TWB[lrow] = (i1 == pa) ? w2 : w1;
            }
        }
        __syncthreads();
        if (F.tid < 128) TRK[F.tid] = atomicAdd((int*)(CNT + TB[F.tid]), 1);
        __syncthreads();
        if (F.tid < NBUCK) BASE[F.tid] = (int)__hip_atomic_fetch_add(gcnt + F.tid, (unsigned)CNT[F.tid], __ATOMIC_RELAXED, __HIP_MEMORY_SCOPE_AGENT);
        __syncthreads();
        if (F.tid < 128) { const int bk = TB[F.tid], pos = BASE[bk] + TRK[F.tid]; const size_t o = (size_t)bk * T + pos;
            ltok[o] = rb * 128 + F.tid; lwa[o] = TWA[F.tid]; lwb[o] = TWB[F.tid]; }
    }
}
__device__ __forceinline__ void gather_phase(Ctx& F, int layer) {
    moe_tab_build(F.lds, (const unsigned*)(F.ws + WS_CTL) + CW_CNT + layer * 32);
    const MoeTab tab = moe_tab(F.lds);
    const bf16_t* H = (const bf16_t*)(F.ws + WS_H); bf16_t* HP = (bf16_t*)(F.ws + WS_HP); const int* ltok = (const int*)(F.ws + WS_LIST);
    const int gw = F.bx * NWAVES + F.wave, NGW = F.G * NWAVES, nrows = tab.ntiles * 256;
    for (int row = gw; row < nrows; row += NGW) {
        const int t = row >> 8, bk = tab.tileb(t), cnt = tab.cnt(bk); int idx = (t - tab.tpre(bk)) * 256 + (row & 255); idx = idx < cnt ? idx : cnt - 1;
        const int tok = ltok[(size_t)bk * T + idx];
        const u32x4* s = (const u32x4*)(H + (size_t)tok * D) + F.lane; u32x4* d = (u32x4*)(HP + (size_t)row * D) + F.lane;
        const u32x4 a = s[0], c = s[64]; d[0] = a; d[64] = c;
    }
}

__device__ __forceinline__ void gating_unit(Ctx& F, int n, int g, bf16_t* U, const bf16_t* V, const float* stats, const float* Ws, const float* gain, const float* bs) {
    LAS unsigned char* VT = F.lds; LAS unsigned char* WL = F.lds + 65536;
    LAS float* MU = (LAS float*)(F.lds + 98304); LAS float* RS = (LAS float*)(F.lds + 98816); LAS float* TP = (LAS float*)(F.lds + 99328);
    __syncthreads();
    if (F.tid < 128) {
        const f32x4* sp = (const f32x4*)(stats + (size_t)(n * 128 + F.tid) * 64); float s1 = 0.f, s2 = 0.f;
#pragma unroll
        for (int i = 0; i < 16; ++i) { const f32x4 v = sp[i]; s1 += v.x + v.z; s2 += v.y + v.w; }
        const float mu = s1 * (1.0f / GH), var = s2 * (1.0f / GH) - mu * mu;
        MU[F.tid] = mu; RS[F.tid] = 1.0f / sqrtf(var + EPS);
    }
#pragma unroll
    for (int pass = 0; pass < 8; ++pass) {
        const int idx = pass * NTHR + F.tid, q = idx >> 5, c16 = idx & 31;
        const u32x4 v = *(const u32x4*)(V + (size_t)(n * 128 + q) * GH + g * 256 + c16 * 8);
        *(LAS u32x4*)(VT + q * 512 + ((((c16 >> 2) ^ (q & 3))) << 6) + (c16 & 3) * 16) = v;
    }
    __syncthreads();
    {
        const int p = F.tid >> 2, qp = F.tid & 3; float t = 0.f;
        const f32x4* wp = (const f32x4*)(Ws + ((size_t)g * 128 + p) * 128 + 32 * qp);
#pragma unroll
        for (int i = 0; i < 4; ++i) {
            const f32x4 w0 = wp[2 * i], w1 = wp[2 * i + 1]; const int q0 = 32 * qp + 8 * i;
            float wv[8];
#pragma unroll
            for (int j = 0; j < 4; ++j) { wv[j] = w0[j] * RS[q0 + j]; wv[4 + j] = w1[j] * RS[q0 + 4 + j]; }
#pragma unroll
            for (int j = 0; j < 8; ++j) t += wv[j] * MU[q0 + j];
            const int c = 4 * qp + i;
            *(LAS u32x4*)(WL + p * 256 + ((c ^ (p & 15)) << 4)) = (u32x4){pk2(wv[0], wv[1]), pk2(wv[2], wv[3]), pk2(wv[4], wv[5]), pk2(wv[6], wv[7])};
        }
        t += __shfl_xor(t, 1); t += __shfl_xor(t, 2);
        if (qp == 0) TP[p] = t;
    }
    __syncthreads();
    const int w = F.wave, r32 = F.lane & 31, hi = F.lane >> 5, G4 = F.lane >> 4, li = F.lane & 15, qq = li >> 2, pp = li & 3;
    f32x16 acc[4];
#pragma unroll
    for (int nt = 0; nt < 4; ++nt) acc[nt] = (f32x16){0.f, 0.f, 0.f, 0.f, 0.f, 0.f, 0.f, 0.f, 0.f, 0.f, 0.f, 0.f, 0.f, 0.f, 0.f, 0.f};
#pragma unroll
    for (int ks = 0; ks < 8; ++ks) {
        const int cbyte = (32 * w + 16 * (G4 & 1) + 4 * pp) * 2;
        const int rA = 16 * ks + 8 * hi + qq, rB = rA + 4;
        const s16x4 lo = vtr(VT + rA * 512 + ((((cbyte >> 6) ^ (rA & 3))) << 6) + (cbyte & 63));
        const s16x4 hh = vtr(VT + rB * 512 + ((((cbyte >> 6) ^ (rB & 3))) << 6) + (cbyte & 63));
        const bf16x8 af = (bf16x8){lo[0], lo[1], lo[2], lo[3], hh[0], hh[1], hh[2], hh[3]};
#pragma unroll
        for (int nt = 0; nt < 4; ++nt) {
            const int p = 32 * nt + r32;
            const bf16x8 bfr = *(const LAS bf16x8*)(WL + p * 256 + (((2 * ks + hi) ^ (p & 15)) << 4));
            acc[nt] = __builtin_amdgcn_mfma_f32_32x32x16_bf16(af, bfr, acc[nt], 0, 0, 0);
        }
    }
    __syncthreads();
#pragma unroll
    for (int nt = 0; nt < 4; ++nt) {
        const int p = 32 * nt + r32; const float tp = TP[p], bp = bs[g * 128 + p];
#pragma unroll
        for (int gq = 0; gq < 4; ++gq) {
            const int c = 32 * w + 8 * gq + 4 * hi; const f32x4 gn = *(const f32x4*)(gain + g * 256 + c);
            float o[4];
#pragma unroll
            for (int j = 0; j < 4; ++j) o[j] = gn[j] * (acc[nt][4 * gq + j] - tp) + bp;
            const int cb = c * 2;
            *(LAS u32x2*)(VT + p * 512 + ((((cb >> 4) ^ (p & 15))) << 4) + (cb & 15)) = (u32x2){pk2(o[0], o[1]), pk2(o[2], o[3])};
        }
    }
    __syncthreads();
#pragma unroll
    for (int pass = 0; pass < 8; ++pass) {
        const int idx = pass * NTHR + F.tid, p = idx >> 5, c16 = idx & 31;
        const u32x4 vs = *(const LAS u32x4*)(VT + p * 512 + ((c16 ^ (p & 15)) << 4));
        u32x4* up = (u32x4*)(U + (size_t)(n * 128 + p) * GH + g * 256 + c16 * 8);
        const u32x4 uv = *up; u32x4 o;
        o.x = pk2(bflo(uv.x) * bflo(vs.x), bfhi(uv.x) * bfhi(vs.x)); o.y = pk2(bflo(uv.y) * bflo(vs.y), bfhi(uv.y) * bfhi(vs.y));
        o.z = pk2(bflo(uv.z) * bflo(vs.z), bfhi(uv.z) * bfhi(vs.z)); o.w = pk2(bflo(uv.w) * bflo(vs.w), bfhi(uv.w) * bfhi(vs.w));
        *up = o;
    }
}

__global__ void __launch_bounds__(NTHR, 2) mk_fwd(Args args) {
    extern __shared__ __attribute__((aligned(16))) unsigned char lds_[];
    Ctx F;
    F.lds = (LAS unsigned char*)lds_;
    F.tid = threadIdx.x; F.lane = F.tid & 63; F.wave = __builtin_amdgcn_readfirstlane(F.tid >> 6); F.G = gridDim.x; F.bx = blockIdx.x;
    F.out = args.out; F.ws = args.ws;
    unsigned char* ws = args.ws;
    volatile LAS unsigned* MISC = (volatile LAS unsigned*)(F.lds + MISC_OFF);
    for (int u = F.tid; u < (LDS_BYTES - LDSCTL_OFF) / 4; u += NTHR) ((LAS unsigned*)(F.lds + LDSCTL_OFF))[u] = 0u;
    __syncthreads();
    const int lo = args.ph_lo, hi = args.ph_hi;
#if MK_PER_PHASE
#define GRID_BAR(k) do {} while (0)
#else
    cg::grid_group grid = cg::this_grid();
    XcdBarrier bar = xcd_barrier_post((unsigned*)(ws + WS_CTL) + CW_BAR, MISC + 8);
#define GRID_BAR(k) do { if ((k) == 0) grid.sync(); else xcd_barrier(bar); } while (0)
#endif
#define IN(k) (lo <= (k) && (k) < hi)
#define SEAM(k) do { if (IN(k) && IN((k) + 1)) GRID_BAR(k); } while (0)
    const float* mod = (const float*)(ws + WS_MOD);
    bf16_t* H = (bf16_t*)(ws + WS_H);
    float* XR = args.out;

    if (IN(0)) { p0_prep(F, args); } SEAM(0);
    if (IN(1)) { norm_rows(F, args.in[I_X], args.in[I_NMIX], mod + 0 * D, mod + 1 * D, H); } SEAM(1);
    if (IN(2)) {
        pg8::DenseOrder S; S.init(H, ws + WS_WQKV, T, NQKVP, D, F.G, F.bx);
        EpiQKV E{(bf16_t*)(ws + WS_Q), (bf16_t*)(ws + WS_K), (bf16_t*)(ws + WS_V), (const float*)(ws + WS_ROPE)};
        pg8::gemm_phase<EpiQKV, pg8::DenseOrder>(F.lds, D, S, E);
    } SEAM(2);
    if (IN(3)) { attn_phase(F); } SEAM(3);
    if (IN(4)) { combine_phase(F); } SEAM(4);
    if (IN(5)) {
        pg8::DenseOrder S; S.init(ws + WS_O, ws + WS_WO, T, D, D, F.G, F.bx);
        EpiResid E{args.in[I_X], XR, mod + 2 * D};
        pg8::gemm_phase<EpiResid, pg8::DenseOrder>(F.lds, D, S, E);
    } SEAM(5);
#define MOE_LAYER(layer, pb) do { \
        const float* modl = mod + (layer) * 2 * 6144; \
        if (IN(pb)) { route_phase(F, layer, args.in[I_NFFN]); } SEAM(pb); \
        if (IN((pb) + 1)) { gather_phase(F, layer); } SEAM((pb) + 1); \
        if (IN((pb) + 2)) { \
            moe_tab_build(F.lds, (const unsigned*)(ws + WS_CTL) + CW_CNT + (layer) * 32); \
            const MoeTab tab = moe_tab(F.lds); \
            MoeOrder S{(const char*)(ws + WS_HP), (size_t)256 * D * 2, (const char*)(ws + WS_BGU), 0, layer, tab, tab.ntiles * 4, F.G, F.bx}; \
            EpiAct E{(bf16_t*)(ws + WS_ACT), (const float*)(ws + WS_LIST + 3 * MiB), (const float*)(ws + WS_LIST + 6 * MiB), tab}; \
            pg8::gemm_phase<EpiAct, MoeOrder>(F.lds, D, S, E); \
        } SEAM((pb) + 2); \
        if (IN((pb) + 3)) { \
            moe_tab_build(F.lds, (const unsigned*)(ws + WS_CTL) + CW_CNT + (layer) * 32); \
            const MoeTab tab = moe_tab(F.lds); \
            MoeOrder S{(const char*)(ws + WS_ACT), (size_t)256 * 512 * 2, (const char*)(ws + WS_BDP), 1, layer, tab, tab.ntiles * 4, F.G, F.bx}; \
            EpiDown E{XR, modl + 5 * D, (const int*)(ws + WS_LIST), tab}; \
            pg8::gemm_phase<EpiDown, MoeOrder>(F.lds, 512, S, E); \
        } SEAM((pb) + 3); \
    } while (0)
    MOE_LAYER(0, 6);
    if (IN(10)) { norm_rows(F, XR, args.in[I_NMIX] + D, mod + 2 * 6144 + 0 * D, mod + 2 * 6144 + 1 * D, H); } SEAM(10);
    if (IN(11)) {
        pg8::DenseOrder S; S.init(H, ws + WS_WIN, T, FF, D, F.G, F.bx);
        EpiGelu E{(bf16_t*)(ws + WS_U), (bf16_t*)(ws + WS_VV), (float*)(ws + WS_STATS)};
        pg8::gemm_phase<EpiGelu, pg8::DenseOrder>(F.lds, D, S, E);
    } SEAM(11);
    if (IN(12)) {
        for (int u = F.bx; u < 256 * NGRP; u += F.G) gating_unit(F, u >> 3, u & 7, (bf16_t*)(ws + WS_U), (const bf16_t*)(ws + WS_VV), (const float*)(ws + WS_STATS), args.in[I_WS], args.in[I_VGAIN], args.in[I_BS]);
    } SEAM(12);
    if (IN(13)) {
        pg8::DenseOrder S; S.init(ws + WS_U, ws + WS_WO2, T, D, GH, F.G, F.bx);
        EpiResid E{XR, XR, mod + 2 * 6144 + 2 * D};
        pg8::gemm_phase<EpiResid, pg8::DenseOrder>(F.lds, GH, S, E);
    } SEAM(13);
    MOE_LAYER(1, 14);
    if (IN(18)) { final_norm(F, XR, args.in[I_FNORM]); }
}

extern "C" void kernel_launch(void* const* d_in, const int* in_sizes, int n_in, void* d_out, int out_size, void* d_ws, size_t ws_size, hipStream_t stream) {
    static int grid = 0;
    if (grid == 0) {
        if (n_in != 21 || in_sizes[0] != T * D || out_size != T * D || ws_size < WS_END) { fprintf(stderr, "kernel_launch: unexpected problem (n_in %d, in0 %d, out %d, ws %zu)\n", n_in, n_in > 0 ? in_sizes[0] : -1, out_size, ws_size); grid = -1; return; }
        int dev = 0, cus = 0, per_cu = 0;
        (void)hipGetDevice(&dev);
        (void)hipDeviceGetAttribute(&cus, hipDeviceAttributeMultiprocessorCount, dev);
        (void)hipFuncSetAttribute((const void*)mk_fwd, hipFuncAttributeMaxDynamicSharedMemorySize, LDS_BYTES);
        (void)hipOccupancyMaxActiveBlocksPerMultiprocessor(&per_cu, (const void*)mk_fwd, NTHR, LDS_BYTES);
        if (per_cu < 1) { fprintf(stderr, "kernel_launch: occupancy query says %d blocks per CU\n", per_cu); grid = -1; return; }
        grid = cus;
    }
    if (grid < 0) return;
    (void)hipMemsetAsync((char*)d_ws + WS_CTL, 0, CTL_ZERO_BYTES, stream);
    Args a{};
    for (int i = 0; i < 21; ++i) a.in[i] = (const float*)d_in[i];
    a.out = (float*)d_out; a.ws = (unsigned char*)d_ws;
#if MK_PER_PHASE
    for (int p = 0; p < NPHASE; ++p) { a.ph_lo = p; a.ph_hi = p + 1; hipLaunchKernelGGL(mk_fwd, dim3(grid), dim3(NTHR), LDS_BYTES, stream, a); }
#else
    a.ph_lo = 0; a.ph_hi = NPHASE;
    void* kargs[] = {&a};
    hipError_t e = hipLaunchCooperativeKernel((const void*)mk_fwd, dim3(grid), dim3(NTHR), kargs, LDS_BYTES, stream);
    if (e != hipSuccess) fprintf(stderr, "cooperative launch failed: %s (grid %d)\n", hipGetErrorString(e), grid);
#endif
}
```

```cpp
#include <hip/hip_runtime.h>
#include <hip/hip_cooperative_groups.h>
#include <cstdio>
#include <cstdint>
namespace cg = cooperative_groups;

#ifndef MK_PER_PHASE
#define MK_PER_PHASE 0
#endif

#define GAS __attribute__((address_space(1)))
#define LAS __attribute__((address_space(3)))
typedef unsigned short bf16_t;
typedef short bf16x8 __attribute__((ext_vector_type(8)));
typedef short s16x4 __attribute__((ext_vector_type(4)));
typedef float f32x2 __attribute__((ext_vector_type(2)));
typedef float f32x4 __attribute__((ext_vector_type(4)));
typedef float f32x16 __attribute__((ext_vector_type(16)));
typedef unsigned u32x2 __attribute__((ext_vector_type(2)));
typedef unsigned u32x4 __attribute__((ext_vector_type(4)));

constexpr int NWAVES = 8, NTHR = 512;
constexpr int BATCH = 2, SEQ = 16384, T = BATCH * SEQ, D = 1024;
constexpr int NH = 15, HD = 64, AW = 960, NQKV = 2880, NQKVP = 3072;
constexpr int GH = 2048, FF = 4096, CHUNK = 128, NGRP = 8;
constexpr int NEXP = 16, DE = 256, NBUCK = 24, MAXTILES = 152;
constexpr float EPS = 1e-6f;
constexpr float C2 = 0.125f * 1.4426950408889634f;
constexpr int NPHASE = 19;

constexpr size_t MiB = 1u << 20;
constexpr size_t WS_CTL = 0, CTL_ZERO_BYTES = 1 * MiB;
constexpr size_t WS_MOD = 1 * MiB;
constexpr size_t WS_ROPE = 2 * MiB;
constexpr size_t WS_WR = 3 * MiB;
constexpr size_t WS_WQKV = 4 * MiB;
constexpr size_t WS_WO = 10 * MiB;
constexpr size_t WS_WIN = 12 * MiB;
constexpr size_t WS_WO2 = 20 * MiB;
constexpr size_t WS_BGU = 24 * MiB;
constexpr size_t WS_BDP = 56 * MiB;
constexpr size_t WS_H = 104 * MiB;
constexpr size_t WS_LIST = 168 * MiB;
constexpr size_t WS_WF = 177 * MiB;
constexpr size_t WS_STATS = 178 * MiB;
constexpr size_t WS_LSE = 186 * MiB;
constexpr size_t WS_BIG = 192 * MiB;
constexpr size_t WS_Q = WS_BIG, WS_K = WS_BIG + 60 * MiB, WS_V = WS_BIG + 120 * MiB, WS_O = WS_BIG + 180 * MiB;
constexpr size_t WS_HP = WS_BIG, WS_ACT = WS_BIG + 80 * MiB, WS_Y = WS_BIG + 120 * MiB, WS_Y1 = WS_BIG, WS_Y3 = WS_BIG + 128 * MiB, WS_Y4 = WS_BIG;
constexpr size_t WS_U = WS_BIG, WS_VV = WS_BIG + 128 * MiB;
constexpr size_t WS_XRB = 448 * MiB;
constexpr size_t WS_END = 512 * MiB;
constexpr int CW_BAR = 4096;
constexpr int CW_CNT = 16384;

constexpr int RING_BYTES = 131072;
constexpr int LDSCTL_OFF = RING_BYTES, MISC_OFF = LDSCTL_OFF + 320, TAB_OFF = LDSCTL_OFF + 1024;
constexpr int LDS_BYTES = 147456;

__device__ __forceinline__ unsigned f2bf(float f) { unsigned u = __builtin_bit_cast(unsigned, f); return (u + 0x7fffu + ((u >> 16) & 1u)) >> 16; }
__device__ __forceinline__ unsigned pk2(float lo, float hi) { return f2bf(lo) | (f2bf(hi) << 16); }
__device__ __forceinline__ float bf2f(unsigned short v) { return __builtin_bit_cast(float, (unsigned)v << 16); }
__device__ __forceinline__ float bflo(unsigned w) { return __builtin_bit_cast(float, w << 16); }
__device__ __forceinline__ float bfhi(unsigned w) { return __builtin_bit_cast(float, w & 0xffff0000u); }
__device__ __forceinline__ float wave_sum(float v) {
#pragma unroll
    for (int o = 1; o < 64; o <<= 1) v += __shfl_xor(v, o);
    return v;
}
__device__ __forceinline__ float sum16(float v) {
#pragma unroll
    for (int o = 1; o < 16; o <<= 1) v += __shfl_xor(v, o);
    return v;
}
#define LDS_WAIT() asm volatile("s_waitcnt lgkmcnt(0)" ::: "memory")
__device__ __forceinline__ int lane_now() { int l = (int)__builtin_amdgcn_mbcnt_hi(~0u, __builtin_amdgcn_mbcnt_lo(~0u, 0u)); asm volatile("" : "+v"(l)); return l; }

__device__ __forceinline__ int crow(int r, int hi) { return (r & 3) + 8 * (r >> 2) + 4 * hi; }
#define XB_TMO      128
#define XB_XCNT(j)  (256  + 64 * (j))
#define XB_XSUB(j)  (1280 + 64 * (j))
#define XB_XGEN(j)  (2304 + 64 * (j))
#define XB_TOP      3328
#define XB_TOPGEN   3392
#define XCD_BAR_WORDS 3456
#define XB_SPIN_CAP (1u << 22)
__device__ __forceinline__ unsigned xb_ld(unsigned* p)              { return __hip_atomic_load(p, __ATOMIC_RELAXED, __HIP_MEMORY_SCOPE_AGENT); }
__device__ __forceinline__ unsigned xb_add(unsigned* p, unsigned v) { return __hip_atomic_fetch_add(p, v, __ATOMIC_RELAXED, __HIP_MEMORY_SCOPE_AGENT); }
__device__ __forceinline__ unsigned xb_xcc_id() { return (unsigned)__builtin_amdgcn_s_getreg((3 << 11) | 20) & 0xFu; }
#define XB_SPIN(cond, bar) do { unsigned _sp = 0; while (cond) { __builtin_amdgcn_s_sleep(1); \
    if ((++_sp & 255u) == 0u) { if (xb_ld(&(bar)[XB_TMO])) break; if (_sp > XB_SPIN_CAP) { atomicAdd(&(bar)[XB_TMO], 1u); break; } } } } while (0)
struct XcdBarrier { unsigned* bar; unsigned x; volatile LAS unsigned* st; int wave; };
__device__ __forceinline__ XcdBarrier xcd_barrier_post(unsigned* bar, volatile LAS unsigned* st, int wave) {
    XcdBarrier b; b.bar = bar; b.x = xb_xcc_id(); b.st = st; b.wave = wave;
    if (wave == 0 && lane_now() == 0) (void)xb_add(&bar[XB_XCNT(b.x)], 1u);
    return b;
}
__device__ __forceinline__ void xcd_barrier_complete(unsigned* bar, unsigned x, unsigned& nloc, unsigned& nx) {
    const unsigned G = gridDim.x * gridDim.y * gridDim.z;
    unsigned sum, cnt, mine, sp = 0u;
    for (;;) {
        sum = 0u; cnt = 0u; mine = 0u;
#pragma unroll
        for (unsigned j = 0; j < 16; ++j) { const unsigned c = xb_ld(&bar[XB_XCNT(j)]); sum += c; cnt += (c > 0u) ? 1u : 0u; mine = (j == x) ? c : mine; }
        if (sum == G) break;
        __builtin_amdgcn_s_sleep(1);
        if ((++sp & 255u) == 0u) { if (xb_ld(&bar[XB_TMO])) break; if (sp > XB_SPIN_CAP) { atomicAdd(&bar[XB_TMO], 1u); break; } }
    }
    nloc = mine > 0u ? mine : 1u; nx = cnt > 0u ? cnt : 1u;
}
__device__ __forceinline__ void xcd_barrier2(const XcdBarrier& b) {
    asm volatile("s_waitcnt vmcnt(0)" ::: "memory");
    __syncthreads();
    if (b.wave == 0 && lane_now() == 0) {
        unsigned* bar = b.bar;
        __builtin_amdgcn_s_waitcnt(0);
        unsigned nloc = b.st[0], nx = b.st[1];
        if (nloc == 0u) { xcd_barrier_complete(bar, b.x, nloc, nx); b.st[0] = nloc; b.st[1] = nx; }
        const unsigned old = xb_add(&bar[XB_XSUB(b.x)], 1u);
        const unsigned gen = old / nloc;
        __builtin_amdgcn_fence(__ATOMIC_ACQUIRE, "agent");
        if (old + 1u == (gen + 1u) * nloc) {
            __builtin_amdgcn_fence(__ATOMIC_RELEASE, "agent");
            asm volatile("s_waitcnt vmcnt(0)" ::: "memory");
            const unsigned og = xb_add(&bar[XB_TOP], 1u);
            if (og + 1u == (gen + 1u) * nx) xb_add(&bar[XB_TOPGEN], 1u);
        }
        XB_SPIN(xb_ld(&bar[XB_TOPGEN]) == gen, bar);
        asm volatile("s_waitcnt vmcnt(0)" ::: "memory");
    }
    __syncthreads();
}

namespace pg8 {
constexpr int BM = 256, BK = 64, HALF = 128, HTB = HALF * BK * 2, NXCD = 8, WGM = 4;
__host__ __device__ __forceinline__ int lds_byte(int r, int c) { const int st = (r >> 4) * 2 + (c >> 5), rr = r & 15, cc = c & 31, ob = rr * 64 + cc * 2; return st * 1024 + (ob ^ (((ob >> 9) & 1) << 5)); }
__host__ __device__ __forceinline__ void stage_rc(int b, int& R, int& C) { const int st = b / 1024, sb = b % 1024, swz = sb ^ (((sb >> 9) & 1) << 5); R = (st >> 1) * 16 + swz / 64; C = (st & 1) * 32 + (swz % 64) / 2; }
__host__ __device__ __forceinline__ int perm32(int rho) { const int n = rho >> 4, i = rho & 15; return 8 * (i >> 2) + 4 * n + (i & 3); }
struct Unit { int pm, pn, h; };
__device__ __forceinline__ int xcd_remap(int L, int nwg) { const int q = nwg / NXCD, r = nwg % NXCD, xcd = L % NXCD, off = L / NXCD; return (xcd < r ? xcd * (q + 1) : r * (q + 1) + (xcd - r) * q) + off; }

struct DenseOrder {
    static constexpr bool HALFCAP = false;
    const char* A; const char* Bt; size_t tstep; int nM, nN, nwg, G, c;
    __device__ void init(const void* A_, const void* Bt_, int M, int N, int K, int G_, int c_) { A = (const char*)A_; Bt = (const char*)Bt_; tstep = (size_t)BM * K * 2; nM = M / BM; nN = N / BM; nwg = nM * nN; G = G_; c = c_; }
    __device__ bool next(int i, Unit& u) const {
        const long L = (long)i * G + c; if (L >= nwg) return false;
        const int wgid = xcd_remap((int)L, nwg);
        const int nig = WGM * nN, gid = wgid / nig, fm = gid * WGM, gsz = (nM - fm) < WGM ? (nM - fm) : WGM;
        u.pm = fm + ((wgid % nig) % gsz); u.pn = (wgid % nig) / gsz; u.h = 0; return true;
    }
    __device__ __forceinline__ const char* abase(const Unit& u) const { return A + (size_t)u.pm * tstep; }
    __device__ __forceinline__ const char* bptr(const Unit& u) const { return Bt + (size_t)u.pn * tstep; }
    __device__ __forceinline__ void aoffs(const Unit&, int, const int (&R)[2], const int (&C)[2], int K, unsigned& v00, unsigned& v01, unsigned& v10, unsigned& v11) const {
        v00 = (unsigned)(R[0] * K + C[0]) * 2u; v01 = (unsigned)(R[1] * K + C[1]) * 2u; v10 = v00 + (unsigned)(HALF * K * 2); v11 = v01 + (unsigned)(HALF * K * 2); }
};

__device__ __forceinline__ unsigned cvt_pk_bf16(float lo, float hi) { unsigned r; asm volatile("v_cvt_pk_bf16_f32 %0, %1, %2" : "=v"(r) : "v"(lo), "v"(hi)); return r; }
__device__ __forceinline__ f32x2 gelu_pk(f32x2 v) {
    const float six = 6.0f; f32x2 x, m;
    asm("v_min_f32_e64 %0, |%1|, %2" : "=v"(x.x) : "v"(v.x), "s"(six)); asm("v_min_f32_e64 %0, |%1|, %2" : "=v"(x.y) : "v"(v.y), "s"(six));
    f32x2 p = x * 3.309498500e-05f + (-7.692387091e-04f); p = p * x + 8.080778804e-03f; p = p * x + (-5.341219989e-02f); p = p * x + (-4.587709027e-01f); p = p * x + (-1.151201725e+00f); p = p * x + (-9.999930587e-01f);
    f32x2 e; e.x = __builtin_amdgcn_exp2f(p.x); e.y = __builtin_amdgcn_exp2f(p.y);
    asm("v_max_f32_e32 %0, 0, %1" : "=v"(m.x) : "v"(v.x)); asm("v_max_f32_e32 %0, 0, %1" : "=v"(m.y) : "v"(v.y));
    return m - x * e;
}

template <class Epi, class Sched, bool ALIGN_EPI = true>
__device__ __forceinline__ void gemm_phase(LAS unsigned char* lds, const int K, const Sched& S, const Epi& E, const int wave) {
    const int lane = lane_now(), wid = wave, tid = wave * 64 + lane, wr = wid >> 2, wc = wid & 3, fr = lane & 15, fq = lane >> 4;
    const int nt = K / BK;
    int RA[2], CA[2]; unsigned voffB[2];
#pragma unroll
    for (int i = 0; i < 2; ++i) { int R, C; stage_rc(tid * 16 + i * 8192, R, C);
        const int Rb = Epi::BMAP ? ((R >> 5) * 64 + perm32(R & 31)) : (Epi::PERM ? ((R & ~31) + perm32(R & 31)) : R);
        RA[i] = R; CA[i] = C; voffB[i] = (unsigned)(Rb * K + C) * 2u; }
    const size_t kstep = (size_t)(BK * 2);
    const size_t hstep = (size_t)(Epi::BMAP ? 32 : HALF) * K * 2;
    const unsigned ldsw = (unsigned)wid * 1024u;
    const int aoff = lds_byte(wr * 64 + fr, fq * 8), boff = lds_byte(wc * 32 + fr, fq * 8);
#define PG8_SA(b, h) (((b) * 2 + (h)) * HTB)
#define PG8_SB(b, h) ((4 + (b) * 2 + (h)) * HTB)
#define PG8_STAGE(bufoff, gbase, v0, v1) do { \
        __builtin_amdgcn_global_load_lds((const unsigned*)((const char*)(gbase) + (v0)), (LAS unsigned*)(lds + (bufoff) + ldsw), 16, 0, 0); \
        __builtin_amdgcn_global_load_lds((const unsigned*)((const char*)(gbase) + (v1)), (LAS unsigned*)(lds + (bufoff) + ldsw + 8192), 16, 0, 0); } while (0)
#define PG8_STB(bufoff, gbase) PG8_STAGE(bufoff, gbase, voffB[0], voffB[1])
#define PG8_LDA(dst, b, h) do { _Pragma("unroll") for (int m = 0; m < 4; ++m) _Pragma("unroll") for (int k = 0; k < 2; ++k) dst[m][k] = *(const LAS bf16x8*)(lds + PG8_SA(b, h) + aoff + m * 2048 + k * 1024); } while (0)
#define PG8_LDB(dst, b, h) do { _Pragma("unroll") for (int n = 0; n < 2; ++n) _Pragma("unroll") for (int k = 0; k < 2; ++k) dst[n][k] = *(const LAS bf16x8*)(lds + PG8_SB(b, h) + boff + n * 2048 + k * 1024); } while (0)
#define PG8_MMA(ai, bj, At, Bt) do { __builtin_amdgcn_s_setprio(1); _Pragma("unroll") for (int m = 0; m < 4; ++m) _Pragma("unroll") for (int n = 0; n < 2; ++n) _Pragma("unroll") for (int k = 0; k < 2; ++k) \
        acc[ai][bj][m][n] = __builtin_amdgcn_mfma_f32_16x16x32_bf16(Bt[n][k], At[m][k], acc[ai][bj][m][n], 0, 0, 0); __builtin_amdgcn_s_setprio(0); } while (0)
#define PG8_WAIT_V(n) asm volatile("s_waitcnt vmcnt(" #n ")" ::: "memory")
#define PG8_WAIT_L(n) asm volatile("s_waitcnt lgkmcnt(" #n ")" ::: "memory")
#define PG8_BAR __builtin_amdgcn_s_barrier()
#define PG8_SCHED __builtin_amdgcn_sched_barrier(0)
    Unit cur, nxt; int ui = 0;
    if (!S.next(0, cur)) return;
    f32x4 acc[2][2][4][2];
#pragma unroll
    for (int a = 0; a < 2; ++a)
#pragma unroll
        for (int b = 0; b < 2; ++b)
#pragma unroll
            for (int m = 0; m < 4; ++m)
#pragma unroll
                for (int n = 0; n < 2; ++n) acc[a][b][m][n] = (f32x4){0.f, 0.f, 0.f, 0.f};
    bf16x8 At[4][2], B0[2][2], B1[2][2];
    const char* cA = S.abase(cur); const char* cB = S.bptr(cur);
    unsigned vA00, vA01, vA10, vA11;
    S.aoffs(cur, 0, RA, CA, K, vA00, vA01, vA10, vA11);
    {
        PG8_STB(PG8_SB(0, 0), cB); PG8_STB(PG8_SB(0, 1), cB + hstep); PG8_STAGE(PG8_SA(0, 0), cA, vA00, vA01); PG8_STAGE(PG8_SA(0, 1), cA, vA10, vA11);
        if (wr == 1) PG8_BAR;
        PG8_WAIT_V(2); PG8_BAR;
        PG8_STB(PG8_SB(1, 0), cB + kstep); PG8_STAGE(PG8_SA(1, 0), cA + kstep, vA00, vA01); PG8_STB(PG8_SB(1, 1), cB + hstep + kstep);
        PG8_WAIT_V(6); PG8_BAR;
    }
    for (;;) {
        const bool has_next = S.next(ui + 1, nxt);
        const char* nA = has_next ? S.abase(nxt) : cA; const char* nB = has_next ? S.bptr(nxt) : cB;
        unsigned nA00 = vA00, nA01 = vA01, nA10 = vA10, nA11 = vA11;
        if (has_next) S.aoffs(nxt, ui + 1, RA, CA, K, nA00, nA01, nA10, nA11);
        const bool full = !Sched::HALFCAP || cur.h == 0;
        for (int t = 0; t < nt; t += 2) {
            const bool last = (t == nt - 2);
            const char* a1 = cA + (size_t)(t + 1) * kstep;
            const char* a2 = last ? nA : cA + (size_t)(t + 2) * kstep; const char* b2 = last ? nB : cB + (size_t)(t + 2) * kstep;
            const char* a3 = a2 + kstep; const char* b3 = b2 + kstep;
            const unsigned w00 = last ? nA00 : vA00, w01 = last ? nA01 : vA01, w10 = last ? nA10 : vA10, w11 = last ? nA11 : vA11;
            PG8_LDB(B0, 0, 0); PG8_LDB(B1, 0, 1); PG8_SCHED; PG8_LDA(At, 0, 0); PG8_STAGE(PG8_SA(1, 1), a1, vA10, vA11);
            PG8_WAIT_V(8); PG8_WAIT_L(0); PG8_BAR; PG8_MMA(0, 0, At, B0); PG8_MMA(0, 1, At, B1); PG8_BAR; PG8_SCHED;
            if (full) PG8_LDA(At, 0, 1); PG8_STB(PG8_SB(0, 0), b2); PG8_STB(PG8_SB(0, 1), b2 + hstep); PG8_STAGE(PG8_SA(0, 0), a2, w00, w01);
            PG8_WAIT_V(8); PG8_WAIT_L(0); PG8_BAR; if (full) { PG8_MMA(1, 0, At, B0); PG8_MMA(1, 1, At, B1); } PG8_BAR; PG8_SCHED;
            PG8_LDB(B0, 1, 0); PG8_LDB(B1, 1, 1); PG8_SCHED; PG8_LDA(At, 1, 0); PG8_STAGE(PG8_SA(0, 1), a2, w10, w11);
            PG8_WAIT_V(8); PG8_WAIT_L(0); PG8_BAR; PG8_MMA(0, 0, At, B0); PG8_MMA(0, 1, At, B1); PG8_BAR; PG8_SCHED;
            if (full) PG8_LDA(At, 1, 1); PG8_STB(PG8_SB(1, 0), b3); PG8_STB(PG8_SB(1, 1), b3 + hstep); PG8_STAGE(PG8_SA(1, 0), a3, w00, w01);
            PG8_WAIT_V(8); PG8_WAIT_L(0); PG8_BAR; if (full) { PG8_MMA(1, 0, At, B0); PG8_MMA(1, 1, At, B1); } PG8_BAR; PG8_SCHED;
        }
        if constexpr (ALIGN_EPI) { if (wr == 0) PG8_BAR; }
        E(acc, cur, wr, wc, fr, fq);
        if (!has_next) break;
#pragma unroll
        for (int a = 0; a < 2; ++a)
#pragma unroll
            for (int b = 0; b < 2; ++b)
#pragma unroll
                for (int m = 0; m < 4; ++m)
#pragma unroll
                    for (int n = 0; n < 2; ++n) acc[a][b][m][n] = (f32x4){0.f, 0.f, 0.f, 0.f};
        cur = nxt; cA = nA; cB = nB; ++ui; vA00 = nA00; vA01 = nA01; vA10 = nA10; vA11 = nA11;
        if constexpr (ALIGN_EPI) { if (wr == 1) PG8_BAR; }
    }
    PG8_WAIT_V(0);
    if constexpr (!ALIGN_EPI) { if (wr == 0) PG8_BAR; }
    PG8_BAR;
#undef PG8_SA
#undef PG8_SB
#undef PG8_STAGE
#undef PG8_STB
#undef PG8_LDA
#undef PG8_LDB
#undef PG8_MMA
#undef PG8_WAIT_V
#undef PG8_WAIT_L
#undef PG8_BAR
#undef PG8_SCHED
}
}
using pg8::Unit;
using pg8::cvt_pk_bf16;


struct EpiQKV {
    static constexpr bool PERM = true; static constexpr int BMAP = 1;
    bf16_t* Q; bf16_t* Kk; bf16_t* V; const float* rope;
    __device__ __forceinline__ void operator()(const f32x4 (&acc)[2][2][4][2], const Unit& u, int wr, int wc, int fr, int fq) const {
#pragma unroll
        for (int bj = 0; bj < 2; ++bj) {
            const int colbase = u.pn * 256 + wc * 64 + bj * 32;
            const int hs = colbase >> 6, half = (colbase >> 5) & 1;
            const int type = hs / NH, head = hs - type * NH;
            if (type >= 3) continue;
            const int grp = head / 5, shift = 2 * grp, L = SEQ >> shift, dmask = (1 << shift) - 1;
            bf16_t* dst = Q + (size_t)type * (60u * 1024u * 1024u / 2u);
            const bool do_rope = (type < 2) && (half == 0) && (fq < 2);
            const float sc = (type == 0) ? C2 : 1.0f;
#pragma unroll
            for (int ai = 0; ai < 2; ++ai) {
                f32x4 cs0[4], cs1[4];
#pragma unroll
                for (int m = 0; m < 4; ++m) {
                    const int s = (u.pm * 256 + ai * 128 + wr * 64 + m * 16 + fr) & (SEQ - 1);
                    if (do_rope) { cs0[m] = *(const f32x4*)(rope + (size_t)s * 16 + fq * 8); cs1[m] = *(const f32x4*)(rope + (size_t)s * 16 + fq * 8 + 4); }
                    else { cs0[m] = (f32x4){1.f, 0.f, 1.f, 0.f}; cs1[m] = cs0[m]; }
                }
#pragma unroll
                for (int m = 0; m < 4; ++m) {
                    const int row = u.pm * 256 + ai * 128 + wr * 64 + m * 16 + fr;
                    const int b = row >> 14, s = row & (SEQ - 1);
                    const int r = s & dmask, i = s >> shift;
                    const size_t drow = (size_t)(b * NH + head) * SEQ + (size_t)r * L + i;
                    f32x4 v0 = acc[ai][bj][m][0], v1 = acc[ai][bj][m][1];
                    const f32x4 c = (f32x4){cs0[m][0], cs0[m][2], cs1[m][0], cs1[m][2]}, sn = (f32x4){cs0[m][1], cs0[m][3], cs1[m][1], cs1[m][3]};
                    const f32x4 lo = v0 * c - v1 * sn, hi = v1 * c + v0 * sn;
                    v0 = lo * sc; v1 = hi * sc;
                    u32x4 w; w.x = cvt_pk_bf16(v0[0], v0[1]); w.y = cvt_pk_bf16(v0[2], v0[3]); w.z = cvt_pk_bf16(v1[0], v1[1]); w.w = cvt_pk_bf16(v1[2], v1[3]);
                    *(u32x4*)(dst + drow * 64 + half * 32 + fq * 8) = w;
                }
            }
        }
    }
};

struct EpiResid {
    static constexpr bool PERM = false; static constexpr int BMAP = 0;
    const float* base; float* out; const float* gate;
    __device__ __forceinline__ void operator()(const f32x4 (&acc)[2][2][4][2], const Unit& u, int wr, int wc, int fr, int fq) const {
        const int row0 = u.pm * 256 + wr * 64 + fr, col0 = u.pn * 256 + wc * 32 + 4 * fq;
        const int b = (u.pm * 256) >> 14;
        f32x4 gv[2][2];
#pragma unroll
        for (int bj = 0; bj < 2; ++bj)
#pragma unroll
            for (int n = 0; n < 2; ++n) gv[bj][n] = *(const f32x4*)(gate + b * 6144 + col0 + bj * 128 + n * 16);
#pragma unroll
        for (int ai = 0; ai < 2; ++ai) {
            f32x4 pre[4][2][2];
#pragma unroll
            for (int m = 0; m < 4; ++m) { const size_t off = (size_t)(row0 + ai * 128 + m * 16) * D + col0;
#pragma unroll
                for (int bj = 0; bj < 2; ++bj)
#pragma unroll
                    for (int n = 0; n < 2; ++n) pre[m][bj][n] = *(const f32x4*)(base + off + bj * 128 + n * 16); }
#pragma unroll
            for (int m = 0; m < 4; ++m) { const size_t off = (size_t)(row0 + ai * 128 + m * 16) * D + col0;
#pragma unroll
                for (int bj = 0; bj < 2; ++bj)
#pragma unroll
                    for (int n = 0; n < 2; ++n) *(f32x4*)(out + off + bj * 128 + n * 16) = pre[m][bj][n] + gv[bj][n] * acc[ai][bj][m][n]; }
        }
    }
};

struct EpiY {
    static constexpr bool PERM = true; static constexpr int BMAP = 1;
    bf16_t* Y; const float* gate;
    __device__ __forceinline__ void operator()(const f32x4 (&acc)[2][2][4][2], const Unit& u, int wr, int wc, int fr, int fq) const {
        const int row0 = u.pm * 256 + wr * 64 + fr, col0 = u.pn * 256 + wc * 64 + 8 * fq;
        const int b = (u.pm * 256) >> 14;
        f32x4 gv[2][2];
#pragma unroll
        for (int bj = 0; bj < 2; ++bj)
#pragma unroll
            for (int n = 0; n < 2; ++n) gv[bj][n] = *(const f32x4*)(gate + b * 6144 + col0 + bj * 32 + n * 4);
#pragma unroll
        for (int ai = 0; ai < 2; ++ai)
#pragma unroll
            for (int m = 0; m < 4; ++m) { bf16_t* yp = Y + (size_t)(row0 + ai * 128 + m * 16) * D + col0;
#pragma unroll
                for (int bj = 0; bj < 2; ++bj) { const f32x4 y0 = gv[bj][0] * acc[ai][bj][m][0], y1 = gv[bj][1] * acc[ai][bj][m][1];
                    *(u32x4*)(yp + bj * 32) = (u32x4){cvt_pk_bf16(y0[0], y0[1]), cvt_pk_bf16(y0[2], y0[3]), cvt_pk_bf16(y1[0], y1[1]), cvt_pk_bf16(y1[2], y1[3])}; } }
    }
};

template <int MODE = 0> struct EpiGelu {
    static constexpr bool PERM = true; static constexpr int BMAP = 1;
    bf16_t* U; bf16_t* V; float* stats;
    template <bool ISV> __device__ __forceinline__ void run(const f32x4 (&acc)[2][2][4][2], const Unit& u, int wr, int wc, int fr, int fq) const {
        bf16_t* dst = ISV ? V : U;
        const int colt = (ISV ? u.pn - 8 : u.pn) * 256 + wc * 64 + 8 * fq;
#pragma unroll
        for (int ai = 0; ai < 2; ++ai)
#pragma unroll
            for (int m = 0; m < 4; ++m) {
                const int row = u.pm * 256 + ai * 128 + wr * 64 + m * 16 + fr;
                f32x2 s1v = {0.f, 0.f}, s2v = {0.f, 0.f};
#pragma unroll
                for (int bj = 0; bj < 2; ++bj) {
                    const f32x4 v0 = acc[ai][bj][m][0], v1 = acc[ai][bj][m][1];
                    if constexpr (MODE == 2) { asm volatile("" :: "v"(v0), "v"(v1)); continue; }
                    const f32x2 a = pg8::gelu_pk((f32x2){v0[0], v0[1]}), bq = pg8::gelu_pk((f32x2){v0[2], v0[3]}), c = pg8::gelu_pk((f32x2){v1[0], v1[1]}), d = pg8::gelu_pk((f32x2){v1[2], v1[3]});
                    if constexpr (ISV) { s1v += (a + bq) + (c + d); s2v = a * a + s2v; s2v = bq * bq + s2v; s2v = c * c + s2v; s2v = d * d + s2v; }
                    u32x4 w; w.x = cvt_pk_bf16(a.x, a.y); w.y = cvt_pk_bf16(bq.x, bq.y); w.z = cvt_pk_bf16(c.x, c.y); w.w = cvt_pk_bf16(d.x, d.y);
                    if constexpr (MODE == 0) __builtin_nontemporal_store(w, (u32x4*)(dst + (size_t)row * GH + colt + bj * 32)); else asm volatile("" :: "v"(w));
                }
                if constexpr (ISV && MODE == 0) {
                    float s1 = s1v.x + s1v.y, s2 = s2v.x + s2v.y;
                    s1 += __shfl_xor(s1, 16); s1 += __shfl_xor(s1, 32); s2 += __shfl_xor(s2, 16); s2 += __shfl_xor(s2, 32);
                    if (fq == 0) *(f32x2*)(stats + ((size_t)row * 32 + (u.pn - 8) * 4 + wc) * 2) = (f32x2){s1, s2};
                }
            }
    }
    __device__ __forceinline__ void operator()(const f32x4 (&acc)[2][2][4][2], const Unit& u, int wr, int wc, int fr, int fq) const {
        if (u.pn >= 8) run<true>(acc, u, wr, wc, fr, fq); else run<false>(acc, u, wr, wc, fr, fq);
    }
};

struct MoeTab { LAS unsigned char* lds; int ntiles;
    __device__ __forceinline__ int cnt(int b) const { return __builtin_amdgcn_readfirstlane(((const LAS int*)(lds + TAB_OFF))[b]); }
    __device__ __forceinline__ int tpre(int b) const { return __builtin_amdgcn_readfirstlane(((const LAS int*)(lds + TAB_OFF + 128))[b]); }
    __device__ __forceinline__ int tileb(int t) const { return __builtin_amdgcn_readfirstlane((int)((const LAS unsigned char*)(lds + TAB_OFF + 256))[t]); }
};
__device__ __forceinline__ MoeTab moe_tab(LAS unsigned char* lds) {
    MoeTab t; t.lds = lds; t.ntiles = __builtin_amdgcn_readfirstlane(((const LAS int*)(lds + TAB_OFF + 128))[24]); return t;
}
__device__ __forceinline__ void moe_tab_build(LAS unsigned char* lds, const unsigned* gcnt, const int t) {
    LAS int* cnt = (LAS int*)(lds + TAB_OFF); LAS int* tpre = (LAS int*)(lds + TAB_OFF + 128); LAS unsigned char* tileb = (LAS unsigned char*)(lds + TAB_OFF + 256);
    __syncthreads();
    if (t < NBUCK) cnt[t] = (int)__hip_atomic_load(gcnt + t, __ATOMIC_RELAXED, __HIP_MEMORY_SCOPE_AGENT);
    __syncthreads();
    if (t <= NBUCK) { int p = 0;
#pragma unroll 1
        for (int j = 0; j < t; ++j) p += (cnt[j] + 255) >> 8;
        tpre[t] = p; }
    __syncthreads();
    if (t < 160) { int b = 0;
#pragma unroll 1
        for (int j = 1; j < NBUCK; ++j) b += (tpre[j] <= t) ? 1 : 0;
        tileb[t] = (unsigned char)b; }
    __syncthreads();
}
__device__ __forceinline__ int pair_a(int p) { return p < 3 ? 0 : (p < 5 ? 1 : 2); }
__device__ __forceinline__ int pair_b(int p) { return p == 0 ? 1 : ((p == 1 || p == 3) ? 2 : 3); }

constexpr int TOKL_OFF = LDSCTL_OFF + 2048;
struct MoeOrder {
    static constexpr bool HALFCAP = true;
    const char* A; size_t tstepA; const char* B; int mode; int layer; MoeTab tab; int nwg, G, c;
    __device__ __forceinline__ bool split() const { return layer == 1; }
    __device__ __forceinline__ int tail_lo() const { const int R = nwg / G, rem = nwg - R * G; return (G - rem >= G / 2) ? rem : 0; }
    __device__ bool next(int i, Unit& u) const {
        const int R = nwg / G, rem = nwg - R * G;
        int L; u.h = 0;
        if (i < R) L = i * G + c;
        else if (i > R) return false;
        else if (!split() || 2 * rem > G) { if (c >= rem) return false; L = R * G + c; }
        else { const int x = c & 7, o = c >> 3, Lt = 8 * (o >> 1) + x; if (Lt >= rem) return false; L = R * G + Lt; u.h = 1 + (o & 1); }
        const int wgid = pg8::xcd_remap(L, nwg); u.pm = wgid >> 2; u.pn = wgid & 3;
        if (u.h == 2) { const int bk = tab.tileb(u.pm); if ((u.pm - tab.tpre(bk)) * 256 + 128 >= tab.cnt(bk)) return false; }
        return true;
    }
    __device__ __forceinline__ const char* abase(const Unit& u) const { return mode == 0 ? A : A + (size_t)u.pm * tstepA; }
    __device__ __forceinline__ const char* bptr(const Unit& u) const {
        const int bk = tab.tileb(u.pm);
        if (mode == 0) { const int g = bk / 6, p = bk - g * 6; const int e = 4 * g + ((u.pn >> 1) ? pair_b(p) : pair_a(p));
            return B + ((size_t)((layer * NEXP + e) * 512 + (u.pn & 1) * 256)) * 1024 * 2; }
        return B + ((size_t)((layer * NBUCK + bk) * 1024 + u.pn * 256)) * 512 * 2;
    }
    __device__ __forceinline__ void aoffs(const Unit& u, int ui, const int (&R)[2], const int (&C)[2], int K, unsigned& v00, unsigned& v01, unsigned& v10, unsigned& v11) const {
        if (mode == 0) { const LAS int* tl = (const LAS int*)(tab.lds + TOKL_OFF) + ui * 256;
            v00 = (unsigned)(tl[R[0]] * K + C[0]) * 2u; v01 = (unsigned)(tl[R[1]] * K + C[1]) * 2u; v10 = (unsigned)(tl[128 + R[0]] * K + C[0]) * 2u; v11 = (unsigned)(tl[128 + R[1]] * K + C[1]) * 2u; }
        else { const unsigned ro = u.h == 2 ? (unsigned)(128 * K * 2) : 0u;
            v00 = (unsigned)(R[0] * K + C[0]) * 2u + ro; v01 = (unsigned)(R[1] * K + C[1]) * 2u + ro; v10 = u.h ? v00 : v00 + (unsigned)(128 * K * 2); v11 = u.h ? v01 : v01 + (unsigned)(128 * K * 2); }
    }
    __device__ __forceinline__ void fill_tokl(const int* ltok, const int tid) const {
        LAS int* tl = (LAS int*)(tab.lds + TOKL_OFF); Unit u;
        for (int i = 0; i < 4 && next(i, u); ++i) {
            const int bk = tab.tileb(u.pm), idx0 = (u.pm - tab.tpre(bk)) * 256, cnt = tab.cnt(bk);
            if (tid < 256) { int idx = idx0 + (u.h ? (tid & 127) + 128 * (u.h - 1) : tid); idx = idx < cnt ? idx : cnt - 1; tl[i * 256 + tid] = ltok[(size_t)bk * T + idx]; }
        }
        __syncthreads();
    }
};

struct EpiAct {
    static constexpr bool PERM = true; static constexpr int BMAP = 0;
    bf16_t* ACT; const float* lwa; const float* lwb; MoeTab tab;
    __device__ __forceinline__ void operator()(const f32x4 (&acc)[2][2][4][2], const Unit& u, int wr, int wc, int fr, int fq) const {
        const int bk = tab.tileb(u.pm), idx0 = (u.pm - tab.tpre(bk)) * 256, cnt = tab.cnt(bk);
        const float* lw = ((u.pn >> 1) ? lwb : lwa) + (size_t)bk * T;
        const int col = u.pn * 128 + wc * 32 + 8 * fq;
        const int roff = u.h == 2 ? 128 : 0;
        float wrow[2][4];
#pragma unroll
        for (int ai = 0; ai < 2; ++ai)
#pragma unroll
            for (int m = 0; m < 4; ++m) { const int idx = idx0 + roff + ai * 128 + wr * 64 + m * 16 + fr; wrow[ai][m] = idx < cnt ? lw[idx] : 0.f; }
#pragma unroll
        for (int ai = 0; ai < 2; ++ai) {
            if (ai == 1 && u.h != 0) continue;
#pragma unroll
            for (int m = 0; m < 4; ++m) {
                const int rl = roff + ai * 128 + wr * 64 + m * 16 + fr;
                const float w = wrow[ai][m];
                float o[8];
#pragma unroll
                for (int n = 0; n < 2; ++n)
#pragma unroll
                    for (int j = 0; j < 4; ++j) { const float g = acc[ai][0][m][n][j], up = acc[ai][1][m][n][j];
                        const float sg = g * __builtin_amdgcn_rcpf(1.0f + __builtin_amdgcn_exp2f(-1.4426950408889634f * g));
                        o[n * 4 + j] = sg * up * w; }
                u32x4 pw; pw.x = cvt_pk_bf16(o[0], o[1]); pw.y = cvt_pk_bf16(o[2], o[3]); pw.z = cvt_pk_bf16(o[4], o[5]); pw.w = cvt_pk_bf16(o[6], o[7]);
                *(u32x4*)(ACT + (size_t)(u.pm * 256 + rl) * 512 + col) = pw;
            }
        }
    }
};

struct EpiDown {
    static constexpr bool PERM = true; static constexpr int BMAP = 1;
    bf16_t* Y; const float* gate; const int* ltok; MoeTab tab;
    __device__ __forceinline__ void operator()(const f32x4 (&acc)[2][2][4][2], const Unit& u, int wr, int wc, int fr, int fq) const {
        const int bk = tab.tileb(u.pm), idx0 = (u.pm - tab.tpre(bk)) * 256, cnt = tab.cnt(bk);
        const int* lt = ltok + (size_t)bk * T;
        const int col0 = u.pn * 256 + wc * 64 + 8 * fq;
        const int roff = u.h == 2 ? 128 : 0;
        int tokr[2][4];
#pragma unroll
        for (int ai = 0; ai < 2; ++ai)
#pragma unroll
            for (int m = 0; m < 4; ++m) { const int idx = idx0 + roff + ai * 128 + wr * 64 + m * 16 + fr; tokr[ai][m] = (idx < cnt && (ai == 0 || u.h == 0)) ? lt[idx] : -1; }
        f32x4 g0[2][2], g1[2][2];
#pragma unroll
        for (int bj = 0; bj < 2; ++bj)
#pragma unroll
            for (int n = 0; n < 2; ++n) { g0[bj][n] = *(const f32x4*)(gate + col0 + bj * 32 + n * 4); g1[bj][n] = *(const f32x4*)(gate + 6144 + col0 + bj * 32 + n * 4); }
#pragma unroll
        for (int ai = 0; ai < 2; ++ai)
#pragma unroll
            for (int m = 0; m < 4; ++m) {
                const int tok = tokr[ai][m];
                if (tok >= 0) {
                    const bool b1 = tok >= SEQ;
#pragma unroll
                    for (int bj = 0; bj < 2; ++bj) {
                        const f32x4 ga = b1 ? g1[bj][0] : g0[bj][0], gb = b1 ? g1[bj][1] : g0[bj][1];
                        const f32x4 y0 = ga * acc[ai][bj][m][0], y1 = gb * acc[ai][bj][m][1];
                        *(u32x4*)(Y + (size_t)tok * D + col0 + bj * 32) = (u32x4){cvt_pk_bf16(y0[0], y0[1]), cvt_pk_bf16(y0[2], y0[3]), cvt_pk_bf16(y1[0], y1[1]), cvt_pk_bf16(y1[2], y1[3])};
                    }
                }
            }
    }
};

struct Args { const float* in[21]; float* out; unsigned char* ws; int ph_lo, ph_hi; };
struct Ctx {
    LAS unsigned char* lds; int tid, lane, wave, G, bx;
    float* out; unsigned char* ws;
};
enum { I_X = 0, I_C, I_NMIX, I_NFFN, I_WADA, I_BADA, I_WQKV, I_AWO, I_WIN, I_VGAIN, I_WS, I_BS, I_BWO, I_RWG, I_RBG, I_RWE, I_RBE, I_EWG, I_EWU, I_EWD, I_FNORM };

__device__ __forceinline__ void tr_load(const float* W, int ldw, int k0, int n0, LAS float* scr, int lane) {
#pragma unroll 8
    for (int i = 0; i < 32; ++i) { const int kk = 2 * i + (lane >> 5); scr[kk * 33 + (lane & 31)] = __builtin_nontemporal_load(W + (size_t)(k0 + kk) * ldw + n0 + (lane & 31)); }
    LDS_WAIT(); asm volatile("" ::: "memory");
}
template <class RowFn> __device__ __forceinline__ void tr_store(LAS float* scr, int lane, RowFn rowfn) {
    const int c = lane & 7;
#pragma unroll
    for (int j = 0; j < 4; ++j) { const int n = (lane >> 3) + 8 * j; const LAS float* s = scr + (8 * c) * 33 + n;
        u32x4 o; o.x = pk2(s[0 * 33], s[1 * 33]); o.y = pk2(s[2 * 33], s[3 * 33]); o.z = pk2(s[4 * 33], s[5 * 33]); o.w = pk2(s[6 * 33], s[7 * 33]);
        bf16_t* p = rowfn(n); if (p) *(u32x4*)(p + 8 * c) = o; }
    LDS_WAIT(); asm volatile("" ::: "memory");
}
__device__ __forceinline__ int qk_perm_row(int n) {
    if (n >= 2 * AW) return n;
    const int d = n & 63; if (d >= 16) return n;
    const int b = d >> 3, rem = d & 7, a = rem >> 2, c = rem & 3;
    return (n & ~63) + 8 * a + 4 * b + c;
}

__device__ __forceinline__ void expert_items(Ctx& F, const Args& A, int layer, int widx, int nw) {
    unsigned char* ws = F.ws;
    LAS float* scr = (LAS float*)(F.lds + F.wave * 16384);
    bf16_t* Bgu = (bf16_t*)(ws + WS_BGU); bf16_t* Bdp = (bf16_t*)(ws + WS_BDP);
    constexpr int I_E = 16 * 16 * 8, I_G = 16 * 4 * 32;
    for (int it = widx; it < 2 * I_E + I_G; it += nw) {
        int r = it;
        if (r < 2 * I_E) { const bool up = r >= I_E; if (up) r -= I_E;
            const int le = layer * 16 + r / 128, q = r % 128, kb = q / 8, nb = q % 8, k0 = kb * 64, n0 = nb * 32;
            tr_load(A.in[up ? I_EWU : I_EWG] + (size_t)le * D * DE, DE, k0, n0, scr, F.lane);
            tr_store(scr, F.lane, [&](int n) { const int j = n0 + n; return Bgu + ((size_t)le * 512 + (j >> 7) * 256 + (up ? 128 : 0) + (j & 127)) * D + k0; }); continue; } r -= 2 * I_E;
        { const int le = layer * 16 + r / 128, q = r % 128, kb = q / 32, nb = q % 32, k0 = kb * 64, n0 = nb * 32;
            const int l = le >> 4, e = le & 15, g = e >> 2, li = e & 3;
            tr_load(A.in[I_EWD] + (size_t)le * DE * D, D, k0, n0, scr, F.lane);
#pragma unroll
            for (int p = 0; p < 6; ++p) { const int pa = pair_a(p), pb = pair_b(p); if (pa != li && pb != li) continue;
                const int koff = (pa == li ? 0 : 256) + k0; bf16_t* base = Bdp + ((size_t)(l * NBUCK + g * 6 + p) * D) * 512 + koff;
                const int c = F.lane & 7;
#pragma unroll
                for (int j = 0; j < 4; ++j) { const int n = (F.lane >> 3) + 8 * j; const LAS float* s = scr + (8 * c) * 33 + n;
                    u32x4 o; o.x = pk2(s[0 * 33], s[1 * 33]); o.y = pk2(s[2 * 33], s[3 * 33]); o.z = pk2(s[4 * 33], s[5 * 33]); o.w = pk2(s[6 * 33], s[7 * 33]);
                    *(u32x4*)(base + (size_t)(n0 + n) * 512 + 8 * c) = o; }
            }
            LDS_WAIT(); asm volatile("" ::: "memory");
        }
    }
}

__device__ __forceinline__ void gmlp_items(Ctx& F, const Args& A, int widx, int nw) {
    unsigned char* ws = F.ws;
    LAS float* scr = (LAS float*)(F.lds + F.wave * 16384);
    bf16_t* Win = (bf16_t*)(ws + WS_WIN); bf16_t* Wo2 = (bf16_t*)(ws + WS_WO2);
    constexpr int I_C2 = 16 * 128, I_D = 32 * 32;
    for (int it = widx; it < I_C2 + I_D; it += nw) {
        int r = it;
        if (r < I_C2) { const int kb = r / 128, nb = r % 128, k0 = kb * 64, n0 = nb * 32; tr_load(A.in[I_WIN], FF, k0, n0, scr, F.lane);
            tr_store(scr, F.lane, [&](int n) { return Win + (size_t)(n0 + n) * D + k0; }); continue; } r -= I_C2;
        { const int kb = r / 32, nb = r % 32, k0 = kb * 64, n0 = nb * 32; tr_load(A.in[I_BWO], D, k0, n0, scr, F.lane);
            tr_store(scr, F.lane, [&](int n) { return Wo2 + (size_t)(n0 + n) * GH + k0; }); }
    }
}
__device__ __forceinline__ void p0_prep(Ctx& F, const Args& A) {
    unsigned char* ws = F.ws;
    {
        LAS float* CA = (LAS float*)F.lds;
        LAS float* RED = (LAS float*)(F.lds + 8192);
        for (int i = F.tid; i < 2 * D; i += NTHR) { const float v = A.in[I_C][i]; CA[i] = v / (1.0f + __expf(-v)); }
        __syncthreads();
        float* mod = (float*)(ws + WS_MOD);
        for (int task = F.bx; task < 192; task += F.G) {
            const int l = task / 96, j0 = (task % 96) * 64;
            const float* W = A.in[I_WADA] + (size_t)l * D * 6144 + j0 + F.lane;
            float a0 = 0.f, a1 = 0.f;
#pragma unroll 1
            for (int k0 = F.wave * 128; k0 < F.wave * 128 + 128; k0 += 32) {
                float wv[32];
#pragma unroll
                for (int j = 0; j < 32; ++j) wv[j] = __builtin_nontemporal_load(W + (size_t)(k0 + j) * 6144);
#pragma unroll
                for (int j = 0; j < 32; ++j) { a0 += CA[k0 + j] * wv[j]; a1 += CA[D + k0 + j] * wv[j]; }
            }
            RED[(F.wave * 2 + 0) * 64 + F.lane] = a0; RED[(F.wave * 2 + 1) * 64 + F.lane] = a1;
            __syncthreads();
            if (F.wave < 2) { float s = 0.f;
#pragma unroll
                for (int w = 0; w < 8; ++w) s += RED[(w * 2 + F.wave) * 64 + F.lane];
                mod[(l * 2 + F.wave) * 6144 + j0 + F.lane] = s + A.in[I_BADA][l * 6144 + j0 + F.lane]; }
            __syncthreads();
        }
    }
    {
        LAS float* scr = (LAS float*)(F.lds + F.wave * 16384);
        const int gw = F.bx * NWAVES + F.wave, NGW = F.G * NWAVES;
        constexpr int I_A = 16 * 90, I_B = 15 * 32;
        constexpr int NITEMS = I_A + I_B;
        bf16_t* Wqkv = (bf16_t*)(ws + WS_WQKV); bf16_t* Wo = (bf16_t*)(ws + WS_WO); bf16_t* Win = (bf16_t*)(ws + WS_WIN); bf16_t* Wo2 = (bf16_t*)(ws + WS_WO2);
        bf16_t* Bgu = (bf16_t*)(ws + WS_BGU); bf16_t* Bdp = (bf16_t*)(ws + WS_BDP);
        for (int it = gw; it < NITEMS; it += NGW) {
            int r = it;
            if (r < I_A) { const int kb = r / 90, nb = r % 90, k0 = kb * 64, n0 = nb * 32; tr_load(A.in[I_WQKV], NQKV, k0, n0, scr, F.lane);
                tr_store(scr, F.lane, [&](int n) { return Wqkv + (size_t)qk_perm_row(n0 + n) * D + k0; }); continue; } r -= I_A;
            if (r < I_B) { const int kb = r / 32, nb = r % 32, k0 = kb * 64, n0 = nb * 32; tr_load(A.in[I_AWO], D, k0, n0, scr, F.lane);
                tr_store(scr, F.lane, [&](int n) { return Wo + (size_t)(n0 + n) * D + k0; }); continue; } r -= I_B;
        }
        expert_items(F, A, 0, gw, NGW);
        const int gt = F.bx * NTHR + F.tid, NGT = F.G * NTHR;
        for (int i = gt; i < 192 * 128; i += NGT) *(u32x4*)(Wqkv + (size_t)NQKV * D + (size_t)i * 8) = (u32x4){0u, 0u, 0u, 0u};
        for (int i = gt; i < 1024 * 8; i += NGT) *(u32x4*)(Wo + (size_t)(i >> 3) * D + AW + (i & 7) * 8) = (u32x4){0u, 0u, 0u, 0u};
        float* rope = (float*)(ws + WS_ROPE);
        for (int i = gt; i < SEQ * 8; i += NGT) { const int pos = i >> 3, j = i & 7; const double inv = pow(500000.0, -(double)j / 8.0); const double ang = (double)pos * inv;
            rope[i * 2] = (float)cos(ang); rope[i * 2 + 1] = (float)sin(ang); }
        float* WR = (float*)(ws + WS_WR); float* WRB = (float*)(ws + WS_WR + 512 * 1024);
        for (int i = gt; i < 2 * D * 20; i += NGT) { const int l = i / (D * 20), rem = i % (D * 20), k = rem / 20, j = rem % 20;
            WR[i] = j < 4 ? A.in[I_RWG][((size_t)l * D + k) * 4 + j] : A.in[I_RWE][(((size_t)l * 4 + ((j - 4) >> 2)) * D + k) * 4 + ((j - 4) & 3)]; }
        for (int i = gt; i < 2 * 20; i += NGT) { const int l = i / 20, j = i % 20; WRB[l * 32 + j] = j < 4 ? A.in[I_RBG][l * 4 + j] : A.in[I_RBE][l * 16 + (j - 4)]; }
    }
}


__device__ __forceinline__ void route_prep(Ctx& F, const float* norm_ffn) {
    const float* mod = (const float*)(F.ws + WS_MOD);
    const float* WR = (const float*)(F.ws + WS_WR); const float* WRB = (const float*)(F.ws + WS_WR + 512 * 1024);
    bf16_t* WF = (bf16_t*)(F.ws + WS_WF); float* B2 = (float*)(F.ws + WS_WF + 768 * 1024);
    const int gt = F.bx * NTHR + F.tid, NGT = F.G * NTHR;
    for (int i = gt; i < 2 * 2 * 64 * 64; i += NGT) {
        const int lane = i & 63, ks = (i >> 6) & 63, b = (i >> 12) & 1, l = i >> 13;
        const int n = lane & 31, k0 = 16 * ks + 8 * (lane >> 5);
        unsigned hiw[4], low[4];
#pragma unroll
        for (int j2 = 0; j2 < 4; ++j2) {
            float v[2];
#pragma unroll
            for (int e = 0; e < 2; ++e) { const int k = k0 + 2 * j2 + e;
                const float gs = norm_ffn[l * D + k] * (1.0f + mod[(l * 2 + b) * 6144 + 4 * D + k]);
                v[e] = n < 20 ? gs * WR[((size_t)l * D + k) * 20 + n] : 0.f; }
            const unsigned h0 = f2bf(v[0]), h1 = f2bf(v[1]);
            hiw[j2] = h0 | (h1 << 16);
            low[j2] = pk2(v[0] - bf2f((unsigned short)h0), v[1] - bf2f((unsigned short)h1));
        }
        const size_t o = ((size_t)((l * 2 + b) * 2) * 64 + ks) * 64 + lane;
        *(u32x4*)(WF + o * 8) = (u32x4){hiw[0], hiw[1], hiw[2], hiw[3]};
        *(u32x4*)(WF + (o + 64 * 64) * 8) = (u32x4){low[0], low[1], low[2], low[3]};
    }
    const int gw = F.bx * NWAVES + F.wave, NGW = F.G * NWAVES;
    for (int i = gw; i < 2 * 2 * 20; i += NGW) {
        const int n = i % 20, lb = i / 20, l = lb >> 1; float s = 0.f;
        for (int k = F.lane; k < D; k += 64) s += mod[lb * 6144 + 3 * D + k] * WR[((size_t)l * D + k) * 20 + n];
        s = wave_sum(s);
        if (F.lane == 0) B2[lb * 32 + n] = s + WRB[l * 32 + n];
    }
}

template <bool ADDY> __device__ __forceinline__ void norm_rows(Ctx& F, const float* src, const float* gamma, const float* sh, const float* sc, bf16_t* dst, const bf16_t* Y = nullptr, const bf16_t* Yb = nullptr, bf16_t* xwb = nullptr) {
    const int gw = F.bx * NWAVES + F.wave, NGW = F.G * NWAVES;
    f32x4 gs[4], shv[4]; int curb = -1;
    for (int m = gw; m < T; m += NGW) {
        const int b = m >> 14;
        if (b != curb) { curb = b;
#pragma unroll
            for (int j = 0; j < 4; ++j) { const int k = 4 * F.lane + 256 * j; const f32x4 g = *(const f32x4*)(gamma + k), s = *(const f32x4*)(sc + b * 6144 + k); gs[j] = g * (s + 1.0f); shv[j] = *(const f32x4*)(sh + b * 6144 + k); } }
        const f32x4* xr = (const f32x4*)(src + (size_t)m * D) + F.lane;
        f32x4 v[4]; float ss = 0.f;
        u32x2 yv[4], y2v[4];
#pragma unroll
        for (int j = 0; j < 4; ++j) { v[j] = __builtin_nontemporal_load(xr + 64 * j);
            if constexpr (ADDY) { yv[j] = __builtin_nontemporal_load((const u32x2*)(Y + (size_t)m * D) + F.lane + 64 * j); y2v[j] = __builtin_nontemporal_load((const u32x2*)(Yb + (size_t)m * D) + F.lane + 64 * j); } }
#pragma unroll
        for (int j = 0; j < 4; ++j) {
            if constexpr (ADDY) { const u32x2 y = yv[j], y2 = y2v[j];
                v[j] = (v[j] + (f32x4){bflo(y.x), bfhi(y.x), bflo(y.y), bfhi(y.y)}) + (f32x4){bflo(y2.x), bfhi(y2.x), bflo(y2.y), bfhi(y2.y)}; __builtin_nontemporal_store((u32x2){pk2(v[j].x, v[j].y), pk2(v[j].z, v[j].w)}, (u32x2*)(xwb + (size_t)m * D) + F.lane + 64 * j); }
            ss += (v[j].x * v[j].x + v[j].y * v[j].y) + (v[j].z * v[j].z + v[j].w * v[j].w); }
        const float r = 1.0f / sqrtf(wave_sum(ss) * (1.0f / D) + EPS);
        u32x2* o8 = (u32x2*)(dst + (size_t)m * D) + F.lane;
#pragma unroll
        for (int j = 0; j < 4; ++j) { const f32x4 h = v[j] * r * gs[j] + shv[j]; o8[64 * j] = (u32x2){pk2(h.x, h.y), pk2(h.z, h.w)}; }
    }
}
__device__ __forceinline__ void final_norm(Ctx& F, const bf16_t* xr_, float* dst_, const float* gamma, const float oscale, const bf16_t* Y, const bf16_t* Yb) {
    const int gw = F.bx * NWAVES + F.wave, NGW = F.G * NWAVES;
    f32x4 gs[4];
#pragma unroll
    for (int j = 0; j < 4; ++j) gs[j] = *(const f32x4*)(gamma + 4 * F.lane + 256 * j) * oscale;
    for (int m = gw; m < T; m += NGW) {
        const u32x2* xr = (const u32x2*)(xr_ + (size_t)m * D) + F.lane;
        f32x4 v[4]; float ss = 0.f;
#pragma unroll
        for (int j = 0; j < 4; ++j) { { const u32x2 xb = __builtin_nontemporal_load(xr + 64 * j); v[j] = (f32x4){bflo(xb.x), bfhi(xb.x), bflo(xb.y), bfhi(xb.y)}; } const u32x2 y = __builtin_nontemporal_load((const u32x2*)(Y + (size_t)m * D) + F.lane + 64 * j), y2 = __builtin_nontemporal_load((const u32x2*)(Yb + (size_t)m * D) + F.lane + 64 * j);
            v[j] = (v[j] + (f32x4){bflo(y.x), bfhi(y.x), bflo(y.y), bfhi(y.y)}) + (f32x4){bflo(y2.x), bfhi(y2.x), bflo(y2.y), bfhi(y2.y)};
            ss += (v[j].x * v[j].x + v[j].y * v[j].y) + (v[j].z * v[j].z + v[j].w * v[j].w); }
        const float r = 1.0f / sqrtf(wave_sum(ss) * (1.0f / D) + EPS);
        f32x4* dr = (f32x4*)(dst_ + (size_t)m * D) + F.lane;
#pragma unroll
        for (int j = 0; j < 4; ++j) __builtin_nontemporal_store(v[j] * r * gs[j], dr + 64 * j);
    }
}

__device__ __forceinline__ s16x4 vtr(const LAS unsigned char* p) { typedef short v4i16_t __attribute__((ext_vector_type(4))); return __builtin_bit_cast(s16x4, __builtin_amdgcn_ds_read_tr16_b64_v4i16((LAS v4i16_t*)p)); }
__device__ __forceinline__ void attn_load(Ctx& F, int bh, int blk, const bf16_t* Q, const bf16_t* Kk, const bf16_t* V, u32x4 (&kpre)[6], u32x4 (&vpre)[6]) {
    const int head = bh % NH, grp = head / 5, shift = 2 * grp, L = SEQ >> shift;
    const int row0 = blk * 256, seg = row0 / L, i0 = row0 - seg * L;
    const size_t hbase = ((size_t)bh * SEQ + (size_t)seg * L) * 64;
    const bf16_t* Kh = Kk + hbase; const bf16_t* Vh = V + hbase;
#pragma unroll
    for (int pass = 0; pass < 6; ++pass) {
        const int idx = pass * NTHR + F.tid, row = idx >> 3, ch = idx & 7;
        int i = i0 - 64 + row; i = i < 0 ? 0 : (i > L - 1 ? L - 1 : i);
        kpre[pass] = __builtin_nontemporal_load((const u32x4*)(Kh + (size_t)i * 64 + ch * 8)); vpre[pass] = __builtin_nontemporal_load((const u32x4*)(Vh + (size_t)i * 64 + ch * 8));
    }
}
__device__ __forceinline__ void attn_loadq(Ctx& F, int bh, int blk, const bf16_t* Q, bf16x8 (&qf)[4]) {
    const int head = bh % NH, grp = head / 5, shift = 2 * grp, L = SEQ >> shift;
    const int row0 = blk * 256, seg = row0 / L, i0 = row0 - seg * L;
    const bf16_t* Qh = Q + ((size_t)bh * SEQ + (size_t)seg * L) * 64;
    const int qi = i0 + 32 * F.wave + (F.lane & 31);
#pragma unroll
    for (int ks = 0; ks < 4; ++ks) qf[ks] = *(const bf16x8*)(Qh + (size_t)qi * 64 + 16 * ks + 8 * (F.lane >> 5));
}
__device__ __forceinline__ void attn_stage(Ctx& F, const u32x4 (&kpre)[6], const u32x4 (&vpre)[6]) {
    LAS unsigned char* KL = F.lds; LAS unsigned char* VL = F.lds + 49152;
#pragma unroll
    for (int pass = 0; pass < 6; ++pass) {
        const int idx = pass * NTHR + F.tid, row = idx >> 3, ch = idx & 7;
        *(LAS u32x4*)(KL + row * 128 + ((ch ^ ((row >> 1) & 7)) << 4)) = kpre[pass];
        *(LAS u32x4*)(VL + row * 128 + ((((ch >> 2) ^ ((row >> 1) & 1))) << 6) + (ch & 3) * 16) = vpre[pass];
    }
}
__device__ __forceinline__ void attn_compute(Ctx& F, int bh, int blk, const bf16x8 (&qf)[4], bf16_t* O, float* LSE) {
    const int head = bh % NH, b = bh / NH, grp = head / 5, shift = 2 * grp, L = SEQ >> shift;
    const int row0 = blk * 256, seg = row0 / L, i0 = row0 - seg * L;
    LAS unsigned char* KL = F.lds; LAS unsigned char* VL = F.lds + 49152;
    const int w = F.wave, r32 = F.lane & 31, hi = F.lane >> 5;
    const int qi = i0 + 32 * w + r32;
    f32x16 st[5];
#pragma unroll
    for (int j = 0; j < 5; ++j) {
        st[j] = (f32x16){0.f, 0.f, 0.f, 0.f, 0.f, 0.f, 0.f, 0.f, 0.f, 0.f, 0.f, 0.f, 0.f, 0.f, 0.f, 0.f};
        const int row = 32 * w + 32 * j + r32;
#pragma unroll
        for (int ks = 0; ks < 4; ++ks) {
            const bf16x8 kf = *(const LAS bf16x8*)(KL + row * 128 + (((2 * ks + hi) ^ ((row >> 1) & 7)) << 4));
            st[j] = __builtin_amdgcn_mfma_f32_32x32x16_bf16(kf, qf[ks], st[j], 0, 0, 0);
        }
    }
    float mx = -INFINITY;
    if ((i0 < 64) | (i0 + 320 > L)) {
#pragma unroll
        for (int j = 0; j < 5; ++j)
#pragma unroll
            for (int r = 0; r < 16; ++r) {
                const int cr = crow(r, hi), ki = i0 + 32 * w - 64 + 32 * j + cr;
                bool ok = (ki >= 0) && (ki < L);
                if (j == 0) ok = ok && (cr >= r32);
                if (j == 4) ok = ok && (cr <= r32);
                st[j][r] = ok ? st[j][r] : -INFINITY;
            }
    } else {
#pragma unroll
        for (int r = 0; r < 16; ++r) { const int cr = crow(r, hi); st[0][r] = (cr >= r32) ? st[0][r] : -INFINITY; st[4][r] = (cr <= r32) ? st[4][r] : -INFINITY; }
    }
#pragma unroll
    for (int j = 0; j < 5; ++j)
#pragma unroll
        for (int r = 0; r < 16; ++r) mx = fmaxf(mx, st[j][r]);
    mx = fmaxf(mx, __shfl_xor(mx, 32));
    float sum = 0.f;
#pragma unroll
    for (int j = 0; j < 5; ++j)
#pragma unroll
        for (int r = 0; r < 16; ++r) { const float p = __builtin_amdgcn_exp2f(st[j][r] - mx); st[j][r] = p; sum += p; }
    sum += __shfl_xor(sum, 32);
    f32x16 o[2];
    o[0] = (f32x16){0.f, 0.f, 0.f, 0.f, 0.f, 0.f, 0.f, 0.f, 0.f, 0.f, 0.f, 0.f, 0.f, 0.f, 0.f, 0.f}; o[1] = o[0];
    const int G4 = F.lane >> 4, li = F.lane & 15, qq = li >> 2, pp = li & 3;
#pragma unroll
    for (int j = 0; j < 5; ++j)
#pragma unroll
        for (int s = 0; s < 2; ++s) {
            u32x4 pw; pw.x = cvt_pk_bf16(st[j][8 * s + 0], st[j][8 * s + 1]); pw.y = cvt_pk_bf16(st[j][8 * s + 2], st[j][8 * s + 3]);
            pw.z = cvt_pk_bf16(st[j][8 * s + 4], st[j][8 * s + 5]); pw.w = cvt_pk_bf16(st[j][8 * s + 6], st[j][8 * s + 7]);
            const bf16x8 pf = __builtin_bit_cast(bf16x8, pw);
#pragma unroll
            for (int dt = 0; dt < 2; ++dt) {
                const int rowA = 32 * w + 32 * j + 16 * s + 4 * hi + qq, rowB = rowA + 8;
                const int cb = (16 * (G4 & 1) + 4 * pp) * 2;
                const s16x4 lo = vtr(VL + rowA * 128 + ((dt ^ ((rowA >> 1) & 1)) << 6) + cb);
                const s16x4 hh = vtr(VL + rowB * 128 + ((dt ^ ((rowB >> 1) & 1)) << 6) + cb);
                const bf16x8 vf = (bf16x8){lo[0], lo[1], lo[2], lo[3], hh[0], hh[1], hh[2], hh[3]};
                o[dt] = __builtin_amdgcn_mfma_f32_32x32x16_bf16(vf, pf, o[dt], 0, 0, 0);
            }
        }
    const float inv = 1.0f / sum;
    const size_t tok = (size_t)b * SEQ + ((size_t)qi << shift) + seg;
    LAS unsigned char* stg = F.lds + 98304 + w * 4096;
#pragma unroll
    for (int dt = 0; dt < 2; ++dt)
#pragma unroll
        for (int g = 0; g < 4; ++g) {
            u32x2 w2; w2.x = cvt_pk_bf16(o[dt][4 * g + 0] * inv, o[dt][4 * g + 1] * inv); w2.y = cvt_pk_bf16(o[dt][4 * g + 2] * inv, o[dt][4 * g + 3] * inv);
            *(LAS u32x2*)(stg + r32 * 128 + (((4 * dt + g) ^ (r32 & 7)) << 4) + 8 * hi) = w2;
        }
#pragma unroll
    for (int i = 0; i < 4; ++i) {
        const int row = i * 8 + (F.lane >> 3), c16 = F.lane & 7;
        const u32x4 v = *(const LAS u32x4*)(stg + row * 128 + ((c16 ^ (row & 7)) << 4));
        const unsigned tk = (unsigned)(b * SEQ + ((i0 + 32 * w + row) << shift) + seg);
        *(u32x4*)((char*)O + (size_t)(head * 128) + (tk * (unsigned)(D * 2) + (unsigned)(c16 * 16))) = v;
    }
    if (hi == 0) LSE[tok * 16 + head] = (mx + __builtin_amdgcn_logf(sum)) * 0.6931471805599453f;
}
__device__ __forceinline__ void attn_phase(Ctx& F) {
    const bf16_t* Q = (const bf16_t*)(F.ws + WS_Q); const bf16_t* Kk = (const bf16_t*)(F.ws + WS_K); const bf16_t* V = (const bf16_t*)(F.ws + WS_V);
    bf16_t* O = (bf16_t*)(F.ws + WS_O); float* LSE = (float*)(F.ws + WS_LSE);
    const int nunits = BATCH * NH * 64;
    u32x4 kpre[6], vpre[6]; bf16x8 qf[4];
    int u = F.bx;
    if (u < nunits) attn_load(F, u >> 6, u & 63, Q, Kk, V, kpre, vpre);
    for (; u < nunits; u += F.G) {
        attn_loadq(F, u >> 6, u & 63, Q, qf);
        __syncthreads();
        attn_stage(F, kpre, vpre);
        __syncthreads();
        if (u + F.G < nunits) attn_load(F, (u + F.G) >> 6, (u + F.G) & 63, Q, Kk, V, kpre, vpre);
        attn_compute(F, u >> 6, u & 63, qf, O, LSE);
    }
    const int gt = F.bx * NTHR + F.tid, NGT = F.G * NTHR;
    for (int i = gt; i < T * 8; i += NGT) *(u32x4*)(O + (size_t)(i >> 3) * D + AW + (i & 7) * 8) = (u32x4){0u, 0u, 0u, 0u};
}
__device__ __forceinline__ void combine_phase(Ctx& F) {
    bf16_t* O = (bf16_t*)(F.ws + WS_O); const float* LSE = (const float*)(F.ws + WS_LSE);
    const int gt = F.bx * NTHR + F.tid, NGT = F.G * NTHR;
    for (int i = gt; i < T * 120; i += NGT) {
        const int tok = i / 120, rem = i - tok * 120, head = rem >> 3, ch = rem & 7, hg = head % 5;
        const float l0 = LSE[tok * 16 + hg], l1 = LSE[tok * 16 + hg + 5], l2 = LSE[tok * 16 + hg + 10], lm = LSE[tok * 16 + head];
        const float mx = fmaxf(l0, fmaxf(l1, l2));
        const float a = __expf(lm - mx) / (__expf(l0 - mx) + __expf(l1 - mx) + __expf(l2 - mx));
        u32x4* p = (u32x4*)(O + (size_t)tok * D + head * 64 + ch * 8);
        u32x4 v = *p;
        v.x = pk2(bflo(v.x) * a, bfhi(v.x) * a); v.y = pk2(bflo(v.y) * a, bfhi(v.y) * a); v.z = pk2(bflo(v.z) * a, bfhi(v.z) * a); v.w = pk2(bflo(v.w) * a, bfhi(v.w) * a);
        *p = v;
    }
}

template <bool XBF> __device__ __forceinline__ void route_phase(Ctx& F, int layer, const float* gamma_all, const void* XRv, const bf16_t* Yadd, int alias = 0) {
    const float* XR = (const float*)XRv; const bf16_t* XRb = (const bf16_t*)XRv;
    bf16_t* H = (bf16_t*)(F.ws + WS_H);
    const float* mod = (const float*)(F.ws + WS_MOD) + layer * 2 * 6144;
    const float* gamma = gamma_all + layer * D;
    unsigned* gcnt = (unsigned*)(F.ws + WS_CTL) + CW_CNT + layer * 32 + alias * 64;
    const size_t lbase = alias ? (WS_BIG + 244 * MiB) : WS_LIST;
    int* ltok = (int*)(F.ws + lbase); float* lwa = (float*)(F.ws + lbase + 3 * MiB); float* lwb = (float*)(F.ws + lbase + 6 * MiB);
    LAS float* PL = (LAS float*)F.lds;
    LAS float* PS = (LAS float*)(F.lds + 34816);
    LAS float* GS = (LAS float*)(F.lds + 36864); LAS float* SH = (LAS float*)(F.lds + 40960);
    LAS int* TB = (LAS int*)(F.lds + 45056); LAS float* TWA = (LAS float*)(F.lds + 45568); LAS float* TWB = (LAS float*)(F.lds + 46080);
    LAS int* TRK = (LAS int*)(F.lds + 46592); LAS int* CNT = (LAS int*)(F.lds + 47104); LAS int* BASE = (LAS int*)(F.lds + 47232);
    const int w = F.wave, r32 = F.lane & 31, hi = F.lane >> 5;
    for (int rb = F.bx; rb < T / 128; rb += F.G) {
        const int b = (rb * 128) >> 14;
        __syncthreads();
        for (int k = F.tid; k < D; k += NTHR) { GS[k] = gamma[k] * (1.0f + mod[b * 6144 + 4 * D + k]); SH[k] = mod[b * 6144 + 3 * D + k]; }
        if (F.tid < 32) CNT[F.tid] = 0;
        const bf16_t* WFp = (const bf16_t*)(F.ws + WS_WF) + ((size_t)((layer * 2 + b) * 2) * 64 + 8 * w) * 64 * 8 + F.lane * 8;
        const float* B2 = (const float*)(F.ws + WS_WF + 768 * 1024) + (layer * 2 + b) * 32;
        bf16x8 wfh[8], wfl[8];
#pragma unroll
        for (int ks = 0; ks < 8; ++ks) { wfh[ks] = *(const bf16x8*)(WFp + (size_t)ks * 64 * 8); wfl[ks] = *(const bf16x8*)(WFp + (size_t)(64 + ks) * 64 * 8); }
        for (int it = 0; it < 4; ++it) {
            const int row = rb * 128 + it * 32 + r32;
            const float* xp = XR + (size_t)row * D + 128 * w + 8 * hi;
            f32x4 xv[8][2]; float ss = 0.f;
            const bf16_t* yp = Yadd + (size_t)row * D + 128 * w + 8 * hi;
            u32x4 yraw[8], xbraw[8];
#pragma unroll
            for (int ks = 0; ks < 8; ++ks) { yraw[ks] = *(const u32x4*)(yp + 16 * ks);
                if constexpr (XBF) xbraw[ks] = *(const u32x4*)(XRb + (size_t)row * D + 128 * w + 8 * hi + 16 * ks);
                else { xv[ks][0] = *(const f32x4*)(xp + 16 * ks); xv[ks][1] = *(const f32x4*)(xp + 16 * ks + 4); } }
            __builtin_amdgcn_sched_barrier(0);
#pragma unroll
            for (int ks = 0; ks < 8; ++ks) { const u32x4 y = yraw[ks];
                if constexpr (XBF) { const u32x4 xb = xbraw[ks];
                    xv[ks][0] = (f32x4){bflo(xb.x), bfhi(xb.x), bflo(xb.y), bfhi(xb.y)} + (f32x4){bflo(y.x), bfhi(y.x), bflo(y.y), bfhi(y.y)}; xv[ks][1] = (f32x4){bflo(xb.z), bfhi(xb.z), bflo(xb.w), bfhi(xb.w)} + (f32x4){bflo(y.z), bfhi(y.z), bflo(y.w), bfhi(y.w)}; }
                else { xv[ks][0] = xv[ks][0] + (f32x4){bflo(y.x), bfhi(y.x), bflo(y.y), bfhi(y.y)}; xv[ks][1] = xv[ks][1] + (f32x4){bflo(y.z), bfhi(y.z), bflo(y.w), bfhi(y.w)}; } }
            f32x16 acc = (f32x16){0.f, 0.f, 0.f, 0.f, 0.f, 0.f, 0.f, 0.f, 0.f, 0.f, 0.f, 0.f, 0.f, 0.f, 0.f, 0.f};
#pragma unroll
            for (int ks = 0; ks < 8; ++ks) {
                unsigned hw[4], lw[4];
#pragma unroll
                for (int q = 0; q < 2; ++q)
#pragma unroll
                    for (int e = 0; e < 2; ++e) { const float v0 = xv[ks][q][2 * e], v1 = xv[ks][q][2 * e + 1];
                        ss += v0 * v0 + v1 * v1;
                        const unsigned h0 = f2bf(v0), h1 = f2bf(v1);
                        hw[q * 2 + e] = h0 | (h1 << 16);
                        lw[q * 2 + e] = pk2(v0 - __builtin_bit_cast(float, h0 << 16), v1 - __builtin_bit_cast(float, h1 << 16)); }
                const bf16x8 ah = __builtin_bit_cast(bf16x8, (u32x4){hw[0], hw[1], hw[2], hw[3]}), al = __builtin_bit_cast(bf16x8, (u32x4){lw[0], lw[1], lw[2], lw[3]});
                acc = __builtin_amdgcn_mfma_f32_32x32x16_bf16(ah, wfh[ks], acc, 0, 0, 0);
                acc = __builtin_amdgcn_mfma_f32_32x32x16_bf16(al, wfh[ks], acc, 0, 0, 0);
                acc = __builtin_amdgcn_mfma_f32_32x32x16_bf16(ah, wfl[ks], acc, 0, 0, 0);
            }
            ss += __shfl_xor(ss, 32);
            if (hi == 0) PS[w * 32 + r32] = ss;
#pragma unroll
            for (int r = 0; r < 16; ++r) PL[(w * 32 + crow(r, hi)) * 33 + r32] = acc[r];
            __syncthreads();
            float st = 0.f;
#pragma unroll
            for (int ww = 0; ww < 8; ++ww) st += PS[ww * 32 + r32];
            const float r = 1.0f / sqrtf(st * (1.0f / D) + EPS);
            bf16_t* hp = H + (size_t)row * D + 128 * w + 8 * hi;
#pragma unroll
            for (int ks = 0; ks < 8; ++ks) {
                const int k = 128 * w + 16 * ks + 8 * hi;
                const f32x4 g0 = *(const LAS f32x4*)(GS + k), g1 = *(const LAS f32x4*)(GS + k + 4), s0 = *(const LAS f32x4*)(SH + k), s1 = *(const LAS f32x4*)(SH + k + 4);
                const f32x4 h0 = xv[ks][0] * r * g0 + s0, h1 = xv[ks][1] * r * g1 + s1;
                *(u32x4*)(hp + 16 * ks) = (u32x4){pk2(h0[0], h0[1]), pk2(h0[2], h0[3]), pk2(h1[0], h1[1]), pk2(h1[2], h1[3])};
            }
            if (F.tid < 32) {
                float a[20];
#pragma unroll
                for (int j = 0; j < 20; ++j) { float s = 0.f;
#pragma unroll
                    for (int ww = 0; ww < 8; ++ww) s += PL[(ww * 32 + F.tid) * 33 + j];
                    a[j] = r * s + B2[j]; }
                int g = 0; float gm = a[0];
#pragma unroll
                for (int j = 1; j < 4; ++j) if (a[j] > gm) { gm = a[j]; g = j; }
                float den = 0.f;
#pragma unroll
                for (int j = 0; j < 4; ++j) den += __expf(a[j] - gm);
                const float gval = 1.0f / den;
                float el[4];
#pragma unroll
                for (int e = 0; e < 4; ++e) el[e] = g == 0 ? a[4 + e] : (g == 1 ? a[8 + e] : (g == 2 ? a[12 + e] : a[16 + e]));
                int i1 = 0; float v1 = el[0];
#pragma unroll
                for (int e = 1; e < 4; ++e) if (el[e] > v1) { v1 = el[e]; i1 = e; }
                int i2 = -1; float v2 = -INFINITY;
#pragma unroll
                for (int e = 0; e < 4; ++e) if (e != i1 && el[e] > v2) { v2 = el[e]; i2 = e; }
                const float p1 = 1.0f / (1.0f + __expf(v2 - v1)), p2 = 1.0f - p1;
                const float w1 = gval * p1, w2 = gval * p2;
                const int pa = i1 < i2 ? i1 : i2, pb = i1 < i2 ? i2 : i1;
                const int pair = pa == 0 ? pb - 1 : (pa == 1 ? pb + 1 : 5);
                const int lrow = it * 32 + F.tid;
                TB[lrow] = g * 6 + pair; TWA[lrow] = (i1 == pa) ? w1 : w2; TWB[lrow] = (i1 == pa) ? w2 : w1;
            }
            __syncthreads();
        }
        if (F.tid < 128) TRK[F.tid] = atomicAdd((int*)(CNT + TB[F.tid]), 1);
        __syncthreads();
        if (F.tid < NBUCK) BASE[F.tid] = (int)__hip_atomic_fetch_add(gcnt + F.tid, (unsigned)CNT[F.tid], __ATOMIC_RELAXED, __HIP_MEMORY_SCOPE_AGENT);
        __syncthreads();
        if (F.tid < 128) { const int bk = TB[F.tid], pos = BASE[bk] + TRK[F.tid]; const size_t o = (size_t)bk * T + pos;
            ltok[o] = rb * 128 + F.tid; lwa[o] = TWA[F.tid]; lwb[o] = TWB[F.tid]; }
    }
}
__device__ __forceinline__ void gather_phase(Ctx& F, int layer) {
    moe_tab_build(F.lds, (const unsigned*)(F.ws + WS_CTL) + CW_CNT + layer * 32, F.tid);
    const MoeTab tab = moe_tab(F.lds);
    const bf16_t* H = (const bf16_t*)(F.ws + WS_H); bf16_t* HP = (bf16_t*)(F.ws + WS_HP); const int* ltok = (const int*)(F.ws + WS_LIST);
    const int gw = F.bx * NWAVES + F.wave, NGW = F.G * NWAVES, nrows = tab.ntiles * 256;
    for (int row = gw; row < nrows; row += NGW) {
        const int t = row >> 8, bk = tab.tileb(t), cnt = tab.cnt(bk); int idx = (t - tab.tpre(bk)) * 256 + (row & 255); idx = idx < cnt ? idx : cnt - 1;
        const int tok = ltok[(size_t)bk * T + idx];
        const u32x4* s = (const u32x4*)(H + (size_t)tok * D) + F.lane; u32x4* d = (u32x4*)(HP + (size_t)row * D) + F.lane;
        const u32x4 a = s[0], c = s[64]; d[0] = a; d[64] = c;
    }
}

__device__ __forceinline__ void gating_phase(Ctx& F, bf16_t* U, bf16_t* Uout, const bf16_t* V, const float* stats, const float* Ws, const float* gain, const float* bs) {
    LAS unsigned char* VT = F.lds; LAS unsigned char* WL = F.lds + 65536;
    LAS unsigned char* WSL = F.lds + 98304;
    LAS float* MUb = (LAS float*)(F.lds + TOKL_OFF);
    LAS float* RSb = (LAS float*)(F.lds + TOKL_OFF + 1024); LAS float* TP = (LAS float*)(F.lds + TOKL_OFF + 2048);
    const int nunits = 256 * NGRP, g = F.bx & 7;
    const int w = F.wave, r32 = F.lane & 31, hi = F.lane >> 5, G4 = F.lane >> 4, li = F.lane & 15, qq = li >> 2, pp = li & 3;
    const int p_ = F.tid >> 2, qp = F.tid & 3;
    { const f32x4* wp = (const f32x4*)(Ws + ((size_t)g * 128 + p_) * 128 + 32 * qp);
#pragma unroll
      for (int i = 0; i < 4; ++i) { const f32x4 w0 = wp[2 * i], w1 = wp[2 * i + 1];
          *(LAS u32x4*)(WSL + p_ * 256 + (((4 * qp + i) ^ (p_ & 15)) << 4)) = (u32x4){pk2(w0[0], w0[1]), pk2(w0[2], w0[3]), pk2(w1[0], w1[1]), pk2(w1[2], w1[3])}; } }
    const unsigned toff = (unsigned)(((F.tid >> 5) * GH + (F.tid & 31) * 8) * 2);
    constexpr size_t PSTEP = (size_t)16 * GH * 2;
    const unsigned soff = (unsigned)((p_ * 64 + 16 * qp) * 4);
    u32x4 vpre[8]; f32x4 spre[2];
    int u = F.bx;
    __syncthreads();
    if (u < nunits) { const int n = u >> 3;
        { const char* Vb = (const char*)V + ((size_t)n * 128 * GH + g * 256) * 2;
#pragma unroll
          for (int pass = 0; pass < 8; ++pass) vpre[pass] = __builtin_nontemporal_load((const u32x4*)(Vb + pass * PSTEP + toff)); }
        const f32x4* sp = (const f32x4*)((const char*)stats + (size_t)n * 128 * 256 + soff);
        spre[0] = sp[0] + sp[2]; spre[1] = sp[1] + sp[3];
        float s1 = (spre[0].x + spre[0].z) + (spre[1].x + spre[1].z), s2 = (spre[0].y + spre[0].w) + (spre[1].y + spre[1].w);
        s1 += __shfl_xor(s1, 1); s1 += __shfl_xor(s1, 2); s2 += __shfl_xor(s2, 1); s2 += __shfl_xor(s2, 2);
        const float mu = s1 * (1.0f / GH), var = fmaxf(s2 * (1.0f / GH) - mu * mu, 0.f);
        if (qp == 0) { MUb[p_] = mu; RSb[p_] = 1.0f / sqrtf(var + EPS); }
    }
    int par = 0;
    for (; u < nunits; u += F.G, par ^= 1) {
        const int n = u >> 3; const bool has_next = (u + F.G) < nunits; const int nn = (u + F.G) >> 3;
        LAS float* MU = MUb + par * 128; LAS float* RS = RSb + par * 128;
#pragma unroll
        for (int pass = 0; pass < 8; ++pass) { const int idx = pass * NTHR + F.tid, q = idx >> 5, c16 = idx & 31;
            *(LAS u32x4*)(VT + q * 512 + ((((c16 >> 2) ^ (q & 3))) << 6) + (c16 & 3) * 16) = vpre[pass]; }
        __syncthreads();
        { float t = 0.f;
#pragma unroll
          for (int i = 0; i < 4; ++i) {
              const int q0 = 32 * qp + 8 * i;
              const u32x4 wq = *(const LAS u32x4*)(WSL + p_ * 256 + (((4 * qp + i) ^ (p_ & 15)) << 4));
              float wv[8];
              wv[0] = bflo(wq.x) * RS[q0 + 0]; wv[1] = bfhi(wq.x) * RS[q0 + 1]; wv[2] = bflo(wq.y) * RS[q0 + 2]; wv[3] = bfhi(wq.y) * RS[q0 + 3];
              wv[4] = bflo(wq.z) * RS[q0 + 4]; wv[5] = bfhi(wq.z) * RS[q0 + 5]; wv[6] = bflo(wq.w) * RS[q0 + 6]; wv[7] = bfhi(wq.w) * RS[q0 + 7];
#pragma unroll
              for (int j = 0; j < 8; ++j) t += wv[j] * MU[q0 + j];
              const int c = 4 * qp + i;
              *(LAS u32x4*)(WL + p_ * 256 + ((c ^ (p_ & 15)) << 4)) = (u32x4){pk2(wv[0], wv[1]), pk2(wv[2], wv[3]), pk2(wv[4], wv[5]), pk2(wv[6], wv[7])};
          }
          t += __shfl_xor(t, 1); t += __shfl_xor(t, 2);
          if (qp == 0) TP[p_] = t; }
        u32x4 ureg[8];
        { const char* Ub = (const char*)U + ((size_t)n * 128 * GH + g * 256) * 2;
#pragma unroll
          for (int pass = 0; pass < 8; ++pass) ureg[pass] = __builtin_nontemporal_load((const u32x4*)(Ub + pass * PSTEP + toff)); }
        if (has_next) {
            { const char* Vb = (const char*)V + ((size_t)nn * 128 * GH + g * 256) * 2;
#pragma unroll
              for (int pass = 0; pass < 8; ++pass) vpre[pass] = __builtin_nontemporal_load((const u32x4*)(Vb + pass * PSTEP + toff)); }
        }
        __syncthreads();
        f32x16 acc[4];
#pragma unroll
        for (int nt = 0; nt < 4; ++nt) acc[nt] = (f32x16){0.f, 0.f, 0.f, 0.f, 0.f, 0.f, 0.f, 0.f, 0.f, 0.f, 0.f, 0.f, 0.f, 0.f, 0.f, 0.f};
#pragma unroll
        for (int ks = 0; ks < 8; ++ks) {
            const int cbyte = (32 * w + 16 * (G4 & 1) + 4 * pp) * 2;
            const int rA = 16 * ks + 8 * hi + qq, rB = rA + 4;
            const s16x4 lo = vtr(VT + rA * 512 + ((((cbyte >> 6) ^ (rA & 3))) << 6) + (cbyte & 63));
            const s16x4 hh = vtr(VT + rB * 512 + ((((cbyte >> 6) ^ (rB & 3))) << 6) + (cbyte & 63));
            const bf16x8 af = (bf16x8){lo[0], lo[1], lo[2], lo[3], hh[0], hh[1], hh[2], hh[3]};
#pragma unroll
            for (int nt = 0; nt < 4; ++nt) {
                const int p = 32 * nt + r32;
                const bf16x8 bfr = *(const LAS bf16x8*)(WL + p * 256 + (((2 * ks + hi) ^ (p & 15)) << 4));
                acc[nt] = __builtin_amdgcn_mfma_f32_32x32x16_bf16(af, bfr, acc[nt], 0, 0, 0);
            }
        }
        if (has_next) { unsigned so = soff; asm volatile("" : "+v"(so));
            const f32x4* sp = (const f32x4*)((const char*)stats + (size_t)nn * 128 * 256 + so); spre[0] = sp[0] + sp[2]; spre[1] = sp[1] + sp[3]; }
        __syncthreads();
#pragma unroll
        for (int nt = 0; nt < 4; ++nt) {
            const int p = 32 * nt + r32; const float tp = TP[p], bp = bs[g * 128 + p];
#pragma unroll
            for (int gq = 0; gq < 4; ++gq) {
                const int c = 32 * w + 8 * gq + 4 * hi; const f32x4 gnv = *(const f32x4*)(gain + g * 256 + c);
                float o[4];
#pragma unroll
                for (int j = 0; j < 4; ++j) o[j] = gnv[j] * (acc[nt][4 * gq + j] - tp) + bp;
                const int cb = c * 2;
                *(LAS u32x2*)(VT + p * 512 + ((((cb >> 4) ^ (p & 15))) << 4) + (cb & 15)) = (u32x2){pk2(o[0], o[1]), pk2(o[2], o[3])};
            }
        }
        if (has_next) {
            float s1 = (spre[0].x + spre[0].z) + (spre[1].x + spre[1].z), s2 = (spre[0].y + spre[0].w) + (spre[1].y + spre[1].w);
            s1 += __shfl_xor(s1, 1); s1 += __shfl_xor(s1, 2); s2 += __shfl_xor(s2, 1); s2 += __shfl_xor(s2, 2);
            const float mu = s1 * (1.0f / GH), var = fmaxf(s2 * (1.0f / GH) - mu * mu, 0.f);
            if (qp == 0) { MUb[(par ^ 1) * 128 + p_] = mu; RSb[(par ^ 1) * 128 + p_] = 1.0f / sqrtf(var + EPS); }
        }
        __syncthreads();
#pragma unroll
        for (int pass = 0; pass < 8; ++pass) {
            const int idx = pass * NTHR + F.tid, p = idx >> 5, c16 = idx & 31;
            const u32x4 vs = *(const LAS u32x4*)(VT + p * 512 + ((c16 ^ (p & 15)) << 4));
            const u32x4 uv = ureg[pass]; u32x4 o;
            o.x = pk2(bflo(uv.x) * bflo(vs.x), bfhi(uv.x) * bfhi(vs.x)); o.y = pk2(bflo(uv.y) * bflo(vs.y), bfhi(uv.y) * bfhi(vs.y));
            o.z = pk2(bflo(uv.z) * bflo(vs.z), bfhi(uv.z) * bfhi(vs.z)); o.w = pk2(bflo(uv.w) * bflo(vs.w), bfhi(uv.w) * bfhi(vs.w));
            *(u32x4*)((char*)Uout + ((size_t)n * 128 * GH + g * 256) * 2 + pass * PSTEP + toff) = o;
        }
        __syncthreads();
    }
}

__global__ void __launch_bounds__(NTHR, 2) mk_fwd(Args args) {
    extern __shared__ __attribute__((aligned(16))) unsigned char lds_[];
    Ctx F;
    F.lds = (LAS unsigned char*)lds_;
    F.wave = __builtin_amdgcn_readfirstlane((int)threadIdx.x >> 6); F.G = gridDim.x; F.bx = blockIdx.x;
#define REFRESH() do { F.lane = lane_now(); F.tid = F.wave * 64 + F.lane; } while (0)
    REFRESH();
    F.out = args.out; F.ws = args.ws;
    unsigned char* ws = args.ws;
    volatile LAS unsigned* MISC = (volatile LAS unsigned*)(F.lds + MISC_OFF);
    for (int u = F.tid; u < (LDS_BYTES - LDSCTL_OFF) / 4; u += NTHR) ((LAS unsigned*)(F.lds + LDSCTL_OFF))[u] = 0u;
    __syncthreads();
    const int lo = args.ph_lo, hi = args.ph_hi;
#if MK_PER_PHASE
#define GRID_BAR(k) do {} while (0)
#else
    cg::grid_group grid = cg::this_grid();
    XcdBarrier bar = xcd_barrier_post((unsigned*)(ws + WS_CTL) + CW_BAR, MISC + 8, F.wave);
    if (lo < 0) grid.sync();
#define GRID_BAR(k) do { xcd_barrier2(bar); REFRESH(); } while (0)
#endif
#define IN(k) (lo <= (k) && (k) < hi)
#ifndef PROBE_REP
#define PROBE_REP -1
#endif
#define NREP(k) (PROBE_REP == (k) ? 2 : 1)
#ifndef PROBE_A
#define PROBE_A -1
#endif
#ifndef PROBE_B
#define PROBE_B -1
#endif
#if PROBE_A >= 0
    unsigned long long* tsb = (unsigned long long*)(ws + WS_CTL + 512 * 1024);
    if (F.bx == 0 && F.tid == 0) tsb[0] = __builtin_amdgcn_s_memrealtime();
#define STAMP(k) do { if (F.bx == 0 && F.tid == 0) tsb[(k) + 1] = __builtin_amdgcn_s_memrealtime(); } while (0)
#else
#define STAMP(k) do {} while (0)
#endif
#define SEAM(k) do { if (IN(k) && IN((k) + 1)) { GRID_BAR(k); STAMP(k); } } while (0)
#define SEAM2(k) do { if (IN(k) && IN((k) + 2)) { GRID_BAR(k); STAMP(k); } } while (0)
    const float* mod = (const float*)(ws + WS_MOD);
    bf16_t* H = (bf16_t*)(ws + WS_H);
    float* XR = args.out;

    if (IN(0)) { for (int rep = 0; rep < NREP(0); ++rep) { p0_prep(F, args); __syncthreads(); } } SEAM(0);
#if !MK_PER_PHASE
    if (PROBE_REP == 100) { for (int i = 0; i < 10; ++i) xcd_barrier2(bar); }
#endif
    if (IN(1)) { for (int rep = 0; rep < NREP(1); ++rep) norm_rows<false>(F, args.in[I_X], args.in[I_NMIX], mod + 0 * D, mod + 1 * D, H); route_prep(F, args.in[I_NFFN]); } SEAM(1);
    if (IN(2)) {
        pg8::DenseOrder S; S.init(H, ws + WS_WQKV, T, NQKVP, D, F.G, F.bx);
        EpiQKV E{(bf16_t*)(ws + WS_Q), (bf16_t*)(ws + WS_K), (bf16_t*)(ws + WS_V), (const float*)(ws + WS_ROPE)};
        for (int rep = 0; rep < NREP(2); ++rep) pg8::gemm_phase<EpiQKV, pg8::DenseOrder>(F.lds, D, S, E, F.wave);
    } SEAM(2);
    if (IN(3)) { for (int rep = 0; rep < NREP(3); ++rep) attn_phase(F); } SEAM(3);
    if (IN(4)) { combine_phase(F); } SEAM(4);
    if (IN(5)) {
        pg8::DenseOrder S; S.init(ws + WS_O, ws + WS_WO, T, D, D, F.G, F.bx);
        EpiY E{(bf16_t*)(ws + WS_Y1), mod + 2 * D};
        for (int rep = 0; rep < NREP(5); ++rep) pg8::gemm_phase<EpiY, pg8::DenseOrder>(F.lds, D, S, E, F.wave);
    } SEAM(5);
#define MOE_LAYER(layer, pb) do { \
        const float* modl = mod + (layer) * 2 * 6144; \
        if (IN(pb)) { route_phase<(layer) == 1>(F, layer, args.in[I_NFFN], (layer) == 0 ? (const void*)args.in[I_X] : (const void*)(ws + WS_XRB), (const bf16_t*)(ws + ((layer) == 0 ? WS_Y1 : WS_Y3))); } SEAM2(pb); \
        if (IN((pb) + 2)) { \
            moe_tab_build(F.lds, (const unsigned*)(ws + WS_CTL) + CW_CNT + (layer) * 32, F.tid); \
            const MoeTab tab = moe_tab(F.lds); \
            MoeOrder S{(const char*)(ws + WS_H), (size_t)0, (const char*)(ws + WS_BGU), 0, layer, tab, tab.ntiles * 4, F.G, F.bx}; \
            S.fill_tokl((const int*)(ws + WS_LIST), F.tid); \
            EpiAct E{(bf16_t*)(ws + WS_ACT), (const float*)(ws + WS_LIST + 3 * MiB), (const float*)(ws + WS_LIST + 6 * MiB), tab}; \
            for (int rep = 0; rep < NREP((pb) + 2); ++rep) pg8::gemm_phase<EpiAct, MoeOrder>(F.lds, D, S, E, F.wave); \
            if ((layer) == 0) { const int lo_ = S.tail_lo();     \
                __syncthreads(); if (F.bx >= lo_) expert_items(F, args, 1, (F.bx - lo_) * NWAVES + F.wave, (F.G - lo_) * NWAVES); } \
        } SEAM((pb) + 2); \
        if (IN((pb) + 3)) { \
            moe_tab_build(F.lds, (const unsigned*)(ws + WS_CTL) + CW_CNT + (layer) * 32, F.tid); \
            const MoeTab tab = moe_tab(F.lds); \
            MoeOrder S{(const char*)(ws + WS_ACT), (size_t)256 * 512 * 2, (const char*)(ws + WS_BDP), 1, layer, tab, tab.ntiles * 4, F.G, F.bx}; \
            EpiDown E{(bf16_t*)(ws + ((layer) == 0 ? WS_Y : WS_Y4)), modl + 5 * D, (const int*)(ws + WS_LIST), tab}; \
            for (int rep = 0; rep < NREP((pb) + 3); ++rep) pg8::gemm_phase<EpiDown, MoeOrder>(F.lds, 512, S, E, F.wave); \
            if ((layer) == 0) { const int lo_ = S.tail_lo();     \
                __syncthreads(); if (F.bx >= lo_) gmlp_items(F, args, (F.bx - lo_) * NWAVES + F.wave, (F.G - lo_) * NWAVES); } \
        } SEAM((pb) + 3); \
    } while (0)
    MOE_LAYER(0, 6);
    if (IN(10)) { norm_rows<true>(F, args.in[I_X], args.in[I_NMIX] + D, mod + 2 * 6144 + 0 * D, mod + 2 * 6144 + 1 * D, H, (const bf16_t*)(ws + WS_Y1), (const bf16_t*)(ws + WS_Y), (bf16_t*)(ws + WS_XRB)); } SEAM(10);
    if (IN(11)) {
        pg8::DenseOrder S; S.init(H, ws + WS_WIN, T, FF, D, F.G, F.bx);
        EpiGelu<0> E{(bf16_t*)(ws + WS_U), (bf16_t*)(ws + WS_VV), (float*)(ws + WS_STATS)};
        if (PROBE_REP == 111) { EpiGelu<1> E1{(bf16_t*)(ws + WS_U), (bf16_t*)(ws + WS_VV), (float*)(ws + WS_STATS)}; pg8::gemm_phase<EpiGelu<1>, pg8::DenseOrder>(F.lds, D, S, E1, F.wave); }
        if (PROBE_REP == 112) { EpiGelu<2> E2{(bf16_t*)(ws + WS_U), (bf16_t*)(ws + WS_VV), (float*)(ws + WS_STATS)}; pg8::gemm_phase<EpiGelu<2>, pg8::DenseOrder>(F.lds, D, S, E2, F.wave); }
        for (int rep = 0; rep < NREP(11); ++rep) pg8::gemm_phase<EpiGelu<0>, pg8::DenseOrder>(F.lds, D, S, E, F.wave);
    } SEAM(11);
    if (IN(12)) {
        for (int rep = 0; rep < NREP(12); ++rep) gating_phase(F, (bf16_t*)(ws + WS_U), (bf16_t*)(ws + (rep == 0 ? WS_U : WS_VV)), (const bf16_t*)(ws + WS_VV), (const float*)(ws + WS_STATS), args.in[I_WS], args.in[I_VGAIN], args.in[I_BS]);
    } SEAM(12);
    if (IN(13)) {
        pg8::DenseOrder S; S.init(ws + WS_U, ws + WS_WO2, T, D, GH, F.G, F.bx);
        EpiY E{(bf16_t*)(ws + WS_Y3), mod + 2 * 6144 + 2 * D};
        for (int rep = 0; rep < NREP(13); ++rep) pg8::gemm_phase<EpiY, pg8::DenseOrder>(F.lds, GH, S, E, F.wave);
    } SEAM(13);
    MOE_LAYER(1, 14);
    if (IN(18)) { final_norm(F, (const bf16_t*)(ws + WS_XRB), XR, args.in[I_FNORM], 1.0f, (const bf16_t*)(ws + WS_Y3), (const bf16_t*)(ws + WS_Y4)); }
}

extern "C" void kernel_launch(void* const* d_in, const int* in_sizes, int n_in, void* d_out, int out_size, void* d_ws, size_t ws_size, hipStream_t stream) {
    static int grid = 0;
    if (grid == 0) {
        if (n_in != 21 || in_sizes[0] != T * D || out_size != T * D || ws_size < WS_END) { fprintf(stderr, "kernel_launch: unexpected problem (n_in %d, in0 %d, out %d, ws %zu)\n", n_in, n_in > 0 ? in_sizes[0] : -1, out_size, ws_size); grid = -1; return; }
        int dev = 0, cus = 0, per_cu = 0;
        (void)hipGetDevice(&dev);
        (void)hipDeviceGetAttribute(&cus, hipDeviceAttributeMultiprocessorCount, dev);
        (void)hipFuncSetAttribute((const void*)mk_fwd, hipFuncAttributeMaxDynamicSharedMemorySize, LDS_BYTES);
        (void)hipOccupancyMaxActiveBlocksPerMultiprocessor(&per_cu, (const void*)mk_fwd, NTHR, LDS_BYTES);
        if (per_cu < 1) { fprintf(stderr, "kernel_launch: occupancy query says %d blocks per CU\n", per_cu); grid = -1; return; }
        grid = cus;
        if (grid % 8 != 0) { fprintf(stderr, "kernel_launch: this kernel needs a CU count that is a multiple of 8 (got %d)\n", grid); grid = -1; return; }
    }
    if (grid < 0) return;
    (void)hipMemsetAsync((char*)d_ws + WS_CTL, 0, CTL_ZERO_BYTES, stream);
    Args a{};
    for (int i = 0; i < 21; ++i) a.in[i] = (const float*)d_in[i];
    a.out = (float*)d_out; a.ws = (unsigned char*)d_ws;
#if MK_PER_PHASE
    for (int p = 0; p < NPHASE; ++p) { a.ph_lo = p; a.ph_hi = p + 1; hipLaunchKernelGGL(mk_fwd, dim3(grid), dim3(NTHR), LDS_BYTES, stream, a); }
#else
    a.ph_lo = 0; a.ph_hi = NPHASE;
    void* kargs[] = {&a};
    hipError_t e = hipLaunchCooperativeKernel((const void*)mk_fwd, dim3(grid), dim3(NTHR), kargs, LDS_BYTES, stream);
    if (e != hipSuccess) fprintf(stderr, "cooperative launch failed: %s (grid %d)\n", hipGetErrorString(e), grid);
#endif
}
```

```cpp
#include <hip/hip_runtime.h>
#include <hip/hip_cooperative_groups.h>
#include <cstdio>
#include <cstdint>
namespace cg = cooperative_groups;

#ifndef MK_PER_PHASE
#define MK_PER_PHASE 0
#endif

#define GAS __attribute__((address_space(1)))
#define LAS __attribute__((address_space(3)))
typedef unsigned short bf16_t;
typedef short bf16x8 __attribute__((ext_vector_type(8)));
typedef short s16x4 __attribute__((ext_vector_type(4)));
typedef float f32x2 __attribute__((ext_vector_type(2)));
typedef float f32x4 __attribute__((ext_vector_type(4)));
typedef float f32x16 __attribute__((ext_vector_type(16)));
typedef unsigned u32x2 __attribute__((ext_vector_type(2)));
typedef unsigned u32x4 __attribute__((ext_vector_type(4)));

constexpr int NWAVES = 8, NTHR = 512;
constexpr int BATCH = 2, SEQ = 16384, T = BATCH * SEQ, D = 1024;
constexpr int NH = 15, HD = 64, AW = 960, NQKV = 2880, NQKVP = 3072;
constexpr int GH = 2048, FF = 4096, CHUNK = 128, NGRP = 8;
constexpr int NEXP = 16, DE = 256, NBUCK = 24, MAXTILES = 152;
constexpr float EPS = 1e-6f;
constexpr float C2 = 0.125f * 1.4426950408889634f;
constexpr int NPHASE = 19;

constexpr size_t MiB = 1u << 20;
constexpr size_t WS_CTL = 0, CTL_ZERO_BYTES = 1 * MiB;
constexpr size_t WS_MOD = 1 * MiB;
constexpr size_t WS_ROPE = 2 * MiB;
constexpr size_t WS_WR = 3 * MiB;
constexpr size_t WS_WQKV = 4 * MiB;
constexpr size_t WS_WO = 10 * MiB;
constexpr size_t WS_WIN = 12 * MiB;
constexpr size_t WS_WO2 = 20 * MiB;
constexpr size_t WS_BGU = 24 * MiB;
constexpr size_t WS_BDP = 56 * MiB;
constexpr size_t WS_H = 104 * MiB;
constexpr size_t WS_LIST = 168 * MiB;
constexpr size_t WS_WF = 177 * MiB;
constexpr size_t WS_STATS = 178 * MiB;
constexpr size_t WS_LSE = 186 * MiB;
constexpr size_t WS_BIG = 192 * MiB;
constexpr size_t WS_Q = WS_BIG, WS_K = WS_BIG + 60 * MiB, WS_V = WS_BIG + 120 * MiB, WS_O = WS_BIG + 180 * MiB;
constexpr size_t WS_HP = WS_BIG, WS_ACT = WS_BIG + 80 * MiB, WS_Y = WS_BIG + 120 * MiB, WS_Y1 = WS_BIG, WS_Y3 = WS_BIG + 128 * MiB, WS_Y4 = WS_BIG;
constexpr size_t WS_U = WS_BIG, WS_VV = WS_BIG + 128 * MiB;
constexpr size_t WS_XRB = 448 * MiB;
constexpr size_t WS_END = 512 * MiB;
constexpr int CW_BAR = 4096;
constexpr int CW_CNT = 16384;

constexpr int RING_BYTES = 131072;
constexpr int LDSCTL_OFF = RING_BYTES, MISC_OFF = LDSCTL_OFF + 320, TAB_OFF = LDSCTL_OFF + 1024;
constexpr int LDS_BYTES = 147456;

__device__ __forceinline__ unsigned f2bf(float f) { unsigned u = __builtin_bit_cast(unsigned, f); return (u + 0x7fffu + ((u >> 16) & 1u)) >> 16; }
__device__ __forceinline__ unsigned pk2(float lo, float hi) { return f2bf(lo) | (f2bf(hi) << 16); }
__device__ __forceinline__ float bf2f(unsigned short v) { return __builtin_bit_cast(float, (unsigned)v << 16); }
__device__ __forceinline__ float bflo(unsigned w) { return __builtin_bit_cast(float, w << 16); }
__device__ __forceinline__ float bfhi(unsigned w) { return __builtin_bit_cast(float, w & 0xffff0000u); }
__device__ __forceinline__ float wave_sum(float v) {
#pragma unroll
    for (int o = 1; o < 64; o <<= 1) v += __shfl_xor(v, o);
    return v;
}
__device__ __forceinline__ float sum16(float v) {
#pragma unroll
    for (int o = 1; o < 16; o <<= 1) v += __shfl_xor(v, o);
    return v;
}
#define LDS_WAIT() asm volatile("s_waitcnt lgkmcnt(0)" ::: "memory")
__device__ __forceinline__ int lane_now() { int l = (int)__builtin_amdgcn_mbcnt_hi(~0u, __builtin_amdgcn_mbcnt_lo(~0u, 0u)); asm volatile("" : "+v"(l)); return l; }

__device__ __forceinline__ int crow(int r, int hi) { return (r & 3) + 8 * (r >> 2) + 4 * hi; }
#define XB_TMO      128
#define XB_XCNT(j)  (256  + 64 * (j))
#define XB_XSUB(j)  (1280 + 64 * (j))
#define XB_XGEN(j)  (2304 + 64 * (j))
#define XB_TOP      3328
#define XB_TOPGEN   3392
#define XCD_BAR_WORDS 3456
#define XB_SPIN_CAP (1u << 22)
__device__ __forceinline__ unsigned xb_ld(unsigned* p)              { return __hip_atomic_load(p, __ATOMIC_RELAXED, __HIP_MEMORY_SCOPE_AGENT); }
__device__ __forceinline__ unsigned xb_add(unsigned* p, unsigned v) { return __hip_atomic_fetch_add(p, v, __ATOMIC_RELAXED, __HIP_MEMORY_SCOPE_AGENT); }
__device__ __forceinline__ unsigned xb_xcc_id() { return (unsigned)__builtin_amdgcn_s_getreg((3 << 11) | 20) & 0xFu; }
#define XB_SPIN(cond, bar) do { unsigned _sp = 0; while (cond) { __builtin_amdgcn_s_sleep(1); \
    if ((++_sp & 255u) == 0u) { if (xb_ld(&(bar)[XB_TMO])) break; if (_sp > XB_SPIN_CAP) { atomicAdd(&(bar)[XB_TMO], 1u); break; } } } } while (0)
struct XcdBarrier { unsigned* bar; unsigned x; volatile LAS unsigned* st; int wave; };
__device__ __forceinline__ XcdBarrier xcd_barrier_post(unsigned* bar, volatile LAS unsigned* st, int wave) {
    XcdBarrier b; b.bar = bar; b.x = xb_xcc_id(); b.st = st; b.wave = wave;
    if (wave == 0 && lane_now() == 0) (void)xb_add(&bar[XB_XCNT(b.x)], 1u);
    return b;
}
__device__ __forceinline__ void xcd_barrier_complete(unsigned* bar, unsigned x, unsigned& nloc, unsigned& nx) {
    const unsigned G = gridDim.x * gridDim.y * gridDim.z;
    unsigned sum, cnt, mine, sp = 0u;
    for (;;) {
        sum = 0u; cnt = 0u; mine = 0u;
#pragma unroll
        for (unsigned j = 0; j < 16; ++j) { const unsigned c = xb_ld(&bar[XB_XCNT(j)]); sum += c; cnt += (c > 0u) ? 1u : 0u; mine = (j == x) ? c : mine; }
        if (sum == G) break;
        __builtin_amdgcn_s_sleep(1);
        if ((++sp & 255u) == 0u) { if (xb_ld(&bar[XB_TMO])) break; if (sp > XB_SPIN_CAP) { atomicAdd(&bar[XB_TMO], 1u); break; } }
    }
    nloc = mine > 0u ? mine : 1u; nx = cnt > 0u ? cnt : 1u;
}
__device__ __forceinline__ void xcd_barrier2(const XcdBarrier& b) {
    asm volatile("s_waitcnt vmcnt(0)" ::: "memory");
    __syncthreads();
    if (b.wave == 0 && lane_now() == 0) {
        unsigned* bar = b.bar;
        __builtin_amdgcn_s_waitcnt(0);
        unsigned nloc = b.st[0], nx = b.st[1];
        if (nloc == 0u) { xcd_barrier_complete(bar, b.x, nloc, nx); b.st[0] = nloc; b.st[1] = nx; }
        const unsigned old = xb_add(&bar[XB_XSUB(b.x)], 1u);
        const unsigned gen = old / nloc;
        __builtin_amdgcn_fence(__ATOMIC_ACQUIRE, "agent");
        if (old + 1u == (gen + 1u) * nloc) {
            __builtin_amdgcn_fence(__ATOMIC_RELEASE, "agent");
            asm volatile("s_waitcnt vmcnt(0)" ::: "memory");
            const unsigned og = xb_add(&bar[XB_TOP], 1u);
            if (og + 1u == (gen + 1u) * nx) xb_add(&bar[XB_TOPGEN], 1u);
        }
        XB_SPIN(xb_ld(&bar[XB_TOPGEN]) == gen, bar);
        asm volatile("s_waitcnt vmcnt(0)" ::: "memory");
    }
    __syncthreads();
}

namespace pg8 {
constexpr int BM = 256, BK = 64, HALF = 128, HTB = HALF * BK * 2, NXCD = 8, WGM = 4;
__host__ __device__ __forceinline__ int lds_byte(int r, int c) { const int st = (r >> 4) * 2 + (c >> 5), rr = r & 15, cc = c & 31, ob = rr * 64 + cc * 2; return st * 1024 + (ob ^ (((ob >> 9) & 1) << 5)); }
__host__ __device__ __forceinline__ void stage_rc(int b, int& R, int& C) { const int st = b / 1024, sb = b % 1024, swz = sb ^ (((sb >> 9) & 1) << 5); R = (st >> 1) * 16 + swz / 64; C = (st & 1) * 32 + (swz % 64) / 2; }
__host__ __device__ __forceinline__ int perm32(int rho) { const int n = rho >> 4, i = rho & 15; return 8 * (i >> 2) + 4 * n + (i & 3); }
struct Unit { int pm, pn, h; };
__device__ __forceinline__ int xcd_remap(int L, int nwg) { const int q = nwg / NXCD, r = nwg % NXCD, xcd = L % NXCD, off = L / NXCD; return (xcd < r ? xcd * (q + 1) : r * (q + 1) + (xcd - r) * q) + off; }

struct DenseOrder {
    static constexpr bool HALFCAP = false;
    const char* A; const char* Bt; size_t tstep; int nM, nN, nwg, G, c;
    __device__ void init(const void* A_, const void* Bt_, int M, int N, int K, int G_, int c_) { A = (const char*)A_; Bt = (const char*)Bt_; tstep = (size_t)BM * K * 2; nM = M / BM; nN = N / BM; nwg = nM * nN; G = G_; c = c_; }
    __device__ bool next(int i, Unit& u) const {
        const long L = (long)i * G + c; if (L >= nwg) return false;
        const int wgid = xcd_remap((int)L, nwg);
        const int nig = WGM * nN, gid = wgid / nig, fm = gid * WGM, gsz = (nM - fm) < WGM ? (nM - fm) : WGM;
        u.pm = fm + ((wgid % nig) % gsz); u.pn = (wgid % nig) / gsz; u.h = 0; return true;
    }
    __device__ __forceinline__ const char* abase(const Unit& u) const { return A + (size_t)u.pm * tstep; }
    __device__ __forceinline__ const char* bptr(const Unit& u) const { return Bt + (size_t)u.pn * tstep; }
    __device__ __forceinline__ void aoffs(const Unit&, int, const int (&R)[2], const int (&C)[2], int K, unsigned& v00, unsigned& v01, unsigned& v10, unsigned& v11) const {
        v00 = (unsigned)(R[0] * K + C[0]) * 2u; v01 = (unsigned)(R[1] * K + C[1]) * 2u; v10 = v00 + (unsigned)(HALF * K * 2); v11 = v01 + (unsigned)(HALF * K * 2); }
};

__device__ __forceinline__ unsigned cvt_pk_bf16(float lo, float hi) { unsigned r; asm volatile("v_cvt_pk_bf16_f32 %0, %1, %2" : "=v"(r) : "v"(lo), "v"(hi)); return r; }
__device__ __forceinline__ f32x2 gelu_pk(f32x2 v) {
    const float six = 6.0f; f32x2 x, m;
    asm("v_min_f32_e64 %0, |%1|, %2" : "=v"(x.x) : "v"(v.x), "s"(six)); asm("v_min_f32_e64 %0, |%1|, %2" : "=v"(x.y) : "v"(v.y), "s"(six));
    f32x2 p = x * 3.309498500e-05f + (-7.692387091e-04f); p = p * x + 8.080778804e-03f; p = p * x + (-5.341219989e-02f); p = p * x + (-4.587709027e-01f); p = p * x + (-1.151201725e+00f); p = p * x + (-9.999930587e-01f);
    f32x2 e; e.x = __builtin_amdgcn_exp2f(p.x); e.y = __builtin_amdgcn_exp2f(p.y);
    asm("v_max_f32_e32 %0, 0, %1" : "=v"(m.x) : "v"(v.x)); asm("v_max_f32_e32 %0, 0, %1" : "=v"(m.y) : "v"(v.y));
    return m - x * e;
}

template <class Epi, class Sched, bool ALIGN_EPI = true>
__device__ __forceinline__ void gemm_phase(LAS unsigned char* lds, const int K, const Sched& S, const Epi& E, const int wave) {
    const int lane = lane_now(), wid = wave, tid = wave * 64 + lane, wr = wid >> 2, wc = wid & 3, fr = lane & 15, fq = lane >> 4;
    const int nt = K / BK;
    int RA[2], CA[2]; unsigned voffB[2];
#pragma unroll
    for (int i = 0; i < 2; ++i) { int R, C; stage_rc(tid * 16 + i * 8192, R, C);
        const int Rb = Epi::BMAP ? ((R >> 5) * 64 + perm32(R & 31)) : (Epi::PERM ? ((R & ~31) + perm32(R & 31)) : R);
        RA[i] = R; CA[i] = C; voffB[i] = (unsigned)(Rb * K + C) * 2u; }
    const size_t kstep = (size_t)(BK * 2);
    const size_t hstep = (size_t)(Epi::BMAP ? 32 : HALF) * K * 2;
    const unsigned ldsw = (unsigned)wid * 1024u;
    const int aoff = lds_byte(wr * 64 + fr, fq * 8), boff = lds_byte(wc * 32 + fr, fq * 8);
#define PG8_SA(b, h) (((b) * 2 + (h)) * HTB)
#define PG8_SB(b, h) ((4 + (b) * 2 + (h)) * HTB)
#define PG8_STAGE(bufoff, gbase, v0, v1) do { \
        __builtin_amdgcn_global_load_lds((const unsigned*)((const char*)(gbase) + (v0)), (LAS unsigned*)(lds + (bufoff) + ldsw), 16, 0, 0); \
        __builtin_amdgcn_global_load_lds((const unsigned*)((const char*)(gbase) + (v1)), (LAS unsigned*)(lds + (bufoff) + ldsw + 8192), 16, 0, 0); } while (0)
#define PG8_STB(bufoff, gbase) PG8_STAGE(bufoff, gbase, voffB[0], voffB[1])
#define PG8_LDA(dst, b, h) do { _Pragma("unroll") for (int m = 0; m < 4; ++m) _Pragma("unroll") for (int k = 0; k < 2; ++k) dst[m][k] = *(const LAS bf16x8*)(lds + PG8_SA(b, h) + aoff + m * 2048 + k * 1024); } while (0)
#define PG8_LDB(dst, b, h) do { _Pragma("unroll") for (int n = 0; n < 2; ++n) _Pragma("unroll") for (int k = 0; k < 2; ++k) dst[n][k] = *(const LAS bf16x8*)(lds + PG8_SB(b, h) + boff + n * 2048 + k * 1024); } while (0)
#define PG8_MMA(ai, bj, At, Bt) do { __builtin_amdgcn_s_setprio(1); _Pragma("unroll") for (int m = 0; m < 4; ++m) _Pragma("unroll") for (int n = 0; n < 2; ++n) _Pragma("unroll") for (int k = 0; k < 2; ++k) \
        acc[ai][bj][m][n] = __builtin_amdgcn_mfma_f32_16x16x32_bf16(Bt[n][k], At[m][k], acc[ai][bj][m][n], 0, 0, 0); __builtin_amdgcn_s_setprio(0); } while (0)
#define PG8_WAIT_V(n) asm volatile("s_waitcnt vmcnt(" #n ")" ::: "memory")
#define PG8_WAIT_L(n) asm volatile("s_waitcnt lgkmcnt(" #n ")" ::: "memory")
#define PG8_BAR __builtin_amdgcn_s_barrier()
#define PG8_SCHED __builtin_amdgcn_sched_barrier(0)
    Unit cur, nxt; int ui = 0;
    if (!S.next(0, cur)) return;
    f32x4 acc[2][2][4][2];
#pragma unroll
    for (int a = 0; a < 2; ++a)
#pragma unroll
        for (int b = 0; b < 2; ++b)
#pragma unroll
            for (int m = 0; m < 4; ++m)
#pragma unroll
                for (int n = 0; n < 2; ++n) acc[a][b][m][n] = (f32x4){0.f, 0.f, 0.f, 0.f};
    bf16x8 At[4][2], B0[2][2], B1[2][2];
    const char* cA = S.abase(cur); const char* cB = S.bptr(cur);
    unsigned vA00, vA01, vA10, vA11;
    S.aoffs(cur, 0, RA, CA, K, vA00, vA01, vA10, vA11);
    {
        PG8_STB(PG8_SB(0, 0), cB); PG8_STB(PG8_SB(0, 1), cB + hstep); PG8_STAGE(PG8_SA(0, 0), cA, vA00, vA01); PG8_STAGE(PG8_SA(0, 1), cA, vA10, vA11);
        if (wr == 1) PG8_BAR;
        PG8_WAIT_V(2); PG8_BAR;
        PG8_STB(PG8_SB(1, 0), cB + kstep); PG8_STAGE(PG8_SA(1, 0), cA + kstep, vA00, vA01); PG8_STB(PG8_SB(1, 1), cB + hstep + kstep);
        PG8_WAIT_V(6); PG8_BAR;
    }
    for (;;) {
        const bool has_next = S.next(ui + 1, nxt);
        const char* nA = has_next ? S.abase(nxt) : cA; const char* nB = has_next ? S.bptr(nxt) : cB;
        unsigned nA00 = vA00, nA01 = vA01, nA10 = vA10, nA11 = vA11;
        if (has_next) S.aoffs(nxt, ui + 1, RA, CA, K, nA00, nA01, nA10, nA11);
        const bool full = !Sched::HALFCAP || cur.h == 0;
        for (int t = 0; t < nt; t += 2) {
            const bool last = (t == nt - 2);
            const char* a1 = cA + (size_t)(t + 1) * kstep;
            const char* a2 = last ? nA : cA + (size_t)(t + 2) * kstep; const char* b2 = last ? nB : cB + (size_t)(t + 2) * kstep;
            const char* a3 = a2 + kstep; const char* b3 = b2 + kstep;
            const unsigned w00 = last ? nA00 : vA00, w01 = last ? nA01 : vA01, w10 = last ? nA10 : vA10, w11 = last ? nA11 : vA11;
            PG8_LDB(B0, 0, 0); PG8_LDB(B1, 0, 1); PG8_SCHED; PG8_LDA(At, 0, 0); PG8_STAGE(PG8_SA(1, 1), a1, vA10, vA11);
            PG8_WAIT_V(8); PG8_WAIT_L(0); PG8_BAR; PG8_MMA(0, 0, At, B0); PG8_MMA(0, 1, At, B1); PG8_BAR; PG8_SCHED;
            if (full) PG8_LDA(At, 0, 1); PG8_STB(PG8_SB(0, 0), b2); PG8_STB(PG8_SB(0, 1), b2 + hstep); PG8_STAGE(PG8_SA(0, 0), a2, w00, w01);
            PG8_WAIT_V(8); PG8_WAIT_L(0); PG8_BAR; if (full) { PG8_MMA(1, 0, At, B0); PG8_MMA(1, 1, At, B1); } PG8_BAR; PG8_SCHED;
            PG8_LDB(B0, 1, 0); PG8_LDB(B1, 1, 1); PG8_SCHED; PG8_LDA(At, 1, 0); PG8_STAGE(PG8_SA(0, 1), a2, w10, w11);
            PG8_WAIT_V(8); PG8_WAIT_L(0); PG8_BAR; PG8_MMA(0, 0, At, B0); PG8_MMA(0, 1, At, B1); PG8_BAR; PG8_SCHED;
            if (full) PG8_LDA(At, 1, 1); PG8_STB(PG8_SB(1, 0), b3); PG8_STB(PG8_SB(1, 1), b3 + hstep); PG8_STAGE(PG8_SA(1, 0), a3, w00, w01);
            PG8_WAIT_V(8); PG8_WAIT_L(0); PG8_BAR; if (full) { PG8_MMA(1, 0, At, B0); PG8_MMA(1, 1, At, B1); } PG8_BAR; PG8_SCHED;
        }
        if constexpr (ALIGN_EPI) { if (wr == 0) PG8_BAR; }
        E(acc, cur, wr, wc, fr, fq);
        if (!has_next) break;
#pragma unroll
        for (int a = 0; a < 2; ++a)
#pragma unroll
            for (int b = 0; b < 2; ++b)
#pragma unroll
                for (int m = 0; m < 4; ++m)
#pragma unroll
                    for (int n = 0; n < 2; ++n) acc[a][b][m][n] = (f32x4){0.f, 0.f, 0.f, 0.f};
        cur = nxt; cA = nA; cB = nB; ++ui; vA00 = nA00; vA01 = nA01; vA10 = nA10; vA11 = nA11;
        if constexpr (ALIGN_EPI) { if (wr == 1) PG8_BAR; }
    }
    PG8_WAIT_V(0);
    if constexpr (!ALIGN_EPI) { if (wr == 0) PG8_BAR; }
    PG8_BAR;
#undef PG8_SA
#undef PG8_SB
#undef PG8_STAGE
#undef PG8_STB
#undef PG8_LDA
#undef PG8_LDB
#undef PG8_MMA
#undef PG8_WAIT_V
#undef PG8_WAIT_L
#undef PG8_BAR
#undef PG8_SCHED
}
}
using pg8::Unit;
using pg8::cvt_pk_bf16;


struct EpiQKV {
    static constexpr bool PERM = true; static constexpr int BMAP = 1;
    bf16_t* Q; bf16_t* Kk; bf16_t* V; const float* rope;
    __device__ __forceinline__ void operator()(const f32x4 (&acc)[2][2][4][2], const Unit& u, int wr, int wc, int fr, int fq) const {
#pragma unroll
        for (int bj = 0; bj < 2; ++bj) {
            const int colbase = u.pn * 256 + wc * 64 + bj * 32;
            const int hs = colbase >> 6, half = (colbase >> 5) & 1;
            const int type = hs / NH, head = hs - type * NH;
            if (type >= 3) continue;
            const int grp = head / 5, shift = 2 * grp, L = SEQ >> shift, dmask = (1 << shift) - 1;
            bf16_t* dst = Q + (size_t)type * (60u * 1024u * 1024u / 2u);
            const bool do_rope = (type < 2) && (half == 0) && (fq < 2);
            const float sc = (type == 0) ? C2 : 1.0f;
#pragma unroll
            for (int ai = 0; ai < 2; ++ai) {
                f32x4 cs0[4], cs1[4];
#pragma unroll
                for (int m = 0; m < 4; ++m) {
                    const int s = (u.pm * 256 + ai * 128 + wr * 64 + m * 16 + fr) & (SEQ - 1);
                    if (do_rope) { cs0[m] = *(const f32x4*)(rope + (size_t)s * 16 + fq * 8); cs1[m] = *(const f32x4*)(rope + (size_t)s * 16 + fq * 8 + 4); }
                    else { cs0[m] = (f32x4){1.f, 0.f, 1.f, 0.f}; cs1[m] = cs0[m]; }
                }
#pragma unroll
                for (int m = 0; m < 4; ++m) {
                    const int row = u.pm * 256 + ai * 128 + wr * 64 + m * 16 + fr;
                    const int b = row >> 14, s = row & (SEQ - 1);
                    const int r = s & dmask, i = s >> shift;
                    const size_t drow = (size_t)(b * NH + head) * SEQ + (size_t)r * L + i;
                    f32x4 v0 = acc[ai][bj][m][0], v1 = acc[ai][bj][m][1];
                    const f32x4 c = (f32x4){cs0[m][0], cs0[m][2], cs1[m][0], cs1[m][2]}, sn = (f32x4){cs0[m][1], cs0[m][3], cs1[m][1], cs1[m][3]};
                    const f32x4 lo = v0 * c - v1 * sn, hi = v1 * c + v0 * sn;
                    v0 = lo * sc; v1 = hi * sc;
                    u32x4 w; w.x = cvt_pk_bf16(v0[0], v0[1]); w.y = cvt_pk_bf16(v0[2], v0[3]); w.z = cvt_pk_bf16(v1[0], v1[1]); w.w = cvt_pk_bf16(v1[2], v1[3]);
                    *(u32x4*)(dst + drow * 64 + half * 32 + fq * 8) = w;
                }
            }
        }
    }
};

struct EpiResid {
    static constexpr bool PERM = false; static constexpr int BMAP = 0;
    const float* base; float* out; const float* gate;
    __device__ __forceinline__ void operator()(const f32x4 (&acc)[2][2][4][2], const Unit& u, int wr, int wc, int fr, int fq) const {
        const int row0 = u.pm * 256 + wr * 64 + fr, col0 = u.pn * 256 + wc * 32 + 4 * fq;
        const int b = (u.pm * 256) >> 14;
        f32x4 gv[2][2];
#pragma unroll
        for (int bj = 0; bj < 2; ++bj)
#pragma unroll
            for (int n = 0; n < 2; ++n) gv[bj][n] = *(const f32x4*)(gate + b * 6144 + col0 + bj * 128 + n * 16);
#pragma unroll
        for (int ai = 0; ai < 2; ++ai) {
            f32x4 pre[4][2][2];
#pragma unroll
            for (int m = 0; m < 4; ++m) { const size_t off = (size_t)(row0 + ai * 128 + m * 16) * D + col0;
#pragma unroll
                for (int bj = 0; bj < 2; ++bj)
#pragma unroll
                    for (int n = 0; n < 2; ++n) pre[m][bj][n] = *(const f32x4*)(base + off + bj * 128 + n * 16); }
#pragma unroll
            for (int m = 0; m < 4; ++m) { const size_t off = (size_t)(row0 + ai * 128 + m * 16) * D + col0;
#pragma unroll
                for (int bj = 0; bj < 2; ++bj)
#pragma unroll
                    for (int n = 0; n < 2; ++n) *(f32x4*)(out + off + bj * 128 + n * 16) = pre[m][bj][n] + gv[bj][n] * acc[ai][bj][m][n]; }
        }
    }
};

struct EpiY {
    static constexpr bool PERM = true; static constexpr int BMAP = 1;
    bf16_t* Y; const float* gate;
    __device__ __forceinline__ void operator()(const f32x4 (&acc)[2][2][4][2], const Unit& u, int wr, int wc, int fr, int fq) const {
        const int row0 = u.pm * 256 + wr * 64 + fr, col0 = u.pn * 256 + wc * 64 + 8 * fq;
        const int b = (u.pm * 256) >> 14;
        f32x4 gv[2][2];
#pragma unroll
        for (int bj = 0; bj < 2; ++bj)
#pragma unroll
            for (int n = 0; n < 2; ++n) gv[bj][n] = *(const f32x4*)(gate + b * 6144 + col0 + bj * 32 + n * 4);
#pragma unroll
        for (int ai = 0; ai < 2; ++ai)
#pragma unroll
            for (int m = 0; m < 4; ++m) { bf16_t* yp = Y + (size_t)(row0 + ai * 128 + m * 16) * D + col0;
#pragma unroll
                for (int bj = 0; bj < 2; ++bj) { const f32x4 y0 = gv[bj][0] * acc[ai][bj][m][0], y1 = gv[bj][1] * acc[ai][bj][m][1];
                    *(u32x4*)(yp + bj * 32) = (u32x4){cvt_pk_bf16(y0[0], y0[1]), cvt_pk_bf16(y0[2], y0[3]), cvt_pk_bf16(y1[0], y1[1]), cvt_pk_bf16(y1[2], y1[3])}; } }
    }
};

template <int MODE = 0> struct EpiGelu {
    static constexpr bool PERM = true; static constexpr int BMAP = 1;
    bf16_t* U; bf16_t* V; float* stats;
    template <bool ISV> __device__ __forceinline__ void run(const f32x4 (&acc)[2][2][4][2], const Unit& u, int wr, int wc, int fr, int fq) const {
        bf16_t* dst = ISV ? V : U;
        const int colt = (ISV ? u.pn - 8 : u.pn) * 256 + wc * 64 + 8 * fq;
#pragma unroll
        for (int ai = 0; ai < 2; ++ai)
#pragma unroll
            for (int m = 0; m < 4; ++m) {
                const int row = u.pm * 256 + ai * 128 + wr * 64 + m * 16 + fr;
                f32x2 s1v = {0.f, 0.f}, s2v = {0.f, 0.f};
#pragma unroll
                for (int bj = 0; bj < 2; ++bj) {
                    const f32x4 v0 = acc[ai][bj][m][0], v1 = acc[ai][bj][m][1];
                    if constexpr (MODE == 2) { asm volatile("" :: "v"(v0), "v"(v1)); continue; }
                    const f32x2 a = pg8::gelu_pk((f32x2){v0[0], v0[1]}), bq = pg8::gelu_pk((f32x2){v0[2], v0[3]}), c = pg8::gelu_pk((f32x2){v1[0], v1[1]}), d = pg8::gelu_pk((f32x2){v1[2], v1[3]});
                    if constexpr (ISV) { s1v += (a + bq) + (c + d); s2v = a * a + s2v; s2v = bq * bq + s2v; s2v = c * c + s2v; s2v = d * d + s2v; }
                    u32x4 w; w.x = cvt_pk_bf16(a.x, a.y); w.y = cvt_pk_bf16(bq.x, bq.y); w.z = cvt_pk_bf16(c.x, c.y); w.w = cvt_pk_bf16(d.x, d.y);
                    if constexpr (MODE == 0) __builtin_nontemporal_store(w, (u32x4*)(dst + (size_t)row * GH + colt + bj * 32)); else asm volatile("" :: "v"(w));
                }
                if constexpr (ISV && MODE == 0) {
                    float s1 = s1v.x + s1v.y, s2 = s2v.x + s2v.y;
                    s1 += __shfl_xor(s1, 16); s1 += __shfl_xor(s1, 32); s2 += __shfl_xor(s2, 16); s2 += __shfl_xor(s2, 32);
                    if (fq == 0) *(f32x2*)(stats + ((size_t)row * 32 + (u.pn - 8) * 4 + wc) * 2) = (f32x2){s1, s2};
                }
            }
    }
    __device__ __forceinline__ void operator()(const f32x4 (&acc)[2][2][4][2], const Unit& u, int wr, int wc, int fr, int fq) const {
        if (u.pn >= 8) run<true>(acc, u, wr, wc, fr, fq); else run<false>(acc, u, wr, wc, fr, fq);
    }
};

struct MoeTab { LAS unsigned char* lds; int ntiles;
    __device__ __forceinline__ int cnt(int b) const { return __builtin_amdgcn_readfirstlane(((const LAS int*)(lds + TAB_OFF))[b]); }
    __device__ __forceinline__ int tpre(int b) const { return __builtin_amdgcn_readfirstlane(((const LAS int*)(lds + TAB_OFF + 128))[b]); }
    __device__ __forceinline__ int tileb(int t) const { return __builtin_amdgcn_readfirstlane((int)((const LAS unsigned char*)(lds + TAB_OFF + 256))[t]); }
};
__device__ __forceinline__ MoeTab moe_tab(LAS unsigned char* lds) {
    MoeTab t; t.lds = lds; t.ntiles = __builtin_amdgcn_readfirstlane(((const LAS int*)(lds + TAB_OFF + 128))[24]); return t;
}
__device__ __forceinline__ void moe_tab_build(LAS unsigned char* lds, const unsigned* gcnt, const int t) {
    LAS int* cnt = (LAS int*)(lds + TAB_OFF); LAS int* tpre = (LAS int*)(lds + TAB_OFF + 128); LAS unsigned char* tileb = (LAS unsigned char*)(lds + TAB_OFF + 256);
    __syncthreads();
    if (t < NBUCK) cnt[t] = (int)__hip_atomic_load(gcnt + t, __ATOMIC_RELAXED, __HIP_MEMORY_SCOPE_AGENT);
    __syncthreads();
    if (t <= NBUCK) { int p = 0;
#pragma unroll 1
        for (int j = 0; j < t; ++j) p += (cnt[j] + 255) >> 8;
        tpre[t] = p; }
    __syncthreads();
    if (t < 160) { int b = 0;
#pragma unroll 1
        for (int j = 1; j < NBUCK; ++j) b += (tpre[j] <= t) ? 1 : 0;
        tileb[t] = (unsigned char)b; }
    __syncthreads();
}
__device__ __forceinline__ int pair_a(int p) { return p < 3 ? 0 : (p < 5 ? 1 : 2); }
__device__ __forceinline__ int pair_b(int p) { return p == 0 ? 1 : ((p == 1 || p == 3) ? 2 : 3); }

constexpr int TOKL_OFF = LDSCTL_OFF + 2048;
struct MoeOrder {
    static constexpr bool HALFCAP = true;
    const char* A; size_t tstepA; const char* B; int mode; int layer; MoeTab tab; int nwg, G, c;
    __device__ __forceinline__ bool split() const { return layer == 1; }
    __device__ __forceinline__ int tail_lo() const { const int R = nwg / G, rem = nwg - R * G; return (G - rem >= G / 2) ? rem : 0; }
    __device__ bool next(int i, Unit& u) const {
        const int R = nwg / G, rem = nwg - R * G;
        int L; u.h = 0;
        if (i < R) L = i * G + c;
        else if (i > R) return false;
        else if (!split() || 2 * rem > G) { if (c >= rem) return false; L = R * G + c; }
        else { const int x = c & 7, o = c >> 3, Lt = 8 * (o >> 1) + x; if (Lt >= rem) return false; L = R * G + Lt; u.h = 1 + (o & 1); }
        const int wgid = pg8::xcd_remap(L, nwg); u.pm = wgid >> 2; u.pn = wgid & 3;
        if (u.h == 2) { const int bk = tab.tileb(u.pm); if ((u.pm - tab.tpre(bk)) * 256 + 128 >= tab.cnt(bk)) return false; }
        return true;
    }
    __device__ __forceinline__ const char* abase(const Unit& u) const { return mode == 0 ? A : A + (size_t)u.pm * tstepA; }
    __device__ __forceinline__ const char* bptr(const Unit& u) const {
        const int bk = tab.tileb(u.pm);
        if (mode == 0) { const int g = bk / 6, p = bk - g * 6; const int e = 4 * g + ((u.pn >> 1) ? pair_b(p) : pair_a(p));
            return B + ((size_t)((layer * NEXP + e) * 512 + (u.pn & 1) * 256)) * 1024 * 2; }
        return B + ((size_t)((layer * NBUCK + bk) * 1024 + u.pn * 256)) * 512 * 2;
    }
    __device__ __forceinline__ void aoffs(const Unit& u, int ui, const int (&R)[2], const int (&C)[2], int K, unsigned& v00, unsigned& v01, unsigned& v10, unsigned& v11) const {
        if (mode == 0) { const LAS int* tl = (const LAS int*)(tab.lds + TOKL_OFF) + ui * 256;
            v00 = (unsigned)(tl[R[0]] * K + C[0]) * 2u; v01 = (unsigned)(tl[R[1]] * K + C[1]) * 2u; v10 = (unsigned)(tl[128 + R[0]] * K + C[0]) * 2u; v11 = (unsigned)(tl[128 + R[1]] * K + C[1]) * 2u; }
        else { const unsigned ro = u.h == 2 ? (unsigned)(128 * K * 2) : 0u;
            v00 = (unsigned)(R[0] * K + C[0]) * 2u + ro; v01 = (unsigned)(R[1] * K + C[1]) * 2u + ro; v10 = u.h ? v00 : v00 + (unsigned)(128 * K * 2); v11 = u.h ? v01 : v01 + (unsigned)(128 * K * 2); }
    }
    __device__ __forceinline__ void fill_tokl(const int* ltok, const int tid) const {
        LAS int* tl = (LAS int*)(tab.lds + TOKL_OFF); Unit u;
        for (int i = 0; i < 4 && next(i, u); ++i) {
            const int bk = tab.tileb(u.pm), idx0 = (u.pm - tab.tpre(bk)) * 256, cnt = tab.cnt(bk);
            if (tid < 256) { int idx = idx0 + (u.h ? (tid & 127) + 128 * (u.h - 1) : tid); idx = idx < cnt ? idx : cnt - 1; tl[i * 256 + tid] = ltok[(size_t)bk * T + idx]; }
        }
        __syncthreads();
    }
};

struct EpiAct {
    static constexpr bool PERM = true; static constexpr int BMAP = 0;
    bf16_t* ACT; const float* lwa; const float* lwb; MoeTab tab;
    __device__ __forceinline__ void operator()(const f32x4 (&acc)[2][2][4][2], const Unit& u, int wr, int wc, int fr, int fq) const {
        const int bk = tab.tileb(u.pm), idx0 = (u.pm - tab.tpre(bk)) * 256, cnt = tab.cnt(bk);
        const float* lw = ((u.pn >> 1) ? lwb : lwa) + (size_t)bk * T;
        const int col = u.pn * 128 + wc * 32 + 8 * fq;
        const int roff = u.h == 2 ? 128 : 0;
        float wrow[2][4];
#pragma unroll
        for (int ai = 0; ai < 2; ++ai)
#pragma unroll
            for (int m = 0; m < 4; ++m) { const int idx = idx0 + roff + ai * 128 + wr * 64 + m * 16 + fr; wrow[ai][m] = idx < cnt ? lw[idx] : 0.f; }
#pragma unroll
        for (int ai = 0; ai < 2; ++ai) {
            if (ai == 1 && u.h != 0) continue;
#pragma unroll
            for (int m = 0; m < 4; ++m) {
                const int rl = roff + ai * 128 + wr * 64 + m * 16 + fr;
                const float w = wrow[ai][m];
                float o[8];
#pragma unroll
                for (int n = 0; n < 2; ++n)
#pragma unroll
                    for (int j = 0; j < 4; ++j) { const float g = acc[ai][0][m][n][j], up = acc[ai][1][m][n][j];
                        const float sg = g * __builtin_amdgcn_rcpf(1.0f + __builtin_amdgcn_exp2f(-1.4426950408889634f * g));
                        o[n * 4 + j] = sg * up * w; }
                u32x4 pw; pw.x = cvt_pk_bf16(o[0], o[1]); pw.y = cvt_pk_bf16(o[2], o[3]); pw.z = cvt_pk_bf16(o[4], o[5]); pw.w = cvt_pk_bf16(o[6], o[7]);
                *(u32x4*)(ACT + (size_t)(u.pm * 256 + rl) * 512 + col) = pw;
            }
        }
    }
};

struct EpiDown {
    static constexpr bool PERM = true; static constexpr int BMAP = 1;
    bf16_t* Y; const float* gate; const int* ltok; MoeTab tab;
    __device__ __forceinline__ void operator()(const f32x4 (&acc)[2][2][4][2], const Unit& u, int wr, int wc, int fr, int fq) const {
        const int bk = tab.tileb(u.pm), idx0 = (u.pm - tab.tpre(bk)) * 256, cnt = tab.cnt(bk);
        const int* lt = ltok + (size_t)bk * T;
        const int col0 = u.pn * 256 + wc * 64 + 8 * fq;
        const int roff = u.h == 2 ? 128 : 0;
        int tokr[2][4];
#pragma unroll
        for (int ai = 0; ai < 2; ++ai)
#pragma unroll
            for (int m = 0; m < 4; ++m) { const int idx = idx0 + roff + ai * 128 + wr * 64 + m * 16 + fr; tokr[ai][m] = (idx < cnt && (ai == 0 || u.h == 0)) ? lt[idx] : -1; }
        f32x4 g0[2][2], g1[2][2];
#pragma unroll
        for (int bj = 0; bj < 2; ++bj)
#pragma unroll
            for (int n = 0; n < 2; ++n) { g0[bj][n] = *(const f32x4*)(gate + col0 + bj * 32 + n * 4); g1[bj][n] = *(const f32x4*)(gate + 6144 + col0 + bj * 32 + n * 4); }
#pragma unroll
        for (int ai = 0; ai < 2; ++ai)
#pragma unroll
            for (int m = 0; m < 4; ++m) {
                const int tok = tokr[ai][m];
                if (tok >= 0) {
                    const bool b1 = tok >= SEQ;
#pragma unroll
                    for (int bj = 0; bj < 2; ++bj) {
                        const f32x4 ga = b1 ? g1[bj][0] : g0[bj][0], gb = b1 ? g1[bj][1] : g0[bj][1];
                        const f32x4 y0 = ga * acc[ai][bj][m][0], y1 = gb * acc[ai][bj][m][1];
                        *(u32x4*)(Y + (size_t)tok * D + col0 + bj * 32) = (u32x4){cvt_pk_bf16(y0[0], y0[1]), cvt_pk_bf16(y0[2], y0[3]), cvt_pk_bf16(y1[0], y1[1]), cvt_pk_bf16(y1[2], y1[3])};
                    }
                }
            }
    }
};

struct Args { const float* in[21]; float* out; unsigned char* ws; int ph_lo, ph_hi; };
struct Ctx {
    LAS unsigned char* lds; int tid, lane, wave, G, bx;
    float* out; unsigned char* ws;
};
enum { I_X = 0, I_C, I_NMIX, I_NFFN, I_WADA, I_BADA, I_WQKV, I_AWO, I_WIN, I_VGAIN, I_WS, I_BS, I_BWO, I_RWG, I_RBG, I_RWE, I_RBE, I_EWG, I_EWU, I_EWD, I_FNORM };

__device__ __forceinline__ void tr_load(const float* W, int ldw, int k0, int n0, LAS float* scr, int lane) {
#pragma unroll 8
    for (int i = 0; i < 32; ++i) { const int kk = 2 * i + (lane >> 5); scr[kk * 33 + (lane & 31)] = __builtin_nontemporal_load(W + (size_t)(k0 + kk) * ldw + n0 + (lane & 31)); }
    LDS_WAIT(); asm volatile("" ::: "memory");
}
template <class RowFn> __device__ __forceinline__ void tr_store(LAS float* scr, int lane, RowFn rowfn) {
    const int c = lane & 7;
#pragma unroll
    for (int j = 0; j < 4; ++j) { const int n = (lane >> 3) + 8 * j; const LAS float* s = scr + (8 * c) * 33 + n;
        u32x4 o; o.x = pk2(s[0 * 33], s[1 * 33]); o.y = pk2(s[2 * 33], s[3 * 33]); o.z = pk2(s[4 * 33], s[5 * 33]); o.w = pk2(s[6 * 33], s[7 * 33]);
        bf16_t* p = rowfn(n); if (p) *(u32x4*)(p + 8 * c) = o; }
    LDS_WAIT(); asm volatile("" ::: "memory");
}
__device__ __forceinline__ int qk_perm_row(int n) {
    if (n >= 2 * AW) return n;
    const int d = n & 63; if (d >= 16) return n;
    const int b = d >> 3, rem = d & 7, a = rem >> 2, c = rem & 3;
    return (n & ~63) + 8 * a + 4 * b + c;
}

__device__ __forceinline__ void expert_items(Ctx& F, const Args& A, int layer, int widx, int nw) {
    unsigned char* ws = F.ws;
    LAS float* scr = (LAS float*)(F.lds + F.wave * 16384);
    bf16_t* Bgu = (bf16_t*)(ws + WS_BGU); bf16_t* Bdp = (bf16_t*)(ws + WS_BDP);
    constexpr int I_E = 16 * 16 * 8, I_G = 16 * 4 * 32;
    for (int it = widx; it < 2 * I_E + I_G; it += nw) {
        int r = it;
        if (r < 2 * I_E) { const bool up = r >= I_E; if (up) r -= I_E;
            const int le = layer * 16 + r / 128, q = r % 128, kb = q / 8, nb = q % 8, k0 = kb * 64, n0 = nb * 32;
            tr_load(A.in[up ? I_EWU : I_EWG] + (size_t)le * D * DE, DE, k0, n0, scr, F.lane);
            tr_store(scr, F.lane, [&](int n) { const int j = n0 + n; return Bgu + ((size_t)le * 512 + (j >> 7) * 256 + (up ? 128 : 0) + (j & 127)) * D + k0; }); continue; } r -= 2 * I_E;
        { const int le = layer * 16 + r / 128, q = r % 128, kb = q / 32, nb = q % 32, k0 = kb * 64, n0 = nb * 32;
            const int l = le >> 4, e = le & 15, g = e >> 2, li = e & 3;
            tr_load(A.in[I_EWD] + (size_t)le * DE * D, D, k0, n0, scr, F.lane);
#pragma unroll
            for (int p = 0; p < 6; ++p) { const int pa = pair_a(p), pb = pair_b(p); if (pa != li && pb != li) continue;
                const int koff = (pa == li ? 0 : 256) + k0; bf16_t* base = Bdp + ((size_t)(l * NBUCK + g * 6 + p) * D) * 512 + koff;
                const int c = F.lane & 7;
#pragma unroll
                for (int j = 0; j < 4; ++j) { const int n = (F.lane >> 3) + 8 * j; const LAS float* s = scr + (8 * c) * 33 + n;
                    u32x4 o; o.x = pk2(s[0 * 33], s[1 * 33]); o.y = pk2(s[2 * 33], s[3 * 33]); o.z = pk2(s[4 * 33], s[5 * 33]); o.w = pk2(s[6 * 33], s[7 * 33]);
                    *(u32x4*)(base + (size_t)(n0 + n) * 512 + 8 * c) = o; }
            }
            LDS_WAIT(); asm volatile("" ::: "memory");
        }
    }
}

__device__ __forceinline__ void gmlp_items(Ctx& F, const Args& A, int widx, int nw) {
    unsigned char* ws = F.ws;
    LAS float* scr = (LAS float*)(F.lds + F.wave * 16384);
    bf16_t* Win = (bf16_t*)(ws + WS_WIN); bf16_t* Wo2 = (bf16_t*)(ws + WS_WO2);
    constexpr int I_C2 = 16 * 128, I_D = 32 * 32;
    for (int it = widx; it < I_C2 + I_D; it += nw) {
        int r = it;
        if (r < I_C2) { const int kb = r / 128, nb = r % 128, k0 = kb * 64, n0 = nb * 32; tr_load(A.in[I_WIN], FF, k0, n0, scr, F.lane);
            tr_store(scr, F.lane, [&](int n) { return Win + (size_t)(n0 + n) * D + k0; }); continue; } r -= I_C2;
        { const int kb = r / 32, nb = r % 32, k0 = kb * 64, n0 = nb * 32; tr_load(A.in[I_BWO], D, k0, n0, scr, F.lane);
            tr_store(scr, F.lane, [&](int n) { return Wo2 + (size_t)(n0 + n) * GH + k0; }); }
    }
}
__device__ __forceinline__ void p0_prep(Ctx& F, const Args& A) {
    unsigned char* ws = F.ws;
    {
        LAS float* CA = (LAS float*)F.lds;
        LAS float* RED = (LAS float*)(F.lds + 8192);
        for (int i = F.tid; i < 2 * D; i += NTHR) { const float v = A.in[I_C][i]; CA[i] = v / (1.0f + __expf(-v)); }
        __syncthreads();
        float* mod = (float*)(ws + WS_MOD);
        for (int task = F.bx; task < 192; task += F.G) {
            const int l = task / 96, j0 = (task % 96) * 64;
            const float* W = A.in[I_WADA] + (size_t)l * D * 6144 + j0 + F.lane;
            float a0 = 0.f, a1 = 0.f;
#pragma unroll 1
            for (int k0 = F.wave * 128; k0 < F.wave * 128 + 128; k0 += 32) {
                float wv[32];
#pragma unroll
                for (int j = 0; j < 32; ++j) wv[j] = __builtin_nontemporal_load(W + (size_t)(k0 + j) * 6144);
#pragma unroll
                for (int j = 0; j < 32; ++j) { a0 += CA[k0 + j] * wv[j]; a1 += CA[D + k0 + j] * wv[j]; }
            }
            RED[(F.wave * 2 + 0) * 64 + F.lane] = a0; RED[(F.wave * 2 + 1) * 64 + F.lane] = a1;
            __syncthreads();
            if (F.wave < 2) { float s = 0.f;
#pragma unroll
                for (int w = 0; w < 8; ++w) s += RED[(w * 2 + F.wave) * 64 + F.lane];
                mod[(l * 2 + F.wave) * 6144 + j0 + F.lane] = s + A.in[I_BADA][l * 6144 + j0 + F.lane]; }
            __syncthreads();
        }
    }
    {
        LAS float* scr = (LAS float*)(F.lds + F.wave * 16384);
        const int gw = F.bx * NWAVES + F.wave, NGW = F.G * NWAVES;
        constexpr int I_A = 16 * 90, I_B = 15 * 32;
        constexpr int NITEMS = I_A + I_B;
        bf16_t* Wqkv = (bf16_t*)(ws + WS_WQKV); bf16_t* Wo = (bf16_t*)(ws + WS_WO); bf16_t* Win = (bf16_t*)(ws + WS_WIN); bf16_t* Wo2 = (bf16_t*)(ws + WS_WO2);
        bf16_t* Bgu = (bf16_t*)(ws + WS_BGU); bf16_t* Bdp = (bf16_t*)(ws + WS_BDP);
        for (int it = gw; it < NITEMS; it += NGW) {
            int r = it;
            if (r < I_A) { const int kb = r / 90, nb = r % 90, k0 = kb * 64, n0 = nb * 32; tr_load(A.in[I_WQKV], NQKV, k0, n0, scr, F.lane);
                tr_store(scr, F.lane, [&](int n) { return Wqkv + (size_t)qk_perm_row(n0 + n) * D + k0; }); continue; } r -= I_A;
            if (r < I_B) { const int kb = r / 32, nb = r % 32, k0 = kb * 64, n0 = nb * 32; tr_load(A.in[I_AWO], D, k0, n0, scr, F.lane);
                tr_store(scr, F.lane, [&](int n) { return Wo + (size_t)(n0 + n) * D + k0; }); continue; } r -= I_B;
        }
        expert_items(F, A, 0, gw, NGW);
        const int gt = F.bx * NTHR + F.tid, NGT = F.G * NTHR;
        for (int i = gt; i < 192 * 128; i += NGT) *(u32x4*)(Wqkv + (size_t)NQKV * D + (size_t)i * 8) = (u32x4){0u, 0u, 0u, 0u};
        for (int i = gt; i < 1024 * 8; i += NGT) *(u32x4*)(Wo + (size_t)(i >> 3) * D + AW + (i & 7) * 8) = (u32x4){0u, 0u, 0u, 0u};
        float* rope = (float*)(ws + WS_ROPE);
        for (int i = gt; i < SEQ * 8; i += NGT) { const int pos = i >> 3, j = i & 7; const double inv = pow(500000.0, -(double)j / 8.0); const double ang = (double)pos * inv;
            rope[i * 2] = (float)cos(ang); rope[i * 2 + 1] = (float)sin(ang); }
        float* WR = (float*)(ws + WS_WR); float* WRB = (float*)(ws + WS_WR + 512 * 1024);
        for (int i = gt; i < 2 * D * 20; i += NGT) { const int l = i / (D * 20), rem = i % (D * 20), k = rem / 20, j = rem % 20;
            WR[i] = j < 4 ? A.in[I_RWG][((size_t)l * D + k) * 4 + j] : A.in[I_RWE][(((size_t)l * 4 + ((j - 4) >> 2)) * D + k) * 4 + ((j - 4) & 3)]; }
        for (int i = gt; i < 2 * 20; i += NGT) { const int l = i / 20, j = i % 20; WRB[l * 32 + j] = j < 4 ? A.in[I_RBG][l * 4 + j] : A.in[I_RBE][l * 16 + (j - 4)]; }
    }
}


__device__ __forceinline__ void route_prep(Ctx& F, const float* norm_ffn) {
    const float* mod = (const float*)(F.ws + WS_MOD);
    const float* WR = (const float*)(F.ws + WS_WR); const float* WRB = (const float*)(F.ws + WS_WR + 512 * 1024);
    bf16_t* WF = (bf16_t*)(F.ws + WS_WF); float* B2 = (float*)(F.ws + WS_WF + 768 * 1024);
    const int gt = F.bx * NTHR + F.tid, NGT = F.G * NTHR;
    for (int i = gt; i < 2 * 2 * 64 * 64; i += NGT) {
        const int lane = i & 63, ks = (i >> 6) & 63, b = (i >> 12) & 1, l = i >> 13;
        const int n = lane & 31, k0 = 16 * ks + 8 * (lane >> 5);
        unsigned hiw[4], low[4];
#pragma unroll
        for (int j2 = 0; j2 < 4; ++j2) {
            float v[2];
#pragma unroll
            for (int e = 0; e < 2; ++e) { const int k = k0 + 2 * j2 + e;
                const float gs = norm_ffn[l * D + k] * (1.0f + mod[(l * 2 + b) * 6144 + 4 * D + k]);
                v[e] = n < 20 ? gs * WR[((size_t)l * D + k) * 20 + n] : 0.f; }
            const unsigned h0 = f2bf(v[0]), h1 = f2bf(v[1]);
            hiw[j2] = h0 | (h1 << 16);
            low[j2] = pk2(v[0] - bf2f((unsigned short)h0), v[1] - bf2f((unsigned short)h1));
        }
        const size_t o = ((size_t)((l * 2 + b) * 2) * 64 + ks) * 64 + lane;
        *(u32x4*)(WF + o * 8) = (u32x4){hiw[0], hiw[1], hiw[2], hiw[3]};
        *(u32x4*)(WF + (o + 64 * 64) * 8) = (u32x4){low[0], low[1], low[2], low[3]};
    }
    const int gw = F.bx * NWAVES + F.wave, NGW = F.G * NWAVES;
    for (int i = gw; i < 2 * 2 * 20; i += NGW) {
        const int n = i % 20, lb = i / 20, l = lb >> 1; float s = 0.f;
        for (int k = F.lane; k < D; k += 64) s += mod[lb * 6144 + 3 * D + k] * WR[((size_t)l * D + k) * 20 + n];
        s = wave_sum(s);
        if (F.lane == 0) B2[lb * 32 + n] = s + WRB[l * 32 + n];
    }
}

template <bool ADDY> __device__ __forceinline__ void norm_rows(Ctx& F, const float* src, const float* gamma, const float* sh, const float* sc, bf16_t* dst, const bf16_t* Y = nullptr, const bf16_t* Yb = nullptr, bf16_t* xwb = nullptr) {
    const int gw = F.bx * NWAVES + F.wave, NGW = F.G * NWAVES;
    f32x4 gs[4], shv[4]; int curb = -1;
    for (int m = gw; m < T; m += NGW) {
        const int b = m >> 14;
        if (b != curb) { curb = b;
#pragma unroll
            for (int j = 0; j < 4; ++j) { const int k = 4 * F.lane + 256 * j; const f32x4 g = *(const f32x4*)(gamma + k), s = *(const f32x4*)(sc + b * 6144 + k); gs[j] = g * (s + 1.0f); shv[j] = *(const f32x4*)(sh + b * 6144 + k); } }
        const f32x4* xr = (const f32x4*)(src + (size_t)m * D) + F.lane;
        f32x4 v[4]; float ss = 0.f;
        u32x2 yv[4], y2v[4];
#pragma unroll
        for (int j = 0; j < 4; ++j) { v[j] = __builtin_nontemporal_load(xr + 64 * j);
            if constexpr (ADDY) { yv[j] = __builtin_nontemporal_load((const u32x2*)(Y + (size_t)m * D) + F.lane + 64 * j); y2v[j] = __builtin_nontemporal_load((const u32x2*)(Yb + (size_t)m * D) + F.lane + 64 * j); } }
#pragma unroll
        for (int j = 0; j < 4; ++j) {
            if constexpr (ADDY) { const u32x2 y = yv[j], y2 = y2v[j];
                v[j] = (v[j] + (f32x4){bflo(y.x), bfhi(y.x), bflo(y.y), bfhi(y.y)}) + (f32x4){bflo(y2.x), bfhi(y2.x), bflo(y2.y), bfhi(y2.y)}; __builtin_nontemporal_store((u32x2){pk2(v[j].x, v[j].y), pk2(v[j].z, v[j].w)}, (u32x2*)(xwb + (size_t)m * D) + F.lane + 64 * j); }
            ss += (v[j].x * v[j].x + v[j].y * v[j].y) + (v[j].z * v[j].z + v[j].w * v[j].w); }
        const float r = 1.0f / sqrtf(wave_sum(ss) * (1.0f / D) + EPS);
        u32x2* o8 = (u32x2*)(dst + (size_t)m * D) + F.lane;
#pragma unroll
        for (int j = 0; j < 4; ++j) { const f32x4 h = v[j] * r * gs[j] + shv[j]; o8[64 * j] = (u32x2){pk2(h.x, h.y), pk2(h.z, h.w)}; }
    }
}
__device__ __forceinline__ void final_norm(Ctx& F, const bf16_t* xr_, float* dst_, const float* gamma, const float oscale, const bf16_t* Y, const bf16_t* Yb) {
    const int gw = F.bx * NWAVES + F.wave, NGW = F.G * NWAVES;
    f32x4 gs[4];
#pragma unroll
    for (int j = 0; j < 4; ++j) gs[j] = *(const f32x4*)(gamma + 4 * F.lane + 256 * j) * oscale;
    for (int m = gw; m < T; m += NGW) {
        const u32x2* xr = (const u32x2*)(xr_ + (size_t)m * D) + F.lane;
        f32x4 v[4]; float ss = 0.f;
#pragma unroll
        for (int j = 0; j < 4; ++j) { { const u32x2 xb = __builtin_nontemporal_load(xr + 64 * j); v[j] = (f32x4){bflo(xb.x), bfhi(xb.x), bflo(xb.y), bfhi(xb.y)}; } const u32x2 y = __builtin_nontemporal_load((const u32x2*)(Y + (size_t)m * D) + F.lane + 64 * j), y2 = __builtin_nontemporal_load((const u32x2*)(Yb + (size_t)m * D) + F.lane + 64 * j);
            v[j] = (v[j] + (f32x4){bflo(y.x), bfhi(y.x), bflo(y.y), bfhi(y.y)}) + (f32x4){bflo(y2.x), bfhi(y2.x), bflo(y2.y), bfhi(y2.y)};
            ss += (v[j].x * v[j].x + v[j].y * v[j].y) + (v[j].z * v[j].z + v[j].w * v[j].w); }
        const float r = 1.0f / sqrtf(wave_sum(ss) * (1.0f / D) + EPS);
        f32x4* dr = (f32x4*)(dst_ + (size_t)m * D) + F.lane;
#pragma unroll
        for (int j = 0; j < 4; ++j) __builtin_nontemporal_store(v[j] * r * gs[j], dr + 64 * j);
    }
}

__device__ __forceinline__ s16x4 vtr(const LAS unsigned char* p) { typedef short v4i16_t __attribute__((ext_vector_type(4))); return __builtin_bit_cast(s16x4, __builtin_amdgcn_ds_read_tr16_b64_v4i16((LAS v4i16_t*)p)); }
__device__ __forceinline__ void attn_load(Ctx& F, int bh, int blk, const bf16_t* Q, const bf16_t* Kk, const bf16_t* V, u32x4 (&kpre)[6], u32x4 (&vpre)[6]) {
    const int head = bh % NH, grp = head / 5, shift = 2 * grp, L = SEQ >> shift;
    const int row0 = blk * 256, seg = row0 / L, i0 = row0 - seg * L;
    const size_t hbase = ((size_t)bh * SEQ + (size_t)seg * L) * 64;
    const bf16_t* Kh = Kk + hbase; const bf16_t* Vh = V + hbase;
#pragma unroll
    for (int pass = 0; pass < 6; ++pass) {
        const int idx = pass * NTHR + F.tid, row = idx >> 3, ch = idx & 7;
        int i = i0 - 64 + row; i = i < 0 ? 0 : (i > L - 1 ? L - 1 : i);
        kpre[pass] = __builtin_nontemporal_load((const u32x4*)(Kh + (size_t)i * 64 + ch * 8)); vpre[pass] = __builtin_nontemporal_load((const u32x4*)(Vh + (size_t)i * 64 + ch * 8));
    }
}
__device__ __forceinline__ void attn_loadq(Ctx& F, int bh, int blk, const bf16_t* Q, bf16x8 (&qf)[4]) {
    const int head = bh % NH, grp = head / 5, shift = 2 * grp, L = SEQ >> shift;
    const int row0 = blk * 256, seg = row0 / L, i0 = row0 - seg * L;
    const bf16_t* Qh = Q + ((size_t)bh * SEQ + (size_t)seg * L) * 64;
    const int qi = i0 + 32 * F.wave + (F.lane & 31);
#pragma unroll
    for (int ks = 0; ks < 4; ++ks) qf[ks] = *(const bf16x8*)(Qh + (size_t)qi * 64 + 16 * ks + 8 * (F.lane >> 5));
}
__device__ __forceinline__ void attn_stage(Ctx& F, const u32x4 (&kpre)[6], const u32x4 (&vpre)[6]) {
    LAS unsigned char* KL = F.lds; LAS unsigned char* VL = F.lds + 49152;
#pragma unroll
    for (int pass = 0; pass < 6; ++pass) {
        const int idx = pass * NTHR + F.tid, row = idx >> 3, ch = idx & 7;
        *(LAS u32x4*)(KL + row * 128 + ((ch ^ ((row >> 1) & 7)) << 4)) = kpre[pass];
        *(LAS u32x4*)(VL + row * 128 + ((((ch >> 2) ^ ((row >> 1) & 1))) << 6) + (ch & 3) * 16) = vpre[pass];
    }
}
__device__ __forceinline__ void attn_compute(Ctx& F, int bh, int blk, const bf16x8 (&qf)[4], bf16_t* O, float* LSE) {
    const int head = bh % NH, b = bh / NH, grp = head / 5, shift = 2 * grp, L = SEQ >> shift;
    const int row0 = blk * 256, seg = row0 / L, i0 = row0 - seg * L;
    LAS unsigned char* KL = F.lds; LAS unsigned char* VL = F.lds + 49152;
    const int w = F.wave, r32 = F.lane & 31, hi = F.lane >> 5;
    const int qi = i0 + 32 * w + r32;
    f32x16 st[5];
#pragma unroll
    for (int j = 0; j < 5; ++j) {
        st[j] = (f32x16){0.f, 0.f, 0.f, 0.f, 0.f, 0.f, 0.f, 0.f, 0.f, 0.f, 0.f, 0.f, 0.f, 0.f, 0.f, 0.f};
        const int row = 32 * w + 32 * j + r32;
#pragma unroll
        for (int ks = 0; ks < 4; ++ks) {
            const bf16x8 kf = *(const LAS bf16x8*)(KL + row * 128 + (((2 * ks + hi) ^ ((row >> 1) & 7)) << 4));
            st[j] = __builtin_amdgcn_mfma_f32_32x32x16_bf16(kf, qf[ks], st[j], 0, 0, 0);
        }
    }
    float mx = -INFINITY;
    if ((i0 < 64) | (i0 + 320 > L)) {
#pragma unroll
        for (int j = 0; j < 5; ++j)
#pragma unroll
            for (int r = 0; r < 16; ++r) {
                const int cr = crow(r, hi), ki = i0 + 32 * w - 64 + 32 * j + cr;
                bool ok = (ki >= 0) && (ki < L);
                if (j == 0) ok = ok && (cr >= r32);
                if (j == 4) ok = ok && (cr <= r32);
                st[j][r] = ok ? st[j][r] : -INFINITY;
            }
    } else {
#pragma unroll
        for (int r = 0; r < 16; ++r) { const int cr = crow(r, hi); st[0][r] = (cr >= r32) ? st[0][r] : -INFINITY; st[4][r] = (cr <= r32) ? st[4][r] : -INFINITY; }
    }
#pragma unroll
    for (int j = 0; j < 5; ++j)
#pragma unroll
        for (int r = 0; r < 16; ++r) mx = fmaxf(mx, st[j][r]);
    mx = fmaxf(mx, __shfl_xor(mx, 32));
    float sum = 0.f;
#pragma unroll
    for (int j = 0; j < 5; ++j)
#pragma unroll
        for (int r = 0; r < 16; ++r) { const float p = __builtin_amdgcn_exp2f(st[j][r] - mx); st[j][r] = p; sum += p; }
    sum += __shfl_xor(sum, 32);
    f32x16 o[2];
    o[0] = (f32x16){0.f, 0.f, 0.f, 0.f, 0.f, 0.f, 0.f, 0.f, 0.f, 0.f, 0.f, 0.f, 0.f, 0.f, 0.f, 0.f}; o[1] = o[0];
    const int G4 = F.lane >> 4, li = F.lane & 15, qq = li >> 2, pp = li & 3;
#pragma unroll
    for (int j = 0; j < 5; ++j)
#pragma unroll
        for (int s = 0; s < 2; ++s) {
            u32x4 pw; pw.x = cvt_pk_bf16(st[j][8 * s + 0], st[j][8 * s + 1]); pw.y = cvt_pk_bf16(st[j][8 * s + 2], st[j][8 * s + 3]);
            pw.z = cvt_pk_bf16(st[j][8 * s + 4], st[j][8 * s + 5]); pw.w = cvt_pk_bf16(st[j][8 * s + 6], st[j][8 * s + 7]);
            const bf16x8 pf = __builtin_bit_cast(bf16x8, pw);
#pragma unroll
            for (int dt = 0; dt < 2; ++dt) {
                const int rowA = 32 * w + 32 * j + 16 * s + 4 * hi + qq, rowB = rowA + 8;
                const int cb = (16 * (G4 & 1) + 4 * pp) * 2;
                const s16x4 lo = vtr(VL + rowA * 128 + ((dt ^ ((rowA >> 1) & 1)) << 6) + cb);
                const s16x4 hh = vtr(VL + rowB * 128 + ((dt ^ ((rowB >> 1) & 1)) << 6) + cb);
                const bf16x8 vf = (bf16x8){lo[0], lo[1], lo[2], lo[3], hh[0], hh[1], hh[2], hh[3]};
                o[dt] = __builtin_amdgcn_mfma_f32_32x32x16_bf16(vf, pf, o[dt], 0, 0, 0);
            }
        }
    const float inv = 1.0f / sum;
    const size_t tok = (size_t)b * SEQ + ((size_t)qi << shift) + seg;
    LAS unsigned char* stg = F.lds + 98304 + w * 4096;
#pragma unroll
    for (int dt = 0; dt < 2; ++dt)
#pragma unroll
        for (int g = 0; g < 4; ++g) {
            u32x2 w2; w2.x = cvt_pk_bf16(o[dt][4 * g + 0] * inv, o[dt][4 * g + 1] * inv); w2.y = cvt_pk_bf16(o[dt][4 * g + 2] * inv, o[dt][4 * g + 3] * inv);
            *(LAS u32x2*)(stg + r32 * 128 + (((4 * dt + g) ^ (r32 & 7)) << 4) + 8 * hi) = w2;
        }
#pragma unroll
    for (int i = 0; i < 4; ++i) {
        const int row = i * 8 + (F.lane >> 3), c16 = F.lane & 7;
        const u32x4 v = *(const LAS u32x4*)(stg + row * 128 + ((c16 ^ (row & 7)) << 4));
        const unsigned tk = (unsigned)(b * SEQ + ((i0 + 32 * w + row) << shift) + seg);
        *(u32x4*)((char*)O + (size_t)(head * 128) + (tk * (unsigned)(D * 2) + (unsigned)(c16 * 16))) = v;
    }
    if (hi == 0) LSE[tok * 16 + head] = (mx + __builtin_amdgcn_logf(sum)) * 0.6931471805599453f;
}
__device__ __forceinline__ void attn_phase(Ctx& F) {
    const bf16_t* Q = (const bf16_t*)(F.ws + WS_Q); const bf16_t* Kk = (const bf16_t*)(F.ws + WS_K); const bf16_t* V = (const bf16_t*)(F.ws + WS_V);
    bf16_t* O = (bf16_t*)(F.ws + WS_O); float* LSE = (float*)(F.ws + WS_LSE);
    const int nunits = BATCH * NH * 64;
    u32x4 kpre[6], vpre[6]; bf16x8 qf[4];
    int u = F.bx;
    if (u < nunits) attn_load(F, u >> 6, u & 63, Q, Kk, V, kpre, vpre);
    for (; u < nunits; u += F.G) {
        attn_loadq(F, u >> 6, u & 63, Q, qf);
        __syncthreads();
        attn_stage(F, kpre, vpre);
        __syncthreads();
        if (u + F.G < nunits) attn_load(F, (u + F.G) >> 6, (u + F.G) & 63, Q, Kk, V, kpre, vpre);
        attn_compute(F, u >> 6, u & 63, qf, O, LSE);
    }
    const int gt = F.bx * NTHR + F.tid, NGT = F.G * NTHR;
    for (int i = gt; i < T * 8; i += NGT) *(u32x4*)(O + (size_t)(i >> 3) * D + AW + (i & 7) * 8) = (u32x4){0u, 0u, 0u, 0u};
}
__device__ __forceinline__ void combine_phase(Ctx& F) {
    bf16_t* O = (bf16_t*)(F.ws + WS_O); const float* LSE = (const float*)(F.ws + WS_LSE);
    const int gt = F.bx * NTHR + F.tid, NGT = F.G * NTHR;
    for (int i = gt; i < T * 120; i += NGT) {
        const int tok = i / 120, rem = i - tok * 120, head = rem >> 3, ch = rem & 7, hg = head % 5;
        const float l0 = LSE[tok * 16 + hg], l1 = LSE[tok * 16 + hg + 5], l2 = LSE[tok * 16 + hg + 10], lm = LSE[tok * 16 + head];
        const float mx = fmaxf(l0, fmaxf(l1, l2));
        const float a = __expf(lm - mx) / (__expf(l0 - mx) + __expf(l1 - mx) + __expf(l2 - mx));
        u32x4* p = (u32x4*)(O + (size_t)tok * D + head * 64 + ch * 8);
        u32x4 v = *p;
        v.x = pk2(bflo(v.x) * a, bfhi(v.x) * a); v.y = pk2(bflo(v.y) * a, bfhi(v.y) * a); v.z = pk2(bflo(v.z) * a, bfhi(v.z) * a); v.w = pk2(bflo(v.w) * a, bfhi(v.w) * a);
        *p = v;
    }
}

template <bool XBF> __device__ __forceinline__ void route_phase(Ctx& F, int layer, const float* gamma_all, const void* XRv, const bf16_t* Yadd, int alias = 0) {
    const float* XR = (const float*)XRv; const bf16_t* XRb = (const bf16_t*)XRv;
    bf16_t* H = (bf16_t*)(F.ws + WS_H);
    const float* mod = (const float*)(F.ws + WS_MOD) + layer * 2 * 6144;
    const float* gamma = gamma_all + layer * D;
    unsigned* gcnt = (unsigned*)(F.ws + WS_CTL) + CW_CNT + layer * 32 + alias * 64;
    const size_t lbase = alias ? (WS_BIG + 244 * MiB) : WS_LIST;
    int* ltok = (int*)(F.ws + lbase); float* lwa = (float*)(F.ws + lbase + 3 * MiB); float* lwb = (float*)(F.ws + lbase + 6 * MiB);
    LAS float* PL = (LAS float*)F.lds;
    LAS float* PS = (LAS float*)(F.lds + 34816);
    LAS float* GS = (LAS float*)(F.lds + 36864); LAS float* SH = (LAS float*)(F.lds + 40960);
    LAS int* TB = (LAS int*)(F.lds + 45056); LAS float* TWA = (LAS float*)(F.lds + 45568); LAS float* TWB = (LAS float*)(F.lds + 46080);
    LAS int* TRK = (LAS int*)(F.lds + 46592); LAS int* CNT = (LAS int*)(F.lds + 47104); LAS int* BASE = (LAS int*)(F.lds + 47232);
    const int w = F.wave, r32 = F.lane & 31, hi = F.lane >> 5;
    for (int rb = F.bx; rb < T / 128; rb += F.G) {
        const int b = (rb * 128) >> 14;
        __syncthreads();
        for (int k = F.tid; k < D; k += NTHR) { GS[k] = gamma[k] * (1.0f + mod[b * 6144 + 4 * D + k]); SH[k] = mod[b * 6144 + 3 * D + k]; }
        if (F.tid < 32) CNT[F.tid] = 0;
        const bf16_t* WFp = (const bf16_t*)(F.ws + WS_WF) + ((size_t)((layer * 2 + b) * 2) * 64 + 8 * w) * 64 * 8 + F.lane * 8;
        const float* B2 = (const float*)(F.ws + WS_WF + 768 * 1024) + (layer * 2 + b) * 32;
        bf16x8 wfh[8], wfl[8];
#pragma unroll
        for (int ks = 0; ks < 8; ++ks) { wfh[ks] = *(const bf16x8*)(WFp + (size_t)ks * 64 * 8); wfl[ks] = *(const bf16x8*)(WFp + (size_t)(64 + ks) * 64 * 8); }
        for (int it = 0; it < 4; ++it) {
            const int row = rb * 128 + it * 32 + r32;
            const float* xp = XR + (size_t)row * D + 128 * w + 8 * hi;
            f32x4 xv[8][2]; float ss = 0.f;
            const bf16_t* yp = Yadd + (size_t)row * D + 128 * w + 8 * hi;
#pragma unroll
            for (int ks = 0; ks < 8; ++ks) { const u32x4 y = *(const u32x4*)(yp + 16 * ks);
                if constexpr (XBF) { const u32x4 xb = *(const u32x4*)(XRb + (size_t)row * D + 128 * w + 8 * hi + 16 * ks);
                    xv[ks][0] = (f32x4){bflo(xb.x), bfhi(xb.x), bflo(xb.y), bfhi(xb.y)} + (f32x4){bflo(y.x), bfhi(y.x), bflo(y.y), bfhi(y.y)}; xv[ks][1] = (f32x4){bflo(xb.z), bfhi(xb.z), bflo(xb.w), bfhi(xb.w)} + (f32x4){bflo(y.z), bfhi(y.z), bflo(y.w), bfhi(y.w)}; }
                else { xv[ks][0] = *(const f32x4*)(xp + 16 * ks) + (f32x4){bflo(y.x), bfhi(y.x), bflo(y.y), bfhi(y.y)}; xv[ks][1] = *(const f32x4*)(xp + 16 * ks + 4) + (f32x4){bflo(y.z), bfhi(y.z), bflo(y.w), bfhi(y.w)}; } }
            f32x16 acc = (f32x16){0.f, 0.f, 0.f, 0.f, 0.f, 0.f, 0.f, 0.f, 0.f, 0.f, 0.f, 0.f, 0.f, 0.f, 0.f, 0.f};
#pragma unroll
            for (int ks = 0; ks < 8; ++ks) {
                unsigned hw[4], lw[4];
#pragma unroll
                for (int q = 0; q < 2; ++q)
#pragma unroll
                    for (int e = 0; e < 2; ++e) { const float v0 = xv[ks][q][2 * e], v1 = xv[ks][q][2 * e + 1];
                        ss += v0 * v0 + v1 * v1;
                        const unsigned h0 = f2bf(v0), h1 = f2bf(v1);
                        hw[q * 2 + e] = h0 | (h1 << 16);
                        lw[q * 2 + e] = pk2(v0 - __builtin_bit_cast(float, h0 << 16), v1 - __builtin_bit_cast(float, h1 << 16)); }
                const bf16x8 ah = __builtin_bit_cast(bf16x8, (u32x4){hw[0], hw[1], hw[2], hw[3]}), al = __builtin_bit_cast(bf16x8, (u32x4){lw[0], lw[1], lw[2], lw[3]});
                acc = __builtin_amdgcn_mfma_f32_32x32x16_bf16(ah, wfh[ks], acc, 0, 0, 0);
                acc = __builtin_amdgcn_mfma_f32_32x32x16_bf16(al, wfh[ks], acc, 0, 0, 0);
                acc = __builtin_amdgcn_mfma_f32_32x32x16_bf16(ah, wfl[ks], acc, 0, 0, 0);
            }
            ss += __shfl_xor(ss, 32);
            if (hi == 0) PS[w * 32 + r32] = ss;
#pragma unroll
            for (int r = 0; r < 16; ++r) PL[(w * 32 + crow(r, hi)) * 33 + r32] = acc[r];
            __syncthreads();
            float st = 0.f;
#pragma unroll
            for (int ww = 0; ww < 8; ++ww) st += PS[ww * 32 + r32];
            const float r = 1.0f / sqrtf(st * (1.0f / D) + EPS);
            bf16_t* hp = H + (size_t)row * D + 128 * w + 8 * hi;
#pragma unroll
            for (int ks = 0; ks < 8; ++ks) {
                const int k = 128 * w + 16 * ks + 8 * hi;
                const f32x4 g0 = *(const LAS f32x4*)(GS + k), g1 = *(const LAS f32x4*)(GS + k + 4), s0 = *(const LAS f32x4*)(SH + k), s1 = *(const LAS f32x4*)(SH + k + 4);
                const f32x4 h0 = xv[ks][0] * r * g0 + s0, h1 = xv[ks][1] * r * g1 + s1;
                *(u32x4*)(hp + 16 * ks) = (u32x4){pk2(h0[0], h0[1]), pk2(h0[2], h0[3]), pk2(h1[0], h1[1]), pk2(h1[2], h1[3])};
            }
            if (F.tid < 32) {
                float a[20];
#pragma unroll
                for (int j = 0; j < 20; ++j) { float s = 0.f;
#pragma unroll
                    for (int ww = 0; ww < 8; ++ww) s += PL[(ww * 32 + F.tid) * 33 + j];
                    a[j] = r * s + B2[j]; }
                int g = 0; float gm = a[0];
#pragma unroll
                for (int j = 1; j < 4; ++j) if (a[j] > gm) { gm = a[j]; g = j; }
                float den = 0.f;
#pragma unroll
                for (int j = 0; j < 4; ++j) den += __expf(a[j] - gm);
                const float gval = 1.0f / den;
                float el[4];
#pragma unroll
                for (int e = 0; e < 4; ++e) el[e] = g == 0 ? a[4 + e] : (g == 1 ? a[8 + e] : (g == 2 ? a[12 + e] : a[16 + e]));
                int i1 = 0; float v1 = el[0];
#pragma unroll
                for (int e = 1; e < 4; ++e) if (el[e] > v1) { v1 = el[e]; i1 = e; }
                int i2 = -1; float v2 = -INFINITY;
#pragma unroll
                for (int e = 0; e < 4; ++e) if (e != i1 && el[e] > v2) { v2 = el[e]; i2 = e; }
                const float p1 = 1.0f / (1.0f + __expf(v2 - v1)), p2 = 1.0f - p1;
                const float w1 = gval * p1, w2 = gval * p2;
                const int pa = i1 < i2 ? i1 : i2, pb = i1 < i2 ? i2 : i1;
                const int pair = pa == 0 ? pb - 1 : (pa == 1 ? pb + 1 : 5);
                const int lrow = it * 32 + F.tid;
                TB[lrow] = g * 6 + pair; TWA[lrow] = (i1 == pa) ? w1 : w2; TWB[lrow] = (i1 == pa) ? w2 : w1;
            }
            __syncthreads();
        }
        if (F.tid < 128) TRK[F.tid] = atomicAdd((int*)(CNT + TB[F.tid]), 1);
        __syncthreads();
        if (F.tid < NBUCK) BASE[F.tid] = (int)__hip_atomic_fetch_add(gcnt + F.tid, (unsigned)CNT[F.tid], __ATOMIC_RELAXED, __HIP_MEMORY_SCOPE_AGENT);
        __syncthreads();
        if (F.tid < 128) { const int bk = TB[F.tid], pos = BASE[bk] + TRK[F.tid]; const size_t o = (size_t)bk * T + pos;
            ltok[o] = rb * 128 + F.tid; lwa[o] = TWA[F.tid]; lwb[o] = TWB[F.tid]; }
    }
}
__device__ __forceinline__ void gather_phase(Ctx& F, int layer) {
    moe_tab_build(F.lds, (const unsigned*)(F.ws + WS_CTL) + CW_CNT + layer * 32, F.tid);
    const MoeTab tab = moe_tab(F.lds);
    const bf16_t* H = (const bf16_t*)(F.ws + WS_H); bf16_t* HP = (bf16_t*)(F.ws + WS_HP); const int* ltok = (const int*)(F.ws + WS_LIST);
    const int gw = F.bx * NWAVES + F.wave, NGW = F.G * NWAVES, nrows = tab.ntiles * 256;
    for (int row = gw; row < nrows; row += NGW) {
        const int t = row >> 8, bk = tab.tileb(t), cnt = tab.cnt(bk); int idx = (t - tab.tpre(bk)) * 256 + (row & 255); idx = idx < cnt ? idx : cnt - 1;
        const int tok = ltok[(size_t)bk * T + idx];
        const u32x4* s = (const u32x4*)(H + (size_t)tok * D) + F.lane; u32x4* d = (u32x4*)(HP + (size_t)row * D) + F.lane;
        const u32x4 a = s[0], c = s[64]; d[0] = a; d[64] = c;
    }
}

__device__ __forceinline__ void gating_phase(Ctx& F, bf16_t* U, bf16_t* Uout, const bf16_t* V, const float* stats, const float* Ws, const float* gain, const float* bs) {
    LAS unsigned char* VT = F.lds; LAS unsigned char* WL = F.lds + 65536;
    LAS unsigned char* WSL = F.lds + 98304;
    LAS float* MUb = (LAS float*)(F.lds + TOKL_OFF);
    LAS float* RSb = (LAS float*)(F.lds + TOKL_OFF + 1024); LAS float* TP = (LAS float*)(F.lds + TOKL_OFF + 2048);
    LAS float* GNL = (LAS float*)(F.lds + TOKL_OFF + 2560); LAS float* BSL = (LAS float*)(F.lds + TOKL_OFF + 3584);
    const int nunits = 256 * NGRP, g = F.bx & 7;
    const int w = F.wave, r32 = F.lane & 31, hi = F.lane >> 5, G4 = F.lane >> 4, li = F.lane & 15, qq = li >> 2, pp = li & 3;
    const int p_ = F.tid >> 2, qp = F.tid & 3;
    { const f32x4* wp = (const f32x4*)(Ws + ((size_t)g * 128 + p_) * 128 + 32 * qp);
#pragma unroll
      for (int i = 0; i < 4; ++i) { const f32x4 w0 = wp[2 * i], w1 = wp[2 * i + 1];
          *(LAS u32x4*)(WSL + p_ * 256 + (((4 * qp + i) ^ (p_ & 15)) << 4)) = (u32x4){pk2(w0[0], w0[1]), pk2(w0[2], w0[3]), pk2(w1[0], w1[1]), pk2(w1[2], w1[3])}; } }
    const unsigned toff = (unsigned)(((F.tid >> 5) * GH + (F.tid & 31) * 8) * 2);
    constexpr size_t PSTEP = (size_t)16 * GH * 2;
    const unsigned soff = (unsigned)((p_ * 64 + 16 * qp) * 4);
    u32x4 vpre[8]; f32x4 spre[2], sraw[4];
    if (F.tid < 256) GNL[F.tid] = gain[g * 256 + F.tid]; else if (F.tid < 384) BSL[F.tid - 256] = bs[g * 128 + F.tid - 256];
    int u = F.bx;
    __syncthreads();
    if (u < nunits) { const int n = u >> 3;
        { const char* Vb = (const char*)V + ((size_t)n * 128 * GH + g * 256) * 2;
#pragma unroll
          for (int pass = 0; pass < 8; ++pass) vpre[pass] = __builtin_nontemporal_load((const u32x4*)(Vb + pass * PSTEP + toff)); }
        const f32x4* sp = (const f32x4*)((const char*)stats + (size_t)n * 128 * 256 + soff);
        spre[0] = sp[0] + sp[2]; spre[1] = sp[1] + sp[3];
        float s1 = (spre[0].x + spre[0].z) + (spre[1].x + spre[1].z), s2 = (spre[0].y + spre[0].w) + (spre[1].y + spre[1].w);
        s1 += __shfl_xor(s1, 1); s1 += __shfl_xor(s1, 2); s2 += __shfl_xor(s2, 1); s2 += __shfl_xor(s2, 2);
        const float mu = s1 * (1.0f / GH), var = fmaxf(s2 * (1.0f / GH) - mu * mu, 0.f);
        if (qp == 0) { MUb[p_] = mu; RSb[p_] = 1.0f / sqrtf(var + EPS); }
    }
    int par = 0;
    for (; u < nunits; u += F.G, par ^= 1) {
        const int n = u >> 3; const bool has_next = (u + F.G) < nunits; const int nn = (u + F.G) >> 3;
        LAS float* MU = MUb + par * 128; LAS float* RS = RSb + par * 128;
#pragma unroll
        for (int pass = 0; pass < 8; ++pass) { const int idx = pass * NTHR + F.tid, q = idx >> 5, c16 = idx & 31;
            *(LAS u32x4*)(VT + q * 512 + ((((c16 >> 2) ^ (q & 3))) << 6) + (c16 & 3) * 16) = vpre[pass]; }
        __syncthreads();
        { float t = 0.f;
#pragma unroll
          for (int i = 0; i < 4; ++i) {
              const int q0 = 32 * qp + 8 * i;
              const u32x4 wq = *(const LAS u32x4*)(WSL + p_ * 256 + (((4 * qp + i) ^ (p_ & 15)) << 4));
              float wv[8];
              wv[0] = bflo(wq.x) * RS[q0 + 0]; wv[1] = bfhi(wq.x) * RS[q0 + 1]; wv[2] = bflo(wq.y) * RS[q0 + 2]; wv[3] = bfhi(wq.y) * RS[q0 + 3];
              wv[4] = bflo(wq.z) * RS[q0 + 4]; wv[5] = bfhi(wq.z) * RS[q0 + 5]; wv[6] = bflo(wq.w) * RS[q0 + 6]; wv[7] = bfhi(wq.w) * RS[q0 + 7];
#pragma unroll
              for (int j = 0; j < 8; ++j) t += wv[j] * MU[q0 + j];
              const int c = 4 * qp + i;
              *(LAS u32x4*)(WL + p_ * 256 + ((c ^ (p_ & 15)) << 4)) = (u32x4){pk2(wv[0], wv[1]), pk2(wv[2], wv[3]), pk2(wv[4], wv[5]), pk2(wv[6], wv[7])};
          }
          t += __shfl_xor(t, 1); t += __shfl_xor(t, 2);
          if (qp == 0) TP[p_] = t; }
        u32x4 ureg[8];
        { const char* Ub = (const char*)U + ((size_t)n * 128 * GH + g * 256) * 2;
#pragma unroll
          for (int pass = 0; pass < 8; ++pass) ureg[pass] = __builtin_nontemporal_load((const u32x4*)(Ub + pass * PSTEP + toff)); }
        if (has_next) {
            { const char* Vb = (const char*)V + ((size_t)nn * 128 * GH + g * 256) * 2;
#pragma unroll
              for (int pass = 0; pass < 8; ++pass) vpre[pass] = __builtin_nontemporal_load((const u32x4*)(Vb + pass * PSTEP + toff)); }
        }
        __syncthreads();
        f32x16 acc[4];
#pragma unroll
        for (int nt = 0; nt < 4; ++nt) acc[nt] = (f32x16){0.f, 0.f, 0.f, 0.f, 0.f, 0.f, 0.f, 0.f, 0.f, 0.f, 0.f, 0.f, 0.f, 0.f, 0.f, 0.f};
#pragma unroll
        for (int ks = 0; ks < 8; ++ks) {
            const int cbyte = (32 * w + 16 * (G4 & 1) + 4 * pp) * 2;
            const int rA = 16 * ks + 8 * hi + qq, rB = rA + 4;
            const s16x4 lo = vtr(VT + rA * 512 + ((((cbyte >> 6) ^ (rA & 3))) << 6) + (cbyte & 63));
            const s16x4 hh = vtr(VT + rB * 512 + ((((cbyte >> 6) ^ (rB & 3))) << 6) + (cbyte & 63));
            const bf16x8 af = (bf16x8){lo[0], lo[1], lo[2], lo[3], hh[0], hh[1], hh[2], hh[3]};
#pragma unroll
            for (int nt = 0; nt < 4; ++nt) {
                const int p = 32 * nt + r32;
                const bf16x8 bfr = *(const LAS bf16x8*)(WL + p * 256 + (((2 * ks + hi) ^ (p & 15)) << 4));
                acc[nt] = __builtin_amdgcn_mfma_f32_32x32x16_bf16(af, bfr, acc[nt], 0, 0, 0);
            }
        }
        if (has_next) { unsigned so = soff; asm volatile("" : "+v"(so));
            const f32x4* sp = (const f32x4*)((const char*)stats + (size_t)nn * 128 * 256 + so); sraw[0] = sp[0]; sraw[1] = sp[1]; sraw[2] = sp[2]; sraw[3] = sp[3]; }
        __syncthreads();
#pragma unroll
        for (int nt = 0; nt < 4; ++nt) {
            const int p = 32 * nt + r32; const float tp = TP[p], bp = BSL[p];
#pragma unroll
            for (int gq = 0; gq < 4; ++gq) {
                const int c = 32 * w + 8 * gq + 4 * hi; const f32x4 gnv = *(const LAS f32x4*)(GNL + c);
                float o[4];
#pragma unroll
                for (int j = 0; j < 4; ++j) o[j] = gnv[j] * (acc[nt][4 * gq + j] - tp) + bp;
                const int cb = c * 2;
                *(LAS u32x2*)(VT + p * 512 + ((((cb >> 4) ^ (p & 15))) << 4) + (cb & 15)) = (u32x2){pk2(o[0], o[1]), pk2(o[2], o[3])};
            }
        }
        if (has_next) {
            spre[0] = sraw[0] + sraw[2]; spre[1] = sraw[1] + sraw[3];
            float s1 = (spre[0].x + spre[0].z) + (spre[1].x + spre[1].z), s2 = (spre[0].y + spre[0].w) + (spre[1].y + spre[1].w);
            s1 += __shfl_xor(s1, 1); s1 += __shfl_xor(s1, 2); s2 += __shfl_xor(s2, 1); s2 += __shfl_xor(s2, 2);
            const float mu = s1 * (1.0f / GH), var = fmaxf(s2 * (1.0f / GH) - mu * mu, 0.f);
            if (qp == 0) { MUb[(par ^ 1) * 128 + p_] = mu; RSb[(par ^ 1) * 128 + p_] = 1.0f / sqrtf(var + EPS); }
        }
        __syncthreads();
#pragma unroll
        for (int pass = 0; pass < 8; ++pass) {
            const int idx = pass * NTHR + F.tid, p = idx >> 5, c16 = idx & 31;
            const u32x4 vs = *(const LAS u32x4*)(VT + p * 512 + ((c16 ^ (p & 15)) << 4));
            const u32x4 uv = ureg[pass]; u32x4 o;
            o.x = pk2(bflo(uv.x) * bflo(vs.x), bfhi(uv.x) * bfhi(vs.x)); o.y = pk2(bflo(uv.y) * bflo(vs.y), bfhi(uv.y) * bfhi(vs.y));
            o.z = pk2(bflo(uv.z) * bflo(vs.z), bfhi(uv.z) * bfhi(vs.z)); o.w = pk2(bflo(uv.w) * bflo(vs.w), bfhi(uv.w) * bfhi(vs.w));
            *(u32x4*)((char*)Uout + ((size_t)n * 128 * GH + g * 256) * 2 + pass * PSTEP + toff) = o;
        }
        __syncthreads();
    }
}

__global__ void __launch_bounds__(NTHR, 2) mk_fwd(Args args) {
    extern __shared__ __attribute__((aligned(16))) unsigned char lds_[];
    Ctx F;
    F.lds = (LAS unsigned char*)lds_;
    F.wave = __builtin_amdgcn_readfirstlane((int)threadIdx.x >> 6); F.G = gridDim.x; F.bx = blockIdx.x;
#define REFRESH() do { F.lane = lane_now(); F.tid = F.wave * 64 + F.lane; } while (0)
    REFRESH();
    F.out = args.out; F.ws = args.ws;
    unsigned char* ws = args.ws;
    volatile LAS unsigned* MISC = (volatile LAS unsigned*)(F.lds + MISC_OFF);
    for (int u = F.tid; u < (LDS_BYTES - LDSCTL_OFF) / 4; u += NTHR) ((LAS unsigned*)(F.lds + LDSCTL_OFF))[u] = 0u;
    __syncthreads();
    const int lo = args.ph_lo, hi = args.ph_hi;
#if MK_PER_PHASE
#define GRID_BAR(k) do {} while (0)
#else
    cg::grid_group grid = cg::this_grid();
    XcdBarrier bar = xcd_barrier_post((unsigned*)(ws + WS_CTL) + CW_BAR, MISC + 8, F.wave);
    if (lo < 0) grid.sync();
#define GRID_BAR(k) do { xcd_barrier2(bar); REFRESH(); } while (0)
#endif
#define IN(k) (lo <= (k) && (k) < hi)
#ifndef PROBE_REP
#define PROBE_REP -1
#endif
#define NREP(k) (PROBE_REP == (k) ? 2 : 1)
#ifndef PROBE_A
#define PROBE_A -1
#endif
#ifndef PROBE_B
#define PROBE_B -1
#endif
#if PROBE_A >= 0
    unsigned long long* tsb = (unsigned long long*)(ws + WS_CTL + 512 * 1024);
    if (F.bx == 0 && F.tid == 0) tsb[0] = __builtin_amdgcn_s_memrealtime();
#define STAMP(k) do { if (F.bx == 0 && F.tid == 0) tsb[(k) + 1] = __builtin_amdgcn_s_memrealtime(); } while (0)
#else
#define STAMP(k) do {} while (0)
#endif
#define SEAM(k) do { if (IN(k) && IN((k) + 1)) { GRID_BAR(k); STAMP(k); } } while (0)
#define SEAM2(k) do { if (IN(k) && IN((k) + 2)) { GRID_BAR(k); STAMP(k); } } while (0)
    const float* mod = (const float*)(ws + WS_MOD);
    bf16_t* H = (bf16_t*)(ws + WS_H);
    float* XR = args.out;

    if (IN(0)) { for (int rep = 0; rep < NREP(0); ++rep) { p0_prep(F, args); __syncthreads(); } } SEAM(0);
#if !MK_PER_PHASE
    if (PROBE_REP == 100) { for (int i = 0; i < 10; ++i) xcd_barrier2(bar); }
#endif
    if (IN(1)) { for (int rep = 0; rep < NREP(1); ++rep) norm_rows<false>(F, args.in[I_X], args.in[I_NMIX], mod + 0 * D, mod + 1 * D, H); route_prep(F, args.in[I_NFFN]); } SEAM(1);
    if (IN(2)) {
        pg8::DenseOrder S; S.init(H, ws + WS_WQKV, T, NQKVP, D, F.G, F.bx);
        EpiQKV E{(bf16_t*)(ws + WS_Q), (bf16_t*)(ws + WS_K), (bf16_t*)(ws + WS_V), (const float*)(ws + WS_ROPE)};
        for (int rep = 0; rep < NREP(2); ++rep) pg8::gemm_phase<EpiQKV, pg8::DenseOrder>(F.lds, D, S, E, F.wave);
    } SEAM(2);
    if (IN(3)) { for (int rep = 0; rep < NREP(3); ++rep) attn_phase(F); } SEAM(3);
    if (IN(4)) { combine_phase(F); } SEAM(4);
    if (IN(5)) {
        pg8::DenseOrder S; S.init(ws + WS_O, ws + WS_WO, T, D, D, F.G, F.bx);
        EpiY E{(bf16_t*)(ws + WS_Y1), mod + 2 * D};
        for (int rep = 0; rep < NREP(5); ++rep) pg8::gemm_phase<EpiY, pg8::DenseOrder>(F.lds, D, S, E, F.wave);
    } SEAM(5);
#define MOE_LAYER(layer, pb) do { \
        const float* modl = mod + (layer) * 2 * 6144; \
        if (IN(pb)) { route_phase<(layer) == 1>(F, layer, args.in[I_NFFN], (layer) == 0 ? (const void*)args.in[I_X] : (const void*)(ws + WS_XRB), (const bf16_t*)(ws + ((layer) == 0 ? WS_Y1 : WS_Y3))); } SEAM2(pb); \
        if (IN((pb) + 2)) { \
            moe_tab_build(F.lds, (const unsigned*)(ws + WS_CTL) + CW_CNT + (layer) * 32, F.tid); \
            const MoeTab tab = moe_tab(F.lds); \
            MoeOrder S{(const char*)(ws + WS_H), (size_t)0, (const char*)(ws + WS_BGU), 0, layer, tab, tab.ntiles * 4, F.G, F.bx}; \
            S.fill_tokl((const int*)(ws + WS_LIST), F.tid); \
            EpiAct E{(bf16_t*)(ws + WS_ACT), (const float*)(ws + WS_LIST + 3 * MiB), (const float*)(ws + WS_LIST + 6 * MiB), tab}; \
            for (int rep = 0; rep < NREP((pb) + 2); ++rep) pg8::gemm_phase<EpiAct, MoeOrder>(F.lds, D, S, E, F.wave); \
            if ((layer) == 0) { const int lo_ = S.tail_lo();     \
                __syncthreads(); if (F.bx >= lo_) expert_items(F, args, 1, (F.bx - lo_) * NWAVES + F.wave, (F.G - lo_) * NWAVES); } \
        } SEAM((pb) + 2); \
        if (IN((pb) + 3)) { \
            moe_tab_build(F.lds, (const unsigned*)(ws + WS_CTL) + CW_CNT + (layer) * 32, F.tid); \
            const MoeTab tab = moe_tab(F.lds); \
            MoeOrder S{(const char*)(ws + WS_ACT), (size_t)256 * 512 * 2, (const char*)(ws + WS_BDP), 1, layer, tab, tab.ntiles * 4, F.G, F.bx}; \
            EpiDown E{(bf16_t*)(ws + ((layer) == 0 ? WS_Y : WS_Y4)), modl + 5 * D, (const int*)(ws + WS_LIST), tab}; \
            for (int rep = 0; rep < NREP((pb) + 3); ++rep) pg8::gemm_phase<EpiDown, MoeOrder>(F.lds, 512, S, E, F.wave); \
            if ((layer) == 0) { const int lo_ = S.tail_lo();     \
                __syncthreads(); if (F.bx >= lo_) gmlp_items(F, args, (F.bx - lo_) * NWAVES + F.wave, (F.G - lo_) * NWAVES); } \
        } SEAM((pb) + 3); \
    } while (0)
    MOE_LAYER(0, 6);
    if (IN(10)) { norm_rows<true>(F, args.in[I_X], args.in[I_NMIX] + D, mod + 2 * 6144 + 0 * D, mod + 2 * 6144 + 1 * D, H, (const bf16_t*)(ws + WS_Y1), (const bf16_t*)(ws + WS_Y), (bf16_t*)(ws + WS_XRB)); } SEAM(10);
    if (IN(11)) {
        pg8::DenseOrder S; S.init(H, ws + WS_WIN, T, FF, D, F.G, F.bx);
        EpiGelu<0> E{(bf16_t*)(ws + WS_U), (bf16_t*)(ws + WS_VV), (float*)(ws + WS_STATS)};
        if (PROBE_REP == 111) { EpiGelu<1> E1{(bf16_t*)(ws + WS_U), (bf16_t*)(ws + WS_VV), (float*)(ws + WS_STATS)}; pg8::gemm_phase<EpiGelu<1>, pg8::DenseOrder>(F.lds, D, S, E1, F.wave); }
        if (PROBE_REP == 112) { EpiGelu<2> E2{(bf16_t*)(ws + WS_U), (bf16_t*)(ws + WS_VV), (float*)(ws + WS_STATS)}; pg8::gemm_phase<EpiGelu<2>, pg8::DenseOrder>(F.lds, D, S, E2, F.wave); }
        for (int rep = 0; rep < NREP(11); ++rep) pg8::gemm_phase<EpiGelu<0>, pg8::DenseOrder>(F.lds, D, S, E, F.wave);
    } SEAM(11);
    if (IN(12)) {
        for (int rep = 0; rep < NREP(12); ++rep) gating_phase(F, (bf16_t*)(ws + WS_U), (bf16_t*)(ws + (rep == 0 ? WS_U : WS_VV)), (const bf16_t*)(ws + WS_VV), (const float*)(ws + WS_STATS), args.in[I_WS], args.in[I_VGAIN], args.in[I_BS]);
    } SEAM(12);
    if (IN(13)) {
        pg8::DenseOrder S; S.init(ws + WS_U, ws + WS_WO2, T, D, GH, F.G, F.bx);
        EpiY E{(bf16_t*)(ws + WS_Y3), mod + 2 * 6144 + 2 * D};
        for (int rep = 0; rep < NREP(13); ++rep) pg8::gemm_phase<EpiY, pg8::DenseOrder>(F.lds, GH, S, E, F.wave);
    } SEAM(13);
    MOE_LAYER(1, 14);
    if (IN(18)) { final_norm(F, (const bf16_t*)(ws + WS_XRB), XR, args.in[I_FNORM], 1.0f, (const bf16_t*)(ws + WS_Y3), (const bf16_t*)(ws + WS_Y4)); }
}

extern "C" void kernel_launch(void* const* d_in, const int* in_sizes, int n_in, void* d_out, int out_size, void* d_ws, size_t ws_size, hipStream_t stream) {
    static int grid = 0;
    if (grid == 0) {
        if (n_in != 21 || in_sizes[0] != T * D || out_size != T * D || ws_size < WS_END) { fprintf(stderr, "kernel_launch: unexpected problem (n_in %d, in0 %d, out %d, ws %zu)\n", n_in, n_in > 0 ? in_sizes[0] : -1, out_size, ws_size); grid = -1; return; }
        int dev = 0, cus = 0, per_cu = 0;
        (void)hipGetDevice(&dev);
        (void)hipDeviceGetAttribute(&cus, hipDeviceAttributeMultiprocessorCount, dev);
        (void)hipFuncSetAttribute((const void*)mk_fwd, hipFuncAttributeMaxDynamicSharedMemorySize, LDS_BYTES);
        (void)hipOccupancyMaxActiveBlocksPerMultiprocessor(&per_cu, (const void*)mk_fwd, NTHR, LDS_BYTES);
        if (per_cu < 1) { fprintf(stderr, "kernel_launch: occupancy query says %d blocks per CU\n", per_cu); grid = -1; return; }
        grid = cus;
        if (grid % 8 != 0) { fprintf(stderr, "kernel_launch: this kernel needs a CU count that is a multiple of 8 (got %d)\n", grid); grid = -1; return; }
    }
    if (grid < 0) return;
    (void)hipMemsetAsync((char*)d_ws + WS_CTL, 0, CTL_ZERO_BYTES, stream);
    Args a{};
    for (int i = 0; i < 21; ++i) a.in[i] = (const float*)d_in[i];
    a.out = (float*)d_out; a.ws = (unsigned char*)d_ws;
#if MK_PER_PHASE
    for (int p = 0; p < NPHASE; ++p) { a.ph_lo = p; a.ph_hi = p + 1; hipLaunchKernelGGL(mk_fwd, dim3(grid), dim3(NTHR), LDS_BYTES, stream, a); }
#else
    a.ph_lo = 0; a.ph_hi = NPHASE;
    void* kargs[] = {&a};
    hipError_t e = hipLaunchCooperativeKernel((const void*)mk_fwd, dim3(grid), dim3(NTHR), kargs, LDS_BYTES, stream);
    if (e != hipSuccess) fprintf(stderr, "cooperative launch failed: %s (grid %d)\n", hipGetErrorString(e), grid);
#endif
}
```

```cpp
#include <hip/hip_runtime.h>
#include <hip/hip_cooperative_groups.h>
#include <cstdio>
#include <cstdint>
namespace cg = cooperative_groups;

#ifndef MK_PER_PHASE
#define MK_PER_PHASE 0
#endif

#define GAS __attribute__((address_space(1)))
#define LAS __attribute__((address_space(3)))
typedef unsigned short bf16_t;
typedef short bf16x8 __attribute__((ext_vector_type(8)));
typedef short s16x4 __attribute__((ext_vector_type(4)));
typedef float f32x2 __attribute__((ext_vector_type(2)));
typedef float f32x4 __attribute__((ext_vector_type(4)));
typedef float f32x16 __attribute__((ext_vector_type(16)));
typedef unsigned u32x2 __attribute__((ext_vector_type(2)));
typedef unsigned u32x4 __attribute__((ext_vector_type(4)));

constexpr int NWAVES = 8, NTHR = 512;
constexpr int BATCH = 2, SEQ = 16384, T = BATCH * SEQ, D = 1024;
constexpr int NH = 15, HD = 64, AW = 960, NQKV = 2880, NQKVP = 3072;
constexpr int GH = 2048, FF = 4096, CHUNK = 128, NGRP = 8;
constexpr int NEXP = 16, DE = 256, NBUCK = 24, MAXTILES = 152;
constexpr float EPS = 1e-6f;
constexpr float C2 = 0.125f * 1.4426950408889634f;
constexpr int NPHASE = 19;

constexpr size_t MiB = 1u << 20;
constexpr size_t WS_CTL = 0, CTL_ZERO_BYTES = 1 * MiB;
constexpr size_t WS_MOD = 1 * MiB;
constexpr size_t WS_ROPE = 2 * MiB;
constexpr size_t WS_WR = 3 * MiB;
constexpr size_t WS_WQKV = 4 * MiB;
constexpr size_t WS_WO = 10 * MiB;
constexpr size_t WS_WIN = 12 * MiB;
constexpr size_t WS_WO2 = 20 * MiB;
constexpr size_t WS_BGU = 24 * MiB;
constexpr size_t WS_BDP = 56 * MiB;
constexpr size_t WS_H = 104 * MiB;
constexpr size_t WS_LIST = 168 * MiB;
constexpr size_t WS_WF = 177 * MiB;
constexpr size_t WS_STATS = 178 * MiB;
constexpr size_t WS_LSE = 186 * MiB;
constexpr size_t WS_BIG = 192 * MiB;
constexpr size_t WS_Q = WS_BIG, WS_K = WS_BIG + 60 * MiB, WS_V = WS_BIG + 120 * MiB, WS_O = WS_BIG + 180 * MiB;
constexpr size_t WS_HP = WS_BIG, WS_ACT = WS_BIG + 80 * MiB, WS_Y = WS_BIG + 120 * MiB, WS_Y1 = WS_BIG, WS_Y3 = WS_BIG + 128 * MiB, WS_Y4 = WS_BIG;
constexpr size_t WS_U = WS_BIG, WS_VV = WS_BIG + 128 * MiB;
constexpr size_t WS_XRB = 448 * MiB;
constexpr size_t WS_END = 512 * MiB;
constexpr int CW_BAR = 4096;
constexpr int CW_CNT = 16384;

constexpr int RING_BYTES = 131072;
constexpr int LDSCTL_OFF = RING_BYTES, MISC_OFF = LDSCTL_OFF + 320, TAB_OFF = LDSCTL_OFF + 1024;
constexpr int LDS_BYTES = 147456;

__device__ __forceinline__ unsigned f2bf(float f) { unsigned u = __builtin_bit_cast(unsigned, f); return (u + 0x7fffu + ((u >> 16) & 1u)) >> 16; }
__device__ __forceinline__ unsigned pk2(float lo, float hi) { return f2bf(lo) | (f2bf(hi) << 16); }
__device__ __forceinline__ float bf2f(unsigned short v) { return __builtin_bit_cast(float, (unsigned)v << 16); }
__device__ __forceinline__ float bflo(unsigned w) { return __builtin_bit_cast(float, w << 16); }
__device__ __forceinline__ float bfhi(unsigned w) { return __builtin_bit_cast(float, w & 0xffff0000u); }
__device__ __forceinline__ float wave_sum(float v) {
#pragma unroll
    for (int o = 1; o < 64; o <<= 1) v += __shfl_xor(v, o);
    return v;
}
__device__ __forceinline__ float sum16(float v) {
#pragma unroll
    for (int o = 1; o < 16; o <<= 1) v += __shfl_xor(v, o);
    return v;
}
#define LDS_WAIT() asm volatile("s_waitcnt lgkmcnt(0)" ::: "memory")
__device__ __forceinline__ int lane_now() { int l = (int)__builtin_amdgcn_mbcnt_hi(~0u, __builtin_amdgcn_mbcnt_lo(~0u, 0u)); asm volatile("" : "+v"(l)); return l; }

__device__ __forceinline__ int crow(int r, int hi) { return (r & 3) + 8 * (r >> 2) + 4 * hi; }
#define XB_TMO      128
#define XB_XCNT(j)  (256  + 64 * (j))
#define XB_XSUB(j)  (1280 + 64 * (j))
#define XB_XGEN(j)  (2304 + 64 * (j))
#define XB_TOP      3328
#define XB_TOPGEN   3392
#define XCD_BAR_WORDS 3456
#define XB_SPIN_CAP (1u << 22)
__device__ __forceinline__ unsigned xb_ld(unsigned* p)              { return __hip_atomic_load(p, __ATOMIC_RELAXED, __HIP_MEMORY_SCOPE_AGENT); }
__device__ __forceinline__ unsigned xb_add(unsigned* p, unsigned v) { return __hip_atomic_fetch_add(p, v, __ATOMIC_RELAXED, __HIP_MEMORY_SCOPE_AGENT); }
__device__ __forceinline__ unsigned xb_xcc_id() { return (unsigned)__builtin_amdgcn_s_getreg((3 << 11) | 20) & 0xFu; }
#define XB_SPIN(cond, bar) do { unsigned _sp = 0; while (cond) { __builtin_amdgcn_s_sleep(1); \
    if ((++_sp & 255u) == 0u) { if (xb_ld(&(bar)[XB_TMO])) break; if (_sp > XB_SPIN_CAP) { atomicAdd(&(bar)[XB_TMO], 1u); break; } } } } while (0)
struct XcdBarrier { unsigned* bar; unsigned x; volatile LAS unsigned* st; int wave; };
__device__ __forceinline__ XcdBarrier xcd_barrier_post(unsigned* bar, volatile LAS unsigned* st, int wave) {
    XcdBarrier b; b.bar = bar; b.x = xb_xcc_id(); b.st = st; b.wave = wave;
    if (wave == 0 && lane_now() == 0) (void)xb_add(&bar[XB_XCNT(b.x)], 1u);
    return b;
}
__device__ __forceinline__ void xcd_barrier_complete(unsigned* bar, unsigned x, unsigned& nloc, unsigned& nx) {
    const unsigned G = gridDim.x * gridDim.y * gridDim.z;
    unsigned sum, cnt, mine, sp = 0u;
    for (;;) {
        sum = 0u; cnt = 0u; mine = 0u;
#pragma unroll
        for (unsigned j = 0; j < 16; ++j) { const unsigned c = xb_ld(&bar[XB_XCNT(j)]); sum += c; cnt += (c > 0u) ? 1u : 0u; mine = (j == x) ? c : mine; }
        if (sum == G) break;
        __builtin_amdgcn_s_sleep(1);
        if ((++sp & 255u) == 0u) { if (xb_ld(&bar[XB_TMO])) break; if (sp > XB_SPIN_CAP) { atomicAdd(&bar[XB_TMO], 1u); break; } }
    }
    nloc = mine > 0u ? mine : 1u; nx = cnt > 0u ? cnt : 1u;
}
__device__ __forceinline__ void xcd_barrier2(const XcdBarrier& b) {
    asm volatile("s_waitcnt vmcnt(0)" ::: "memory");
    __syncthreads();
    if (b.wave == 0 && lane_now() == 0) {
        unsigned* bar = b.bar;
        __builtin_amdgcn_s_waitcnt(0);
        unsigned nloc = b.st[0], nx = b.st[1];
        if (nloc == 0u) { xcd_barrier_complete(bar, b.x, nloc, nx); b.st[0] = nloc; b.st[1] = nx; }
        const unsigned old = xb_add(&bar[XB_XSUB(b.x)], 1u);
        const unsigned gen = old / nloc;
        __builtin_amdgcn_fence(__ATOMIC_ACQUIRE, "agent");
        if (old + 1u == (gen + 1u) * nloc) {
            __builtin_amdgcn_fence(__ATOMIC_RELEASE, "agent");
            asm volatile("s_waitcnt vmcnt(0)" ::: "memory");
            (void)xb_add(&bar[XB_TOP], 1u);
        }
        XB_SPIN(xb_ld(&bar[XB_TOP]) < (gen + 1u) * nx, bar);
        asm volatile("s_waitcnt vmcnt(0)" ::: "memory");
    }
    __syncthreads();
}

namespace pg8 {
constexpr int BM = 256, BK = 64, HALF = 128, HTB = HALF * BK * 2, NXCD = 8, WGM = 4;
__host__ __device__ __forceinline__ int lds_byte(int r, int c) { const int st = (r >> 4) * 2 + (c >> 5), rr = r & 15, cc = c & 31, ob = rr * 64 + cc * 2; return st * 1024 + (ob ^ (((ob >> 9) & 1) << 5)); }
__host__ __device__ __forceinline__ void stage_rc(int b, int& R, int& C) { const int st = b / 1024, sb = b % 1024, swz = sb ^ (((sb >> 9) & 1) << 5); R = (st >> 1) * 16 + swz / 64; C = (st & 1) * 32 + (swz % 64) / 2; }
__host__ __device__ __forceinline__ int perm32(int rho) { const int n = rho >> 4, i = rho & 15; return 8 * (i >> 2) + 4 * n + (i & 3); }
struct Unit { int pm, pn, h; };
__device__ __forceinline__ int xcd_remap(int L, int nwg) { const int q = nwg / NXCD, r = nwg % NXCD, xcd = L % NXCD, off = L / NXCD; return (xcd < r ? xcd * (q + 1) : r * (q + 1) + (xcd - r) * q) + off; }

struct DenseOrder {
    static constexpr bool HALFCAP = false;
    const char* A; const char* Bt; size_t tstep; int nM, nN, nwg, G, c;
    __device__ void init(const void* A_, const void* Bt_, int M, int N, int K, int G_, int c_) { A = (const char*)A_; Bt = (const char*)Bt_; tstep = (size_t)BM * K * 2; nM = M / BM; nN = N / BM; nwg = nM * nN; G = G_; c = c_; }
    __device__ bool next(int i, Unit& u) const {
        const long L = (long)i * G + c; if (L >= nwg) return false;
        const int wgid = xcd_remap((int)L, nwg);
        const int nig = WGM * nN, gid = wgid / nig, fm = gid * WGM, gsz = (nM - fm) < WGM ? (nM - fm) : WGM;
        u.pm = fm + ((wgid % nig) % gsz); u.pn = (wgid % nig) / gsz; u.h = 0; return true;
    }
    __device__ __forceinline__ const char* abase(const Unit& u) const { return A + (size_t)u.pm * tstep; }
    __device__ __forceinline__ const char* bptr(const Unit& u) const { return Bt + (size_t)u.pn * tstep; }
    __device__ __forceinline__ void aoffs(const Unit&, int, const int (&R)[2], const int (&C)[2], int K, unsigned& v00, unsigned& v01, unsigned& v10, unsigned& v11) const {
        v00 = (unsigned)(R[0] * K + C[0]) * 2u; v01 = (unsigned)(R[1] * K + C[1]) * 2u; v10 = v00 + (unsigned)(HALF * K * 2); v11 = v01 + (unsigned)(HALF * K * 2); }
};

__device__ __forceinline__ unsigned cvt_pk_bf16(float lo, float hi) { unsigned r; asm volatile("v_cvt_pk_bf16_f32 %0, %1, %2" : "=v"(r) : "v"(lo), "v"(hi)); return r; }
__device__ __forceinline__ f32x2 gelu_pk(f32x2 v) {
    const float six = 6.0f; f32x2 x, m;
    asm("v_min_f32_e64 %0, |%1|, %2" : "=v"(x.x) : "v"(v.x), "s"(six)); asm("v_min_f32_e64 %0, |%1|, %2" : "=v"(x.y) : "v"(v.y), "s"(six));
    f32x2 p = x * 3.309498500e-05f + (-7.692387091e-04f); p = p * x + 8.080778804e-03f; p = p * x + (-5.341219989e-02f); p = p * x + (-4.587709027e-01f); p = p * x + (-1.151201725e+00f); p = p * x + (-9.999930587e-01f);
    f32x2 e; e.x = __builtin_amdgcn_exp2f(p.x); e.y = __builtin_amdgcn_exp2f(p.y);
    asm("v_max_f32_e32 %0, 0, %1" : "=v"(m.x) : "v"(v.x)); asm("v_max_f32_e32 %0, 0, %1" : "=v"(m.y) : "v"(v.y));
    return m - x * e;
}

template <class Epi, class Sched, bool ALIGN_EPI = true>
__device__ __forceinline__ void gemm_phase(LAS unsigned char* lds, const int K, const Sched& S, const Epi& E, const int wave) {
    const int lane = lane_now(), wid = wave, tid = wave * 64 + lane, wr = wid >> 2, wc = wid & 3, fr = lane & 15, fq = lane >> 4;
    const int nt = K / BK;
    int RA[2], CA[2]; unsigned voffB[2];
#pragma unroll
    for (int i = 0; i < 2; ++i) { int R, C; stage_rc(tid * 16 + i * 8192, R, C);
        const int Rb = Epi::BMAP ? ((R >> 5) * 64 + perm32(R & 31)) : (Epi::PERM ? ((R & ~31) + perm32(R & 31)) : R);
        RA[i] = R; CA[i] = C; voffB[i] = (unsigned)(Rb * K + C) * 2u; }
    const size_t kstep = (size_t)(BK * 2);
    const size_t hstep = (size_t)(Epi::BMAP ? 32 : HALF) * K * 2;
    const unsigned ldsw = (unsigned)wid * 1024u;
    const int aoff = lds_byte(wr * 64 + fr, fq * 8), boff = lds_byte(wc * 32 + fr, fq * 8);
#define PG8_SA(b, h) (((b) * 2 + (h)) * HTB)
#define PG8_SB(b, h) ((4 + (b) * 2 + (h)) * HTB)
#define PG8_STAGE(bufoff, gbase, v0, v1) do { \
        __builtin_amdgcn_global_load_lds((const unsigned*)((const char*)(gbase) + (v0)), (LAS unsigned*)(lds + (bufoff) + ldsw), 16, 0, 0); \
        __builtin_amdgcn_global_load_lds((const unsigned*)((const char*)(gbase) + (v1)), (LAS unsigned*)(lds + (bufoff) + ldsw + 8192), 16, 0, 0); } while (0)
#define PG8_STB(bufoff, gbase) PG8_STAGE(bufoff, gbase, voffB[0], voffB[1])
#define PG8_LDA(dst, b, h) do { _Pragma("unroll") for (int m = 0; m < 4; ++m) _Pragma("unroll") for (int k = 0; k < 2; ++k) dst[m][k] = *(const LAS bf16x8*)(lds + PG8_SA(b, h) + aoff + m * 2048 + k * 1024); } while (0)
#define PG8_LDB(dst, b, h) do { _Pragma("unroll") for (int n = 0; n < 2; ++n) _Pragma("unroll") for (int k = 0; k < 2; ++k) dst[n][k] = *(const LAS bf16x8*)(lds + PG8_SB(b, h) + boff + n * 2048 + k * 1024); } while (0)
#define PG8_MMA(ai, bj, At, Bt) do { __builtin_amdgcn_s_setprio(1); _Pragma("unroll") for (int m = 0; m < 4; ++m) _Pragma("unroll") for (int n = 0; n < 2; ++n) _Pragma("unroll") for (int k = 0; k < 2; ++k) \
        acc[ai][bj][m][n] = __builtin_amdgcn_mfma_f32_16x16x32_bf16(Bt[n][k], At[m][k], acc[ai][bj][m][n], 0, 0, 0); __builtin_amdgcn_s_setprio(0); } while (0)
#define PG8_WAIT_V(n) asm volatile("s_waitcnt vmcnt(" #n ")" ::: "memory")
#define PG8_WAIT_L(n) asm volatile("s_waitcnt lgkmcnt(" #n ")" ::: "memory")
#define PG8_BAR __builtin_amdgcn_s_barrier()
#define PG8_SCHED __builtin_amdgcn_sched_barrier(0)
    Unit cur, nxt; int ui = 0;
    if (!S.next(0, cur)) return;
    f32x4 acc[2][2][4][2];
#pragma unroll
    for (int a = 0; a < 2; ++a)
#pragma unroll
        for (int b = 0; b < 2; ++b)
#pragma unroll
            for (int m = 0; m < 4; ++m)
#pragma unroll
                for (int n = 0; n < 2; ++n) acc[a][b][m][n] = (f32x4){0.f, 0.f, 0.f, 0.f};
    bf16x8 At[4][2], B0[2][2], B1[2][2];
    const char* cA = S.abase(cur); const char* cB = S.bptr(cur);
    unsigned vA00, vA01, vA10, vA11;
    S.aoffs(cur, 0, RA, CA, K, vA00, vA01, vA10, vA11);
    {
        PG8_STB(PG8_SB(0, 0), cB); PG8_STB(PG8_SB(0, 1), cB + hstep); PG8_STAGE(PG8_SA(0, 0), cA, vA00, vA01); PG8_STAGE(PG8_SA(0, 1), cA, vA10, vA11);
        if (wr == 1) PG8_BAR;
        PG8_WAIT_V(2); PG8_BAR;
        PG8_STB(PG8_SB(1, 0), cB + kstep); PG8_STAGE(PG8_SA(1, 0), cA + kstep, vA00, vA01); PG8_STB(PG8_SB(1, 1), cB + hstep + kstep);
        PG8_WAIT_V(6); PG8_BAR;
    }
    for (;;) {
        const bool has_next = S.next(ui + 1, nxt);
        const char* nA = has_next ? S.abase(nxt) : cA; const char* nB = has_next ? S.bptr(nxt) : cB;
        unsigned nA00 = vA00, nA01 = vA01, nA10 = vA10, nA11 = vA11;
        if (has_next) S.aoffs(nxt, ui + 1, RA, CA, K, nA00, nA01, nA10, nA11);
        const bool full = !Sched::HALFCAP || cur.h == 0;
        for (int t = 0; t < nt; t += 2) {
            const bool last = (t == nt - 2);
            const char* a1 = cA + (size_t)(t + 1) * kstep;
            const char* a2 = last ? nA : cA + (size_t)(t + 2) * kstep; const char* b2 = last ? nB : cB + (size_t)(t + 2) * kstep;
            const char* a3 = a2 + kstep; const char* b3 = b2 + kstep;
            const unsigned w00 = last ? nA00 : vA00, w01 = last ? nA01 : vA01, w10 = last ? nA10 : vA10, w11 = last ? nA11 : vA11;
            PG8_LDB(B0, 0, 0); PG8_LDB(B1, 0, 1); PG8_SCHED; PG8_LDA(At, 0, 0); PG8_STAGE(PG8_SA(1, 1), a1, vA10, vA11);
            PG8_WAIT_V(8); PG8_WAIT_L(0); PG8_BAR; PG8_MMA(0, 0, At, B0); PG8_MMA(0, 1, At, B1); PG8_BAR; PG8_SCHED;
            if (full) PG8_LDA(At, 0, 1); PG8_STB(PG8_SB(0, 0), b2); PG8_STB(PG8_SB(0, 1), b2 + hstep); PG8_STAGE(PG8_SA(0, 0), a2, w00, w01);
            PG8_WAIT_V(8); PG8_WAIT_L(0); PG8_BAR; if (full) { PG8_MMA(1, 0, At, B0); PG8_MMA(1, 1, At, B1); } PG8_BAR; PG8_SCHED;
            PG8_LDB(B0, 1, 0); PG8_LDB(B1, 1, 1); PG8_SCHED; PG8_LDA(At, 1, 0); PG8_STAGE(PG8_SA(0, 1), a2, w10, w11);
            PG8_WAIT_V(8); PG8_WAIT_L(0); PG8_BAR; PG8_MMA(0, 0, At, B0); PG8_MMA(0, 1, At, B1); PG8_BAR; PG8_SCHED;
            if (full) PG8_LDA(At, 1, 1); PG8_STB(PG8_SB(1, 0), b3); PG8_STB(PG8_SB(1, 1), b3 + hstep); PG8_STAGE(PG8_SA(1, 0), a3, w00, w01);
            PG8_WAIT_V(8); PG8_WAIT_L(0); PG8_BAR; if (full) { PG8_MMA(1, 0, At, B0); PG8_MMA(1, 1, At, B1); } PG8_BAR; PG8_SCHED;
        }
        if constexpr (ALIGN_EPI) { if (wr == 0) PG8_BAR; }
        E(acc, cur, wr, wc, fr, fq);
        if (!has_next) break;
#pragma unroll
        for (int a = 0; a < 2; ++a)
#pragma unroll
            for (int b = 0; b < 2; ++b)
#pragma unroll
                for (int m = 0; m < 4; ++m)
#pragma unroll
                    for (int n = 0; n < 2; ++n) acc[a][b][m][n] = (f32x4){0.f, 0.f, 0.f, 0.f};
        cur = nxt; cA = nA; cB = nB; ++ui; vA00 = nA00; vA01 = nA01; vA10 = nA10; vA11 = nA11;
        if constexpr (ALIGN_EPI) { if (wr == 1) PG8_BAR; }
    }
    PG8_WAIT_V(0);
    if constexpr (!ALIGN_EPI) { if (wr == 0) PG8_BAR; }
    PG8_BAR;
#undef PG8_SA
#undef PG8_SB
#undef PG8_STAGE
#undef PG8_STB
#undef PG8_LDA
#undef PG8_LDB
#undef PG8_MMA
#undef PG8_WAIT_V
#undef PG8_WAIT_L
#undef PG8_BAR
#undef PG8_SCHED
}
}
using pg8::Unit;
using pg8::cvt_pk_bf16;


struct EpiQKV {
    static constexpr bool PERM = true; static constexpr int BMAP = 1;
    bf16_t* Q; bf16_t* Kk; bf16_t* V; const float* rope;
    __device__ __forceinline__ void operator()(const f32x4 (&acc)[2][2][4][2], const Unit& u, int wr, int wc, int fr, int fq) const {
#pragma unroll
        for (int bj = 0; bj < 2; ++bj) {
            const int colbase = u.pn * 256 + wc * 64 + bj * 32;
            const int hs = colbase >> 6, half = (colbase >> 5) & 1;
            const int type = hs / NH, head = hs - type * NH;
            if (type >= 3) continue;
            const int grp = head / 5, shift = 2 * grp, L = SEQ >> shift, dmask = (1 << shift) - 1;
            bf16_t* dst = Q + (size_t)type * (60u * 1024u * 1024u / 2u);
            const bool do_rope = (type < 2) && (half == 0) && (fq < 2);
            const float sc = (type == 0) ? C2 : 1.0f;
#pragma unroll
            for (int ai = 0; ai < 2; ++ai) {
                f32x4 cs0[4], cs1[4];
#pragma unroll
                for (int m = 0; m < 4; ++m) {
                    const int s = (u.pm * 256 + ai * 128 + wr * 64 + m * 16 + fr) & (SEQ - 1);
                    if (do_rope) { cs0[m] = *(const f32x4*)(rope + (size_t)s * 16 + fq * 8); cs1[m] = *(const f32x4*)(rope + (size_t)s * 16 + fq * 8 + 4); }
                    else { cs0[m] = (f32x4){1.f, 0.f, 1.f, 0.f}; cs1[m] = cs0[m]; }
                }
#pragma unroll
                for (int m = 0; m < 4; ++m) {
                    const int row = u.pm * 256 + ai * 128 + wr * 64 + m * 16 + fr;
                    const int b = row >> 14, s = row & (SEQ - 1);
                    const int r = s & dmask, i = s >> shift;
                    const size_t drow = (size_t)(b * NH + head) * SEQ + (size_t)r * L + i;
                    f32x4 v0 = acc[ai][bj][m][0], v1 = acc[ai][bj][m][1];
                    const f32x4 c = (f32x4){cs0[m][0], cs0[m][2], cs1[m][0], cs1[m][2]}, sn = (f32x4){cs0[m][1], cs0[m][3], cs1[m][1], cs1[m][3]};
                    const f32x4 lo = v0 * c - v1 * sn, hi = v1 * c + v0 * sn;
                    v0 = lo * sc; v1 = hi * sc;
                    u32x4 w; w.x = cvt_pk_bf16(v0[0], v0[1]); w.y = cvt_pk_bf16(v0[2], v0[3]); w.z = cvt_pk_bf16(v1[0], v1[1]); w.w = cvt_pk_bf16(v1[2], v1[3]);
                    *(u32x4*)(dst + drow * 64 + half * 32 + fq * 8) = w;
                }
            }
        }
    }
};

struct EpiResid {
    static constexpr bool PERM = false; static constexpr int BMAP = 0;
    const float* base; float* out; const float* gate;
    __device__ __forceinline__ void operator()(const f32x4 (&acc)[2][2][4][2], const Unit& u, int wr, int wc, int fr, int fq) const {
        const int row0 = u.pm * 256 + wr * 64 + fr, col0 = u.pn * 256 + wc * 32 + 4 * fq;
        const int b = (u.pm * 256) >> 14;
        f32x4 gv[2][2];
#pragma unroll
        for (int bj = 0; bj < 2; ++bj)
#pragma unroll
            for (int n = 0; n < 2; ++n) gv[bj][n] = *(const f32x4*)(gate + b * 6144 + col0 + bj * 128 + n * 16);
#pragma unroll
        for (int ai = 0; ai < 2; ++ai) {
            f32x4 pre[4][2][2];
#pragma unroll
            for (int m = 0; m < 4; ++m) { const size_t off = (size_t)(row0 + ai * 128 + m * 16) * D + col0;
#pragma unroll
                for (int bj = 0; bj < 2; ++bj)
#pragma unroll
                    for (int n = 0; n < 2; ++n) pre[m][bj][n] = *(const f32x4*)(base + off + bj * 128 + n * 16); }
#pragma unroll
            for (int m = 0; m < 4; ++m) { const size_t off = (size_t)(row0 + ai * 128 + m * 16) * D + col0;
#pragma unroll
                for (int bj = 0; bj < 2; ++bj)
#pragma unroll
                    for (int n = 0; n < 2; ++n) *(f32x4*)(out + off + bj * 128 + n * 16) = pre[m][bj][n] + gv[bj][n] * acc[ai][bj][m][n]; }
        }
    }
};

struct EpiY {
    static constexpr bool PERM = true; static constexpr int BMAP = 1;
    bf16_t* Y; const float* gate;
    __device__ __forceinline__ void operator()(const f32x4 (&acc)[2][2][4][2], const Unit& u, int wr, int wc, int fr, int fq) const {
        const int row0 = u.pm * 256 + wr * 64 + fr, col0 = u.pn * 256 + wc * 64 + 8 * fq;
        const int b = (u.pm * 256) >> 14;
        f32x4 gv[2][2];
#pragma unroll
        for (int bj = 0; bj < 2; ++bj)
#pragma unroll
            for (int n = 0; n < 2; ++n) gv[bj][n] = *(const f32x4*)(gate + b * 6144 + col0 + bj * 32 + n * 4);
#pragma unroll
        for (int ai = 0; ai < 2; ++ai)
#pragma unroll
            for (int m = 0; m < 4; ++m) { bf16_t* yp = Y + (size_t)(row0 + ai * 128 + m * 16) * D + col0;
#pragma unroll
                for (int bj = 0; bj < 2; ++bj) { const f32x4 y0 = gv[bj][0] * acc[ai][bj][m][0], y1 = gv[bj][1] * acc[ai][bj][m][1];
                    *(u32x4*)(yp + bj * 32) = (u32x4){cvt_pk_bf16(y0[0], y0[1]), cvt_pk_bf16(y0[2], y0[3]), cvt_pk_bf16(y1[0], y1[1]), cvt_pk_bf16(y1[2], y1[3])}; } }
    }
};

template <int MODE = 0> struct EpiGelu {
    static constexpr bool PERM = true; static constexpr int BMAP = 1;
    bf16_t* U; bf16_t* V; float* stats;
    template <bool ISV> __device__ __forceinline__ void run(const f32x4 (&acc)[2][2][4][2], const Unit& u, int wr, int wc, int fr, int fq) const {
        bf16_t* dst = ISV ? V : U;
        const int colt = (ISV ? u.pn - 8 : u.pn) * 256 + wc * 64 + 8 * fq;
#pragma unroll
        for (int ai = 0; ai < 2; ++ai)
#pragma unroll
            for (int m = 0; m < 4; ++m) {
                const int row = u.pm * 256 + ai * 128 + wr * 64 + m * 16 + fr;
                f32x2 s1v = {0.f, 0.f}, s2v = {0.f, 0.f};
#pragma unroll
                for (int bj = 0; bj < 2; ++bj) {
                    const f32x4 v0 = acc[ai][bj][m][0], v1 = acc[ai][bj][m][1];
                    if constexpr (MODE == 2) { asm volatile("" :: "v"(v0), "v"(v1)); continue; }
                    const f32x2 a = pg8::gelu_pk((f32x2){v0[0], v0[1]}), bq = pg8::gelu_pk((f32x2){v0[2], v0[3]}), c = pg8::gelu_pk((f32x2){v1[0], v1[1]}), d = pg8::gelu_pk((f32x2){v1[2], v1[3]});
                    if constexpr (ISV) { s1v += (a + bq) + (c + d); s2v = a * a + s2v; s2v = bq * bq + s2v; s2v = c * c + s2v; s2v = d * d + s2v; }
                    u32x4 w; w.x = cvt_pk_bf16(a.x, a.y); w.y = cvt_pk_bf16(bq.x, bq.y); w.z = cvt_pk_bf16(c.x, c.y); w.w = cvt_pk_bf16(d.x, d.y);
                    if constexpr (MODE == 0) __builtin_nontemporal_store(w, (u32x4*)(dst + (size_t)row * GH + colt + bj * 32)); else asm volatile("" :: "v"(w));
                }
                if constexpr (ISV && MODE == 0) {
                    float s1 = s1v.x + s1v.y, s2 = s2v.x + s2v.y;
                    s1 += __shfl_xor(s1, 16); s1 += __shfl_xor(s1, 32); s2 += __shfl_xor(s2, 16); s2 += __shfl_xor(s2, 32);
                    if (fq == 0) *(f32x2*)(stats + ((size_t)row * 32 + (u.pn - 8) * 4 + wc) * 2) = (f32x2){s1, s2};
                }
            }
    }
    __device__ __forceinline__ void operator()(const f32x4 (&acc)[2][2][4][2], const Unit& u, int wr, int wc, int fr, int fq) const {
        if (u.pn >= 8) run<true>(acc, u, wr, wc, fr, fq); else run<false>(acc, u, wr, wc, fr, fq);
    }
};

struct MoeTab { LAS unsigned char* lds; int ntiles;
    __device__ __forceinline__ int cnt(int b) const { return __builtin_amdgcn_readfirstlane(((const LAS int*)(lds + TAB_OFF))[b]); }
    __device__ __forceinline__ int tpre(int b) const { return __builtin_amdgcn_readfirstlane(((const LAS int*)(lds + TAB_OFF + 128))[b]); }
    __device__ __forceinline__ int tileb(int t) const { return __builtin_amdgcn_readfirstlane((int)((const LAS unsigned char*)(lds + TAB_OFF + 256))[t]); }
};
__device__ __forceinline__ MoeTab moe_tab(LAS unsigned char* lds) {
    MoeTab t; t.lds = lds; t.ntiles = __builtin_amdgcn_readfirstlane(((const LAS int*)(lds + TAB_OFF + 128))[24]); return t;
}
__device__ __forceinline__ void moe_tab_build(LAS unsigned char* lds, const unsigned* gcnt, const int t) {
    LAS int* cnt = (LAS int*)(lds + TAB_OFF); LAS int* tpre = (LAS int*)(lds + TAB_OFF + 128); LAS unsigned char* tileb = (LAS unsigned char*)(lds + TAB_OFF + 256);
    __syncthreads();
    if (t < NBUCK) cnt[t] = (int)__hip_atomic_load(gcnt + t, __ATOMIC_RELAXED, __HIP_MEMORY_SCOPE_AGENT);
    __syncthreads();
    if (t <= NBUCK) { int p = 0;
#pragma unroll 1
        for (int j = 0; j < t; ++j) p += (cnt[j] + 255) >> 8;
        tpre[t] = p; }
    __syncthreads();
    if (t < 160) { int b = 0;
#pragma unroll 1
        for (int j = 1; j < NBUCK; ++j) b += (tpre[j] <= t) ? 1 : 0;
        tileb[t] = (unsigned char)b; }
    __syncthreads();
}
__device__ __forceinline__ int pair_a(int p) { return p < 3 ? 0 : (p < 5 ? 1 : 2); }
__device__ __forceinline__ int pair_b(int p) { return p == 0 ? 1 : ((p == 1 || p == 3) ? 2 : 3); }

constexpr int TOKL_OFF = LDSCTL_OFF + 2048;
struct MoeOrder {
    static constexpr bool HALFCAP = true;
    const char* A; size_t tstepA; const char* B; int mode; int layer; MoeTab tab; int nwg, G, c;
    __device__ __forceinline__ bool split() const { return layer == 1; }
    __device__ __forceinline__ int tail_lo() const { const int R = nwg / G, rem = nwg - R * G; return (G - rem >= G / 2) ? rem : 0; }
    __device__ bool next(int i, Unit& u) const {
        const int R = nwg / G, rem = nwg - R * G;
        int L; u.h = 0;
        if (i < R) L = i * G + c;
        else if (i > R) return false;
        else if (!split() || 2 * rem > G) { if (c >= rem) return false; L = R * G + c; }
        else { const int x = c & 7, o = c >> 3, Lt = 8 * (o >> 1) + x; if (Lt >= rem) return false; L = R * G + Lt; u.h = 1 + (o & 1); }
        const int wgid = pg8::xcd_remap(L, nwg); u.pm = wgid >> 2; u.pn = wgid & 3;
        if (u.h == 2) { const int bk = tab.tileb(u.pm); if ((u.pm - tab.tpre(bk)) * 256 + 128 >= tab.cnt(bk)) return false; }
        return true;
    }
    __device__ __forceinline__ const char* abase(const Unit& u) const { return mode == 0 ? A : A + (size_t)u.pm * tstepA; }
    __device__ __forceinline__ const char* bptr(const Unit& u) const {
        const int bk = tab.tileb(u.pm);
        if (mode == 0) { const int g = bk / 6, p = bk - g * 6; const int e = 4 * g + ((u.pn >> 1) ? pair_b(p) : pair_a(p));
            return B + ((size_t)((layer * NEXP + e) * 512 + (u.pn & 1) * 256)) * 1024 * 2; }
        return B + ((size_t)((layer * NBUCK + bk) * 1024 + u.pn * 256)) * 512 * 2;
    }
    __device__ __forceinline__ void aoffs(const Unit& u, int ui, const int (&R)[2], const int (&C)[2], int K, unsigned& v00, unsigned& v01, unsigned& v10, unsigned& v11) const {
        if (mode == 0) { const LAS int* tl = (const LAS int*)(tab.lds + TOKL_OFF) + ui * 256;
            v00 = (unsigned)(tl[R[0]] * K + C[0]) * 2u; v01 = (unsigned)(tl[R[1]] * K + C[1]) * 2u; v10 = (unsigned)(tl[128 + R[0]] * K + C[0]) * 2u; v11 = (unsigned)(tl[128 + R[1]] * K + C[1]) * 2u; }
        else { const unsigned ro = u.h == 2 ? (unsigned)(128 * K * 2) : 0u;
            v00 = (unsigned)(R[0] * K + C[0]) * 2u + ro; v01 = (unsigned)(R[1] * K + C[1]) * 2u + ro; v10 = u.h ? v00 : v00 + (unsigned)(128 * K * 2); v11 = u.h ? v01 : v01 + (unsigned)(128 * K * 2); }
    }
    __device__ __forceinline__ void fill_tokl(const int* ltok, const int tid) const {
        LAS int* tl = (LAS int*)(tab.lds + TOKL_OFF); Unit u;
        for (int i = 0; i < 4 && next(i, u); ++i) {
            const int bk = tab.tileb(u.pm), idx0 = (u.pm - tab.tpre(bk)) * 256, cnt = tab.cnt(bk);
            if (tid < 256) { int idx = idx0 + (u.h ? (tid & 127) + 128 * (u.h - 1) : tid); idx = idx < cnt ? idx : cnt - 1; tl[i * 256 + tid] = ltok[(size_t)bk * T + idx]; }
        }
        __syncthreads();
    }
};

struct EpiAct {
    static constexpr bool PERM = true; static constexpr int BMAP = 0;
    bf16_t* ACT; const float* lwa; const float* lwb; MoeTab tab;
    __device__ __forceinline__ void operator()(const f32x4 (&acc)[2][2][4][2], const Unit& u, int wr, int wc, int fr, int fq) const {
        const int bk = tab.tileb(u.pm), idx0 = (u.pm - tab.tpre(bk)) * 256, cnt = tab.cnt(bk);
        const float* lw = ((u.pn >> 1) ? lwb : lwa) + (size_t)bk * T;
        const int col = u.pn * 128 + wc * 32 + 8 * fq;
        const int roff = u.h == 2 ? 128 : 0;
        float wrow[2][4];
#pragma unroll
        for (int ai = 0; ai < 2; ++ai)
#pragma unroll
            for (int m = 0; m < 4; ++m) { const int idx = idx0 + roff + ai * 128 + wr * 64 + m * 16 + fr; wrow[ai][m] = idx < cnt ? lw[idx] : 0.f; }
#pragma unroll
        for (int ai = 0; ai < 2; ++ai) {
            if (ai == 1 && u.h != 0) continue;
#pragma unroll
            for (int m = 0; m < 4; ++m) {
                const int rl = roff + ai * 128 + wr * 64 + m * 16 + fr;
                const float w = wrow[ai][m];
                float o[8];
#pragma unroll
                for (int n = 0; n < 2; ++n)
#pragma unroll
                    for (int j = 0; j < 4; ++j) { const float g = acc[ai][0][m][n][j], up = acc[ai][1][m][n][j];
                        const float sg = g * __builtin_amdgcn_rcpf(1.0f + __builtin_amdgcn_exp2f(-1.4426950408889634f * g));
                        o[n * 4 + j] = sg * up * w; }
                u32x4 pw; pw.x = cvt_pk_bf16(o[0], o[1]); pw.y = cvt_pk_bf16(o[2], o[3]); pw.z = cvt_pk_bf16(o[4], o[5]); pw.w = cvt_pk_bf16(o[6], o[7]);
                *(u32x4*)(ACT + (size_t)(u.pm * 256 + rl) * 512 + col) = pw;
            }
        }
    }
};

struct EpiDown {
    static constexpr bool PERM = true; static constexpr int BMAP = 1;
    bf16_t* Y; const float* gate; const int* ltok; MoeTab tab;
    __device__ __forceinline__ void operator()(const f32x4 (&acc)[2][2][4][2], const Unit& u, int wr, int wc, int fr, int fq) const {
        const int bk = tab.tileb(u.pm), idx0 = (u.pm - tab.tpre(bk)) * 256, cnt = tab.cnt(bk);
        const int* lt = ltok + (size_t)bk * T;
        const int col0 = u.pn * 256 + wc * 64 + 8 * fq;
        const int roff = u.h == 2 ? 128 : 0;
        int tokr[2][4];
#pragma unroll
        for (int ai = 0; ai < 2; ++ai)
#pragma unroll
            for (int m = 0; m < 4; ++m) { const int idx = idx0 + roff + ai * 128 + wr * 64 + m * 16 + fr; tokr[ai][m] = (idx < cnt && (ai == 0 || u.h == 0)) ? lt[idx] : -1; }
        f32x4 g0[2][2], g1[2][2];
#pragma unroll
        for (int bj = 0; bj < 2; ++bj)
#pragma unroll
            for (int n = 0; n < 2; ++n) { g0[bj][n] = *(const f32x4*)(gate + col0 + bj * 32 + n * 4); g1[bj][n] = *(const f32x4*)(gate + 6144 + col0 + bj * 32 + n * 4); }
#pragma unroll
        for (int ai = 0; ai < 2; ++ai)
#pragma unroll
            for (int m = 0; m < 4; ++m) {
                const int tok = tokr[ai][m];
                if (tok >= 0) {
                    const bool b1 = tok >= SEQ;
#pragma unroll
                    for (int bj = 0; bj < 2; ++bj) {
                        const f32x4 ga = b1 ? g1[bj][0] : g0[bj][0], gb = b1 ? g1[bj][1] : g0[bj][1];
                        const f32x4 y0 = ga * acc[ai][bj][m][0], y1 = gb * acc[ai][bj][m][1];
                        *(u32x4*)(Y + (size_t)tok * D + col0 + bj * 32) = (u32x4){cvt_pk_bf16(y0[0], y0[1]), cvt_pk_bf16(y0[2], y0[3]), cvt_pk_bf16(y1[0], y1[1]), cvt_pk_bf16(y1[2], y1[3])};
                    }
                }
            }
    }
};

struct Args { const float* in[21]; float* out; unsigned char* ws; int ph_lo, ph_hi; };
struct Ctx {
    LAS unsigned char* lds; int tid, lane, wave, G, bx;
    float* out; unsigned char* ws;
};
enum { I_X = 0, I_C, I_NMIX, I_NFFN, I_WADA, I_BADA, I_WQKV, I_AWO, I_WIN, I_VGAIN, I_WS, I_BS, I_BWO, I_RWG, I_RBG, I_RWE, I_RBE, I_EWG, I_EWU, I_EWD, I_FNORM };

__device__ __forceinline__ void tr_load(const float* W, int ldw, int k0, int n0, LAS float* scr, int lane) {
#pragma unroll 8
    for (int i = 0; i < 32; ++i) { const int kk = 2 * i + (lane >> 5); scr[kk * 33 + (lane & 31)] = __builtin_nontemporal_load(W + (size_t)(k0 + kk) * ldw + n0 + (lane & 31)); }
    LDS_WAIT(); asm volatile("" ::: "memory");
}
template <class RowFn> __device__ __forceinline__ void tr_store(LAS float* scr, int lane, RowFn rowfn) {
    const int c = lane & 7;
#pragma unroll
    for (int j = 0; j < 4; ++j) { const int n = (lane >> 3) + 8 * j; const LAS float* s = scr + (8 * c) * 33 + n;
        u32x4 o; o.x = pk2(s[0 * 33], s[1 * 33]); o.y = pk2(s[2 * 33], s[3 * 33]); o.z = pk2(s[4 * 33], s[5 * 33]); o.w = pk2(s[6 * 33], s[7 * 33]);
        bf16_t* p = rowfn(n); if (p) *(u32x4*)(p + 8 * c) = o; }
    LDS_WAIT(); asm volatile("" ::: "memory");
}
__device__ __forceinline__ int qk_perm_row(int n) {
    if (n >= 2 * AW) return n;
    const int d = n & 63; if (d >= 16) return n;
    const int b = d >> 3, rem = d & 7, a = rem >> 2, c = rem & 3;
    return (n & ~63) + 8 * a + 4 * b + c;
}

__device__ __forceinline__ void expert_items(Ctx& F, const Args& A, int layer, int widx, int nw) {
    unsigned char* ws = F.ws;
    LAS float* scr = (LAS float*)(F.lds + F.wave * 16384);
    bf16_t* Bgu = (bf16_t*)(ws + WS_BGU); bf16_t* Bdp = (bf16_t*)(ws + WS_BDP);
    constexpr int I_E = 16 * 16 * 8, I_G = 16 * 4 * 32;
    for (int it = widx; it < 2 * I_E + I_G; it += nw) {
        int r = it;
        if (r < 2 * I_E) { const bool up = r >= I_E; if (up) r -= I_E;
            const int le = layer * 16 + r / 128, q = r % 128, kb = q / 8, nb = q % 8, k0 = kb * 64, n0 = nb * 32;
            tr_load(A.in[up ? I_EWU : I_EWG] + (size_t)le * D * DE, DE, k0, n0, scr, F.lane);
            tr_store(scr, F.lane, [&](int n) { const int j = n0 + n; return Bgu + ((size_t)le * 512 + (j >> 7) * 256 + (up ? 128 : 0) + (j & 127)) * D + k0; }); continue; } r -= 2 * I_E;
        { const int le = layer * 16 + r / 128, q = r % 128, kb = q / 32, nb = q % 32, k0 = kb * 64, n0 = nb * 32;
            const int l = le >> 4, e = le & 15, g = e >> 2, li = e & 3;
            tr_load(A.in[I_EWD] + (size_t)le * DE * D, D, k0, n0, scr, F.lane);
#pragma unroll
            for (int p = 0; p < 6; ++p) { const int pa = pair_a(p), pb = pair_b(p); if (pa != li && pb != li) continue;
                const int koff = (pa == li ? 0 : 256) + k0; bf16_t* base = Bdp + ((size_t)(l * NBUCK + g * 6 + p) * D) * 512 + koff;
                const int c = F.lane & 7;
#pragma unroll
                for (int j = 0; j < 4; ++j) { const int n = (F.lane >> 3) + 8 * j; const LAS float* s = scr + (8 * c) * 33 + n;
                    u32x4 o; o.x = pk2(s[0 * 33], s[1 * 33]); o.y = pk2(s[2 * 33], s[3 * 33]); o.z = pk2(s[4 * 33], s[5 * 33]); o.w = pk2(s[6 * 33], s[7 * 33]);
                    *(u32x4*)(base + (size_t)(n0 + n) * 512 + 8 * c) = o; }
            }
            LDS_WAIT(); asm volatile("" ::: "memory");
        }
    }
}

__device__ __forceinline__ void gmlp_items(Ctx& F, const Args& A, int widx, int nw) {
    unsigned char* ws = F.ws;
    LAS float* scr = (LAS float*)(F.lds + F.wave * 16384);
    bf16_t* Win = (bf16_t*)(ws + WS_WIN); bf16_t* Wo2 = (bf16_t*)(ws + WS_WO2);
    constexpr int I_C2 = 16 * 128, I_D = 32 * 32;
    for (int it = widx; it < I_C2 + I_D; it += nw) {
        int r = it;
        if (r < I_C2) { const int kb = r / 128, nb = r % 128, k0 = kb * 64, n0 = nb * 32; tr_load(A.in[I_WIN], FF, k0, n0, scr, F.lane);
            tr_store(scr, F.lane, [&](int n) { return Win + (size_t)(n0 + n) * D + k0; }); continue; } r -= I_C2;
        { const int kb = r / 32, nb = r % 32, k0 = kb * 64, n0 = nb * 32; tr_load(A.in[I_BWO], D, k0, n0, scr, F.lane);
            tr_store(scr, F.lane, [&](int n) { return Wo2 + (size_t)(n0 + n) * GH + k0; }); }
    }
}
__device__ __forceinline__ void p0_prep(Ctx& F, const Args& A) {
    unsigned char* ws = F.ws;
    {
        LAS float* CA = (LAS float*)F.lds;
        LAS float* RED = (LAS float*)(F.lds + 8192);
        for (int i = F.tid; i < 2 * D; i += NTHR) { const float v = A.in[I_C][i]; CA[i] = v / (1.0f + __expf(-v)); }
        __syncthreads();
        float* mod = (float*)(ws + WS_MOD);
        for (int task = F.bx; task < 192; task += F.G) {
            const int l = task / 96, j0 = (task % 96) * 64;
            const float* W = A.in[I_WADA] + (size_t)l * D * 6144 + j0 + F.lane;
            float a0 = 0.f, a1 = 0.f;
#pragma unroll 1
            for (int k0 = F.wave * 128; k0 < F.wave * 128 + 128; k0 += 32) {
                float wv[32];
#pragma unroll
                for (int j = 0; j < 32; ++j) wv[j] = __builtin_nontemporal_load(W + (size_t)(k0 + j) * 6144);
#pragma unroll
                for (int j = 0; j < 32; ++j) { a0 += CA[k0 + j] * wv[j]; a1 += CA[D + k0 + j] * wv[j]; }
            }
            RED[(F.wave * 2 + 0) * 64 + F.lane] = a0; RED[(F.wave * 2 + 1) * 64 + F.lane] = a1;
            __syncthreads();
            if (F.wave < 2) { float s = 0.f;
#pragma unroll
                for (int w = 0; w < 8; ++w) s += RED[(w * 2 + F.wave) * 64 + F.lane];
                mod[(l * 2 + F.wave) * 6144 + j0 + F.lane] = s + A.in[I_BADA][l * 6144 + j0 + F.lane]; }
            __syncthreads();
        }
    }
    {
        LAS float* scr = (LAS float*)(F.lds + F.wave * 16384);
        const int gw = F.bx * NWAVES + F.wave, NGW = F.G * NWAVES;
        constexpr int I_A = 16 * 90, I_B = 15 * 32;
        constexpr int NITEMS = I_A + I_B;
        bf16_t* Wqkv = (bf16_t*)(ws + WS_WQKV); bf16_t* Wo = (bf16_t*)(ws + WS_WO); bf16_t* Win = (bf16_t*)(ws + WS_WIN); bf16_t* Wo2 = (bf16_t*)(ws + WS_WO2);
        bf16_t* Bgu = (bf16_t*)(ws + WS_BGU); bf16_t* Bdp = (bf16_t*)(ws + WS_BDP);
        for (int it = gw; it < NITEMS; it += NGW) {
            int r = it;
            if (r < I_A) { const int kb = r / 90, nb = r % 90, k0 = kb * 64, n0 = nb * 32; tr_load(A.in[I_WQKV], NQKV, k0, n0, scr, F.lane);
                tr_store(scr, F.lane, [&](int n) { return Wqkv + (size_t)qk_perm_row(n0 + n) * D + k0; }); continue; } r -= I_A;
            if (r < I_B) { const int kb = r / 32, nb = r % 32, k0 = kb * 64, n0 = nb * 32; tr_load(A.in[I_AWO], D, k0, n0, scr, F.lane);
                tr_store(scr, F.lane, [&](int n) { return Wo + (size_t)(n0 + n) * D + k0; }); continue; } r -= I_B;
        }
        expert_items(F, A, 0, gw, NGW);
        const int gt = F.bx * NTHR + F.tid, NGT = F.G * NTHR;
        for (int i = gt; i < 192 * 128; i += NGT) *(u32x4*)(Wqkv + (size_t)NQKV * D + (size_t)i * 8) = (u32x4){0u, 0u, 0u, 0u};
        for (int i = gt; i < 1024 * 8; i += NGT) *(u32x4*)(Wo + (size_t)(i >> 3) * D + AW + (i & 7) * 8) = (u32x4){0u, 0u, 0u, 0u};
        float* rope = (float*)(ws + WS_ROPE);
        for (int i = gt; i < SEQ * 8; i += NGT) { const int pos = i >> 3, j = i & 7; const double inv = pow(500000.0, -(double)j / 8.0); const double ang = (double)pos * inv;
            rope[i * 2] = (float)cos(ang); rope[i * 2 + 1] = (float)sin(ang); }
        float* WR = (float*)(ws + WS_WR); float* WRB = (float*)(ws + WS_WR + 512 * 1024);
        for (int i = gt; i < 2 * D * 20; i += NGT) { const int l = i / (D * 20), rem = i % (D * 20), k = rem / 20, j = rem % 20;
            WR[i] = j < 4 ? A.in[I_RWG][((size_t)l * D + k) * 4 + j] : A.in[I_RWE][(((size_t)l * 4 + ((j - 4) >> 2)) * D + k) * 4 + ((j - 4) & 3)]; }
        for (int i = gt; i < 2 * 20; i += NGT) { const int l = i / 20, j = i % 20; WRB[l * 32 + j] = j < 4 ? A.in[I_RBG][l * 4 + j] : A.in[I_RBE][l * 16 + (j - 4)]; }
    }
}


__device__ __forceinline__ void route_prep(Ctx& F, const float* norm_ffn) {
    const float* mod = (const float*)(F.ws + WS_MOD);
    const float* WR = (const float*)(F.ws + WS_WR); const float* WRB = (const float*)(F.ws + WS_WR + 512 * 1024);
    bf16_t* WF = (bf16_t*)(F.ws + WS_WF); float* B2 = (float*)(F.ws + WS_WF + 768 * 1024);
    const int gt = F.bx * NTHR + F.tid, NGT = F.G * NTHR;
    for (int i = gt; i < 2 * 2 * 64 * 64; i += NGT) {
        const int lane = i & 63, ks = (i >> 6) & 63, b = (i >> 12) & 1, l = i >> 13;
        const int n = lane & 31, k0 = 16 * ks + 8 * (lane >> 5);
        unsigned hiw[4], low[4];
#pragma unroll
        for (int j2 = 0; j2 < 4; ++j2) {
            float v[2];
#pragma unroll
            for (int e = 0; e < 2; ++e) { const int k = k0 + 2 * j2 + e;
                const float gs = norm_ffn[l * D + k] * (1.0f + mod[(l * 2 + b) * 6144 + 4 * D + k]);
                v[e] = n < 20 ? gs * WR[((size_t)l * D + k) * 20 + n] : 0.f; }
            const unsigned h0 = f2bf(v[0]), h1 = f2bf(v[1]);
            hiw[j2] = h0 | (h1 << 16);
            low[j2] = pk2(v[0] - bf2f((unsigned short)h0), v[1] - bf2f((unsigned short)h1));
        }
        const size_t o = ((size_t)((l * 2 + b) * 2) * 64 + ks) * 64 + lane;
        *(u32x4*)(WF + o * 8) = (u32x4){hiw[0], hiw[1], hiw[2], hiw[3]};
        *(u32x4*)(WF + (o + 64 * 64) * 8) = (u32x4){low[0], low[1], low[2], low[3]};
    }
    const int gw = F.bx * NWAVES + F.wave, NGW = F.G * NWAVES;
    for (int i = gw; i < 2 * 2 * 20; i += NGW) {
        const int n = i % 20, lb = i / 20, l = lb >> 1; float s = 0.f;
        for (int k = F.lane; k < D; k += 64) s += mod[lb * 6144 + 3 * D + k] * WR[((size_t)l * D + k) * 20 + n];
        s = wave_sum(s);
        if (F.lane == 0) B2[lb * 32 + n] = s + WRB[l * 32 + n];
    }
}

template <bool ADDY> __device__ __forceinline__ void norm_rows(Ctx& F, const float* src, const float* gamma, const float* sh, const float* sc, bf16_t* dst, const bf16_t* Y = nullptr, const bf16_t* Yb = nullptr, bf16_t* xwb = nullptr) {
    const int gw = F.bx * NWAVES + F.wave, NGW = F.G * NWAVES;
    f32x4 gs[4], shv[4]; int curb = -1;
    for (int m = gw; m < T; m += NGW) {
        const int b = m >> 14;
        if (b != curb) { curb = b;
#pragma unroll
            for (int j = 0; j < 4; ++j) { const int k = 4 * F.lane + 256 * j; const f32x4 g = *(const f32x4*)(gamma + k), s = *(const f32x4*)(sc + b * 6144 + k); gs[j] = g * (s + 1.0f); shv[j] = *(const f32x4*)(sh + b * 6144 + k); } }
        const f32x4* xr = (const f32x4*)(src + (size_t)m * D) + F.lane;
        f32x4 v[4]; float ss = 0.f;
        u32x2 yv[4], y2v[4];
#pragma unroll
        for (int j = 0; j < 4; ++j) { v[j] = __builtin_nontemporal_load(xr + 64 * j);
            if constexpr (ADDY) { yv[j] = __builtin_nontemporal_load((const u32x2*)(Y + (size_t)m * D) + F.lane + 64 * j); y2v[j] = __builtin_nontemporal_load((const u32x2*)(Yb + (size_t)m * D) + F.lane + 64 * j); } }
#pragma unroll
        for (int j = 0; j < 4; ++j) {
            if constexpr (ADDY) { const u32x2 y = yv[j], y2 = y2v[j];
                v[j] = (v[j] + (f32x4){bflo(y.x), bfhi(y.x), bflo(y.y), bfhi(y.y)}) + (f32x4){bflo(y2.x), bfhi(y2.x), bflo(y2.y), bfhi(y2.y)}; __builtin_nontemporal_store((u32x2){pk2(v[j].x, v[j].y), pk2(v[j].z, v[j].w)}, (u32x2*)(xwb + (size_t)m * D) + F.lane + 64 * j); }
            ss += (v[j].x * v[j].x + v[j].y * v[j].y) + (v[j].z * v[j].z + v[j].w * v[j].w); }
        const float r = 1.0f / sqrtf(wave_sum(ss) * (1.0f / D) + EPS);
        u32x2* o8 = (u32x2*)(dst + (size_t)m * D) + F.lane;
#pragma unroll
        for (int j = 0; j < 4; ++j) { const f32x4 h = v[j] * r * gs[j] + shv[j]; o8[64 * j] = (u32x2){pk2(h.x, h.y), pk2(h.z, h.w)}; }
    }
}
__device__ __forceinline__ void final_norm(Ctx& F, const bf16_t* xr_, float* dst_, const float* gamma, const float oscale, const bf16_t* Y, const bf16_t* Yb) {
    const int gw = F.bx * NWAVES + F.wave, NGW = F.G * NWAVES;
    f32x4 gs[4];
#pragma unroll
    for (int j = 0; j < 4; ++j) gs[j] = *(const f32x4*)(gamma + 4 * F.lane + 256 * j) * oscale;
    for (int m = gw; m < T; m += NGW) {
        const u32x2* xr = (const u32x2*)(xr_ + (size_t)m * D) + F.lane;
        f32x4 v[4]; float ss = 0.f;
#pragma unroll
        for (int j = 0; j < 4; ++j) { { const u32x2 xb = __builtin_nontemporal_load(xr + 64 * j); v[j] = (f32x4){bflo(xb.x), bfhi(xb.x), bflo(xb.y), bfhi(xb.y)}; } const u32x2 y = __builtin_nontemporal_load((const u32x2*)(Y + (size_t)m * D) + F.lane + 64 * j), y2 = __builtin_nontemporal_load((const u32x2*)(Yb + (size_t)m * D) + F.lane + 64 * j);
            v[j] = (v[j] + (f32x4){bflo(y.x), bfhi(y.x), bflo(y.y), bfhi(y.y)}) + (f32x4){bflo(y2.x), bfhi(y2.x), bflo(y2.y), bfhi(y2.y)};
            ss += (v[j].x * v[j].x + v[j].y * v[j].y) + (v[j].z * v[j].z + v[j].w * v[j].w); }
        const float r = 1.0f / sqrtf(wave_sum(ss) * (1.0f / D) + EPS);
        f32x4* dr = (f32x4*)(dst_ + (size_t)m * D) + F.lane;
#pragma unroll
        for (int j = 0; j < 4; ++j) __builtin_nontemporal_store(v[j] * r * gs[j], dr + 64 * j);
    }
}

__device__ __forceinline__ s16x4 vtr(const LAS unsigned char* p) { typedef short v4i16_t __attribute__((ext_vector_type(4))); return __builtin_bit_cast(s16x4, __builtin_amdgcn_ds_read_tr16_b64_v4i16((LAS v4i16_t*)p)); }
__device__ __forceinline__ void attn_load(Ctx& F, int bh, int blk, const bf16_t* Q, const bf16_t* Kk, const bf16_t* V, u32x4 (&kpre)[6], u32x4 (&vpre)[6]) {
    const int head = bh % NH, grp = head / 5, shift = 2 * grp, L = SEQ >> shift;
    const int row0 = blk * 256, seg = row0 / L, i0 = row0 - seg * L;
    const size_t hbase = ((size_t)bh * SEQ + (size_t)seg * L) * 64;
    const bf16_t* Kh = Kk + hbase; const bf16_t* Vh = V + hbase;
#pragma unroll
    for (int pass = 0; pass < 6; ++pass) {
        const int idx = pass * NTHR + F.tid, row = idx >> 3, ch = idx & 7;
        int i = i0 - 64 + row; i = i < 0 ? 0 : (i > L - 1 ? L - 1 : i);
        kpre[pass] = __builtin_nontemporal_load((const u32x4*)(Kh + (size_t)i * 64 + ch * 8)); vpre[pass] = __builtin_nontemporal_load((const u32x4*)(Vh + (size_t)i * 64 + ch * 8));
    }
}
__device__ __forceinline__ void attn_loadq(Ctx& F, int bh, int blk, const bf16_t* Q, bf16x8 (&qf)[4]) {
    const int head = bh % NH, grp = head / 5, shift = 2 * grp, L = SEQ >> shift;
    const int row0 = blk * 256, seg = row0 / L, i0 = row0 - seg * L;
    const bf16_t* Qh = Q + ((size_t)bh * SEQ + (size_t)seg * L) * 64;
    const int qi = i0 + 32 * F.wave + (F.lane & 31);
#pragma unroll
    for (int ks = 0; ks < 4; ++ks) qf[ks] = *(const bf16x8*)(Qh + (size_t)qi * 64 + 16 * ks + 8 * (F.lane >> 5));
}
__device__ __forceinline__ void attn_stage(Ctx& F, const u32x4 (&kpre)[6], const u32x4 (&vpre)[6]) {
    LAS unsigned char* KL = F.lds; LAS unsigned char* VL = F.lds + 49152;
#pragma unroll
    for (int pass = 0; pass < 6; ++pass) {
        const int idx = pass * NTHR + F.tid, row = idx >> 3, ch = idx & 7;
        *(LAS u32x4*)(KL + row * 128 + ((ch ^ ((row >> 1) & 7)) << 4)) = kpre[pass];
        *(LAS u32x4*)(VL + row * 128 + ((((ch >> 2) ^ ((row >> 1) & 1))) << 6) + (ch & 3) * 16) = vpre[pass];
    }
}
__device__ __forceinline__ void attn_compute(Ctx& F, int bh, int blk, const bf16x8 (&qf)[4], bf16_t* O, float* LSE) {
    const int head = bh % NH, b = bh / NH, grp = head / 5, shift = 2 * grp, L = SEQ >> shift;
    const int row0 = blk * 256, seg = row0 / L, i0 = row0 - seg * L;
    LAS unsigned char* KL = F.lds; LAS unsigned char* VL = F.lds + 49152;
    const int w = F.wave, r32 = F.lane & 31, hi = F.lane >> 5;
    const int qi = i0 + 32 * w + r32;
    f32x16 st[5];
#pragma unroll
    for (int j = 0; j < 5; ++j) {
        st[j] = (f32x16){0.f, 0.f, 0.f, 0.f, 0.f, 0.f, 0.f, 0.f, 0.f, 0.f, 0.f, 0.f, 0.f, 0.f, 0.f, 0.f};
        const int row = 32 * w + 32 * j + r32;
#pragma unroll
        for (int ks = 0; ks < 4; ++ks) {
            const bf16x8 kf = *(const LAS bf16x8*)(KL + row * 128 + (((2 * ks + hi) ^ ((row >> 1) & 7)) << 4));
            st[j] = __builtin_amdgcn_mfma_f32_32x32x16_bf16(kf, qf[ks], st[j], 0, 0, 0);
        }
    }
    float mx = -INFINITY;
    if ((i0 < 64) | (i0 + 320 > L)) {
#pragma unroll
        for (int j = 0; j < 5; ++j)
#pragma unroll
            for (int r = 0; r < 16; ++r) {
                const int cr = crow(r, hi), ki = i0 + 32 * w - 64 + 32 * j + cr;
                bool ok = (ki >= 0) && (ki < L);
                if (j == 0) ok = ok && (cr >= r32);
                if (j == 4) ok = ok && (cr <= r32);
                st[j][r] = ok ? st[j][r] : -INFINITY;
            }
    } else {
#pragma unroll
        for (int r = 0; r < 16; ++r) { const int cr = crow(r, hi); st[0][r] = (cr >= r32) ? st[0][r] : -INFINITY; st[4][r] = (cr <= r32) ? st[4][r] : -INFINITY; }
    }
#pragma unroll
    for (int j = 0; j < 5; ++j)
#pragma unroll
        for (int r = 0; r < 16; ++r) mx = fmaxf(mx, st[j][r]);
    mx = fmaxf(mx, __shfl_xor(mx, 32));
    float sum = 0.f;
#pragma unroll
    for (int j = 0; j < 5; ++j)
#pragma unroll
        for (int r = 0; r < 16; ++r) { const float p = __builtin_amdgcn_exp2f(st[j][r] - mx); st[j][r] = p; sum += p; }
    sum += __shfl_xor(sum, 32);
    f32x16 o[2];
    o[0] = (f32x16){0.f, 0.f, 0.f, 0.f, 0.f, 0.f, 0.f, 0.f, 0.f, 0.f, 0.f, 0.f, 0.f, 0.f, 0.f, 0.f}; o[1] = o[0];
    const int G4 = F.lane >> 4, li = F.lane & 15, qq = li >> 2, pp = li & 3;
#pragma unroll
    for (int j = 0; j < 5; ++j)
#pragma unroll
        for (int s = 0; s < 2; ++s) {
            u32x4 pw; pw.x = cvt_pk_bf16(st[j][8 * s + 0], st[j][8 * s + 1]); pw.y = cvt_pk_bf16(st[j][8 * s + 2], st[j][8 * s + 3]);
            pw.z = cvt_pk_bf16(st[j][8 * s + 4], st[j][8 * s + 5]); pw.w = cvt_pk_bf16(st[j][8 * s + 6], st[j][8 * s + 7]);
            const bf16x8 pf = __builtin_bit_cast(bf16x8, pw);
#pragma unroll
            for (int dt = 0; dt < 2; ++dt) {
                const int rowA = 32 * w + 32 * j + 16 * s + 4 * hi + qq, rowB = rowA + 8;
                const int cb = (16 * (G4 & 1) + 4 * pp) * 2;
                const s16x4 lo = vtr(VL + rowA * 128 + ((dt ^ ((rowA >> 1) & 1)) << 6) + cb);
                const s16x4 hh = vtr(VL + rowB * 128 + ((dt ^ ((rowB >> 1) & 1)) << 6) + cb);
                const bf16x8 vf = (bf16x8){lo[0], lo[1], lo[2], lo[3], hh[0], hh[1], hh[2], hh[3]};
                o[dt] = __builtin_amdgcn_mfma_f32_32x32x16_bf16(vf, pf, o[dt], 0, 0, 0);
            }
        }
    const float inv = 1.0f / sum;
    const size_t tok = (size_t)b * SEQ + ((size_t)qi << shift) + seg;
    LAS unsigned char* stg = F.lds + 98304 + w * 4096;
#pragma unroll
    for (int dt = 0; dt < 2; ++dt)
#pragma unroll
        for (int g = 0; g < 4; ++g) {
            u32x2 w2; w2.x = cvt_pk_bf16(o[dt][4 * g + 0] * inv, o[dt][4 * g + 1] * inv); w2.y = cvt_pk_bf16(o[dt][4 * g + 2] * inv, o[dt][4 * g + 3] * inv);
            *(LAS u32x2*)(stg + r32 * 128 + (((4 * dt + g) ^ (r32 & 7)) << 4) + 8 * hi) = w2;
        }
#pragma unroll
    for (int i = 0; i < 4; ++i) {
        const int row = i * 8 + (F.lane >> 3), c16 = F.lane & 7;
        const u32x4 v = *(const LAS u32x4*)(stg + row * 128 + ((c16 ^ (row & 7)) << 4));
        const unsigned tk = (unsigned)(b * SEQ + ((i0 + 32 * w + row) << shift) + seg);
        *(u32x4*)((char*)O + (size_t)(head * 128) + (tk * (unsigned)(D * 2) + (unsigned)(c16 * 16))) = v;
    }
    if (hi == 0) LSE[tok * 16 + head] = (mx + __builtin_amdgcn_logf(sum)) * 0.6931471805599453f;
}
__device__ __forceinline__ void attn_phase(Ctx& F) {
    const bf16_t* Q = (const bf16_t*)(F.ws + WS_Q); const bf16_t* Kk = (const bf16_t*)(F.ws + WS_K); const bf16_t* V = (const bf16_t*)(F.ws + WS_V);
    bf16_t* O = (bf16_t*)(F.ws + WS_O); float* LSE = (float*)(F.ws + WS_LSE);
    const int nunits = BATCH * NH * 64;
    u32x4 kpre[6], vpre[6]; bf16x8 qf[4];
    int u = F.bx;
    if (u < nunits) attn_load(F, u >> 6, u & 63, Q, Kk, V, kpre, vpre);
    for (; u < nunits; u += F.G) {
        attn_loadq(F, u >> 6, u & 63, Q, qf);
        __syncthreads();
        attn_stage(F, kpre, vpre);
        __syncthreads();
        if (u + F.G < nunits) attn_load(F, (u + F.G) >> 6, (u + F.G) & 63, Q, Kk, V, kpre, vpre);
        attn_compute(F, u >> 6, u & 63, qf, O, LSE);
    }
    const int gt = F.bx * NTHR + F.tid, NGT = F.G * NTHR;
    for (int i = gt; i < T * 8; i += NGT) *(u32x4*)(O + (size_t)(i >> 3) * D + AW + (i & 7) * 8) = (u32x4){0u, 0u, 0u, 0u};
}
__device__ __forceinline__ void combine_phase(Ctx& F) {
    bf16_t* O = (bf16_t*)(F.ws + WS_O); const float* LSE = (const float*)(F.ws + WS_LSE);
    const int gt = F.bx * NTHR + F.tid, NGT = F.G * NTHR;
    for (int i = gt; i < T * 120; i += NGT) {
        const int tok = i / 120, rem = i - tok * 120, head = rem >> 3, ch = rem & 7, hg = head % 5;
        const float l0 = LSE[tok * 16 + hg], l1 = LSE[tok * 16 + hg + 5], l2 = LSE[tok * 16 + hg + 10], lm = LSE[tok * 16 + head];
        const float mx = fmaxf(l0, fmaxf(l1, l2));
        const float a = __expf(lm - mx) / (__expf(l0 - mx) + __expf(l1 - mx) + __expf(l2 - mx));
        u32x4* p = (u32x4*)(O + (size_t)tok * D + head * 64 + ch * 8);
        u32x4 v = *p;
        v.x = pk2(bflo(v.x) * a, bfhi(v.x) * a); v.y = pk2(bflo(v.y) * a, bfhi(v.y) * a); v.z = pk2(bflo(v.z) * a, bfhi(v.z) * a); v.w = pk2(bflo(v.w) * a, bfhi(v.w) * a);
        *p = v;
    }
}

template <bool XBF> __device__ __forceinline__ void route_phase(Ctx& F, int layer, const float* gamma_all, const void* XRv, const bf16_t* Yadd, int alias = 0) {
    const float* XR = (const float*)XRv; const bf16_t* XRb = (const bf16_t*)XRv;
    bf16_t* H = (bf16_t*)(F.ws + WS_H);
    const float* mod = (const float*)(F.ws + WS_MOD) + layer * 2 * 6144;
    const float* gamma = gamma_all + layer * D;
    unsigned* gcnt = (unsigned*)(F.ws + WS_CTL) + CW_CNT + layer * 32 + alias * 64;
    const size_t lbase = alias ? (WS_BIG + 244 * MiB) : WS_LIST;
    int* ltok = (int*)(F.ws + lbase); float* lwa = (float*)(F.ws + lbase + 3 * MiB); float* lwb = (float*)(F.ws + lbase + 6 * MiB);
    LAS float* PL = (LAS float*)F.lds;
    LAS float* PS = (LAS float*)(F.lds + 34816);
    LAS float* GS = (LAS float*)(F.lds + 36864); LAS float* SH = (LAS float*)(F.lds + 40960);
    LAS int* TB = (LAS int*)(F.lds + 45056); LAS float* TWA = (LAS float*)(F.lds + 45568); LAS float* TWB = (LAS float*)(F.lds + 46080);
    LAS int* TRK = (LAS int*)(F.lds + 46592); LAS int* CNT = (LAS int*)(F.lds + 47104); LAS int* BASE = (LAS int*)(F.lds + 47232);
    const int w = F.wave, r32 = F.lane & 31, hi = F.lane >> 5;
    for (int rb = F.bx; rb < T / 128; rb += F.G) {
        const int b = (rb * 128) >> 14;
        __syncthreads();
        for (int k = F.tid; k < D; k += NTHR) { GS[k] = gamma[k] * (1.0f + mod[b * 6144 + 4 * D + k]); SH[k] = mod[b * 6144 + 3 * D + k]; }
        if (F.tid < 32) CNT[F.tid] = 0;
        const bf16_t* WFp = (const bf16_t*)(F.ws + WS_WF) + ((size_t)((layer * 2 + b) * 2) * 64 + 8 * w) * 64 * 8 + F.lane * 8;
        const float* B2 = (const float*)(F.ws + WS_WF + 768 * 1024) + (layer * 2 + b) * 32;
        bf16x8 wfh[8], wfl[8];
#pragma unroll
        for (int ks = 0; ks < 8; ++ks) { wfh[ks] = *(const bf16x8*)(WFp + (size_t)ks * 64 * 8); wfl[ks] = *(const bf16x8*)(WFp + (size_t)(64 + ks) * 64 * 8); }
        for (int it = 0; it < 4; ++it) {
            const int row = rb * 128 + it * 32 + r32;
            const float* xp = XR + (size_t)row * D + 128 * w + 8 * hi;
            f32x4 xv[8][2]; float ss = 0.f;
            const bf16_t* yp = Yadd + (size_t)row * D + 128 * w + 8 * hi;
#pragma unroll
            for (int ks = 0; ks < 8; ++ks) { const u32x4 y = *(const u32x4*)(yp + 16 * ks);
                if constexpr (XBF) { const u32x4 xb = *(const u32x4*)(XRb + (size_t)row * D + 128 * w + 8 * hi + 16 * ks);
                    xv[ks][0] = (f32x4){bflo(xb.x), bfhi(xb.x), bflo(xb.y), bfhi(xb.y)} + (f32x4){bflo(y.x), bfhi(y.x), bflo(y.y), bfhi(y.y)}; xv[ks][1] = (f32x4){bflo(xb.z), bfhi(xb.z), bflo(xb.w), bfhi(xb.w)} + (f32x4){bflo(y.z), bfhi(y.z), bflo(y.w), bfhi(y.w)}; }
                else { xv[ks][0] = *(const f32x4*)(xp + 16 * ks) + (f32x4){bflo(y.x), bfhi(y.x), bflo(y.y), bfhi(y.y)}; xv[ks][1] = *(const f32x4*)(xp + 16 * ks + 4) + (f32x4){bflo(y.z), bfhi(y.z), bflo(y.w), bfhi(y.w)}; } }
            f32x16 acc = (f32x16){0.f, 0.f, 0.f, 0.f, 0.f, 0.f, 0.f, 0.f, 0.f, 0.f, 0.f, 0.f, 0.f, 0.f, 0.f, 0.f};
#pragma unroll
            for (int ks = 0; ks < 8; ++ks) {
                unsigned hw[4], lw[4];
#pragma unroll
                for (int q = 0; q < 2; ++q)
#pragma unroll
                    for (int e = 0; e < 2; ++e) { const float v0 = xv[ks][q][2 * e], v1 = xv[ks][q][2 * e + 1];
                        ss += v0 * v0 + v1 * v1;
                        const unsigned h0 = f2bf(v0), h1 = f2bf(v1);
                        hw[q * 2 + e] = h0 | (h1 << 16);
                        lw[q * 2 + e] = pk2(v0 - __builtin_bit_cast(float, h0 << 16), v1 - __builtin_bit_cast(float, h1 << 16)); }
                const bf16x8 ah = __builtin_bit_cast(bf16x8, (u32x4){hw[0], hw[1], hw[2], hw[3]}), al = __builtin_bit_cast(bf16x8, (u32x4){lw[0], lw[1], lw[2], lw[3]});
                acc = __builtin_amdgcn_mfma_f32_32x32x16_bf16(ah, wfh[ks], acc, 0, 0, 0);
                acc = __builtin_amdgcn_mfma_f32_32x32x16_bf16(al, wfh[ks], acc, 0, 0, 0);
                acc = __builtin_amdgcn_mfma_f32_32x32x16_bf16(ah, wfl[ks], acc, 0, 0, 0);
            }
            ss += __shfl_xor(ss, 32);
            if (hi == 0) PS[w * 32 + r32] = ss;
#pragma unroll
            for (int r = 0; r < 16; ++r) PL[(w * 32 + crow(r, hi)) * 33 + r32] = acc[r];
            __syncthreads();
            float st = 0.f;
#pragma unroll
            for (int ww = 0; ww < 8; ++ww) st += PS[ww * 32 + r32];
            const float r = 1.0f / sqrtf(st * (1.0f / D) + EPS);
            bf16_t* hp = H + (size_t)row * D + 128 * w + 8 * hi;
#pragma unroll
            for (int ks = 0; ks < 8; ++ks) {
                const int k = 128 * w + 16 * ks + 8 * hi;
                const f32x4 g0 = *(const LAS f32x4*)(GS + k), g1 = *(const LAS f32x4*)(GS + k + 4), s0 = *(const LAS f32x4*)(SH + k), s1 = *(const LAS f32x4*)(SH + k + 4);
                const f32x4 h0 = xv[ks][0] * r * g0 + s0, h1 = xv[ks][1] * r * g1 + s1;
                *(u32x4*)(hp + 16 * ks) = (u32x4){pk2(h0[0], h0[1]), pk2(h0[2], h0[3]), pk2(h1[0], h1[1]), pk2(h1[2], h1[3])};
            }
            if (F.tid < 32) {
                float a[20];
#pragma unroll
                for (int j = 0; j < 20; ++j) { float s = 0.f;
#pragma unroll
                    for (int ww = 0; ww < 8; ++ww) s += PL[(ww * 32 + F.tid) * 33 + j];
                    a[j] = r * s + B2[j]; }
                int g = 0; float gm = a[0];
#pragma unroll
                for (int j = 1; j < 4; ++j) if (a[j] > gm) { gm = a[j]; g = j; }
                float den = 0.f;
#pragma unroll
                for (int j = 0; j < 4; ++j) den += __expf(a[j] - gm);
                const float gval = 1.0f / den;
                float el[4];
#pragma unroll
                for (int e = 0; e < 4; ++e) el[e] = g == 0 ? a[4 + e] : (g == 1 ? a[8 + e] : (g == 2 ? a[12 + e] : a[16 + e]));
                int i1 = 0; float v1 = el[0];
#pragma unroll
                for (int e = 1; e < 4; ++e) if (el[e] > v1) { v1 = el[e]; i1 = e; }
                int i2 = -1; float v2 = -INFINITY;
#pragma unroll
                for (int e = 0; e < 4; ++e) if (e != i1 && el[e] > v2) { v2 = el[e]; i2 = e; }
                const float p1 = 1.0f / (1.0f + __expf(v2 - v1)), p2 = 1.0f - p1;
                const float w1 = gval * p1, w2 = gval * p2;
                const int pa = i1 < i2 ? i1 : i2, pb = i1 < i2 ? i2 : i1;
                const int pair = pa == 0 ? pb - 1 : (pa == 1 ? pb + 1 : 5);
                const int lrow = it * 32 + F.tid;
                TB[lrow] = g * 6 + pair; TWA[lrow] = (i1 == pa) ? w1 : w2; TWB[lrow] = (i1 == pa) ? w2 : w1;
            }
            __syncthreads();
        }
        if (F.tid < 128) TRK[F.tid] = atomicAdd((int*)(CNT + TB[F.tid]), 1);
        __syncthreads();
        if (F.tid < NBUCK) BASE[F.tid] = (int)__hip_atomic_fetch_add(gcnt + F.tid, (unsigned)CNT[F.tid], __ATOMIC_RELAXED, __HIP_MEMORY_SCOPE_AGENT);
        __syncthreads();
        if (F.tid < 128) { const int bk = TB[F.tid], pos = BASE[bk] + TRK[F.tid]; const size_t o = (size_t)bk * T + pos;
            ltok[o] = rb * 128 + F.tid; lwa[o] = TWA[F.tid]; lwb[o] = TWB[F.tid]; }
    }
}
__device__ __forceinline__ void gather_phase(Ctx& F, int layer) {
    moe_tab_build(F.lds, (const unsigned*)(F.ws + WS_CTL) + CW_CNT + layer * 32, F.tid);
    const MoeTab tab = moe_tab(F.lds);
    const bf16_t* H = (const bf16_t*)(F.ws + WS_H); bf16_t* HP = (bf16_t*)(F.ws + WS_HP); const int* ltok = (const int*)(F.ws + WS_LIST);
    const int gw = F.bx * NWAVES + F.wave, NGW = F.G * NWAVES, nrows = tab.ntiles * 256;
    for (int row = gw; row < nrows; row += NGW) {
        const int t = row >> 8, bk = tab.tileb(t), cnt = tab.cnt(bk); int idx = (t - tab.tpre(bk)) * 256 + (row & 255); idx = idx < cnt ? idx : cnt - 1;
        const int tok = ltok[(size_t)bk * T + idx];
        const u32x4* s = (const u32x4*)(H + (size_t)tok * D) + F.lane; u32x4* d = (u32x4*)(HP + (size_t)row * D) + F.lane;
        const u32x4 a = s[0], c = s[64]; d[0] = a; d[64] = c;
    }
}

__device__ __forceinline__ void gating_phase(Ctx& F, bf16_t* U, bf16_t* Uout, const bf16_t* V, const float* stats, const float* Ws, const float* gain, const float* bs) {
    LAS unsigned char* VT = F.lds; LAS unsigned char* WL = F.lds + 65536;
    LAS unsigned char* WSL = F.lds + 98304;
    LAS float* MUb = (LAS float*)(F.lds + TOKL_OFF);
    LAS float* RSb = (LAS float*)(F.lds + TOKL_OFF + 1024); LAS float* TP = (LAS float*)(F.lds + TOKL_OFF + 2048);
    const int nunits = 256 * NGRP, g = F.bx & 7;
    const int w = F.wave, r32 = F.lane & 31, hi = F.lane >> 5, G4 = F.lane >> 4, li = F.lane & 15, qq = li >> 2, pp = li & 3;
    const int p_ = F.tid >> 2, qp = F.tid & 3;
    { const f32x4* wp = (const f32x4*)(Ws + ((size_t)g * 128 + p_) * 128 + 32 * qp);
#pragma unroll
      for (int i = 0; i < 4; ++i) { const f32x4 w0 = wp[2 * i], w1 = wp[2 * i + 1];
          *(LAS u32x4*)(WSL + p_ * 256 + (((4 * qp + i) ^ (p_ & 15)) << 4)) = (u32x4){pk2(w0[0], w0[1]), pk2(w0[2], w0[3]), pk2(w1[0], w1[1]), pk2(w1[2], w1[3])}; } }
    const unsigned toff = (unsigned)(((F.tid >> 5) * GH + (F.tid & 31) * 8) * 2);
    constexpr size_t PSTEP = (size_t)16 * GH * 2;
    const unsigned soff = (unsigned)((p_ * 64 + 16 * qp) * 4);
    u32x4 vpre[8]; f32x4 spre[2];
    int u = F.bx;
    __syncthreads();
    if (u < nunits) { const int n = u >> 3;
        { const char* Vb = (const char*)V + ((size_t)n * 128 * GH + g * 256) * 2;
#pragma unroll
          for (int pass = 0; pass < 8; ++pass) vpre[pass] = __builtin_nontemporal_load((const u32x4*)(Vb + pass * PSTEP + toff)); }
        const f32x4* sp = (const f32x4*)((const char*)stats + (size_t)n * 128 * 256 + soff);
        spre[0] = sp[0] + sp[2]; spre[1] = sp[1] + sp[3];
        float s1 = (spre[0].x + spre[0].z) + (spre[1].x + spre[1].z), s2 = (spre[0].y + spre[0].w) + (spre[1].y + spre[1].w);
        s1 += __shfl_xor(s1, 1); s1 += __shfl_xor(s1, 2); s2 += __shfl_xor(s2, 1); s2 += __shfl_xor(s2, 2);
        const float mu = s1 * (1.0f / GH), var = fmaxf(s2 * (1.0f / GH) - mu * mu, 0.f);
        if (qp == 0) { MUb[p_] = mu; RSb[p_] = 1.0f / sqrtf(var + EPS); }
    }
    int par = 0;
    for (; u < nunits; u += F.G, par ^= 1) {
        const int n = u >> 3; const bool has_next = (u + F.G) < nunits; const int nn = (u + F.G) >> 3;
        LAS float* MU = MUb + par * 128; LAS float* RS = RSb + par * 128;
#pragma unroll
        for (int pass = 0; pass < 8; ++pass) { const int idx = pass * NTHR + F.tid, q = idx >> 5, c16 = idx & 31;
            *(LAS u32x4*)(VT + q * 512 + ((((c16 >> 2) ^ (q & 3))) << 6) + (c16 & 3) * 16) = vpre[pass]; }
        __syncthreads();
        { float t = 0.f;
#pragma unroll
          for (int i = 0; i < 4; ++i) {
              const int q0 = 32 * qp + 8 * i;
              const u32x4 wq = *(const LAS u32x4*)(WSL + p_ * 256 + (((4 * qp + i) ^ (p_ & 15)) << 4));
              float wv[8];
              wv[0] = bflo(wq.x) * RS[q0 + 0]; wv[1] = bfhi(wq.x) * RS[q0 + 1]; wv[2] = bflo(wq.y) * RS[q0 + 2]; wv[3] = bfhi(wq.y) * RS[q0 + 3];
              wv[4] = bflo(wq.z) * RS[q0 + 4]; wv[5] = bfhi(wq.z) * RS[q0 + 5]; wv[6] = bflo(wq.w) * RS[q0 + 6]; wv[7] = bfhi(wq.w) * RS[q0 + 7];
#pragma unroll
              for (int j = 0; j < 8; ++j) t += wv[j] * MU[q0 + j];
              const int c = 4 * qp + i;
              *(LAS u32x4*)(WL + p_ * 256 + ((c ^ (p_ & 15)) << 4)) = (u32x4){pk2(wv[0], wv[1]), pk2(wv[2], wv[3]), pk2(wv[4], wv[5]), pk2(wv[6], wv[7])};
          }
          t += __shfl_xor(t, 1); t += __shfl_xor(t, 2);
          if (qp == 0) TP[p_] = t; }
        u32x4 ureg[8];
        { const char* Ub = (const char*)U + ((size_t)n * 128 * GH + g * 256) * 2;
#pragma unroll
          for (int pass = 0; pass < 8; ++pass) ureg[pass] = __builtin_nontemporal_load((const u32x4*)(Ub + pass * PSTEP + toff)); }
        if (has_next) {
            { const char* Vb = (const char*)V + ((size_t)nn * 128 * GH + g * 256) * 2;
#pragma unroll
              for (int pass = 0; pass < 8; ++pass) vpre[pass] = __builtin_nontemporal_load((const u32x4*)(Vb + pass * PSTEP + toff)); }
        }
        __syncthreads();
        f32x16 acc[4];
#pragma unroll
        for (int nt = 0; nt < 4; ++nt) acc[nt] = (f32x16){0.f, 0.f, 0.f, 0.f, 0.f, 0.f, 0.f, 0.f, 0.f, 0.f, 0.f, 0.f, 0.f, 0.f, 0.f, 0.f};
#pragma unroll
        for (int ks = 0; ks < 8; ++ks) {
            const int cbyte = (32 * w + 16 * (G4 & 1) + 4 * pp) * 2;
            const int rA = 16 * ks + 8 * hi + qq, rB = rA + 4;
            const s16x4 lo = vtr(VT + rA * 512 + ((((cbyte >> 6) ^ (rA & 3))) << 6) + (cbyte & 63));
            const s16x4 hh = vtr(VT + rB * 512 + ((((cbyte >> 6) ^ (rB & 3))) << 6) + (cbyte & 63));
            const bf16x8 af = (bf16x8){lo[0], lo[1], lo[2], lo[3], hh[0], hh[1], hh[2], hh[3]};
#pragma unroll
            for (int nt = 0; nt < 4; ++nt) {
                const int p = 32 * nt + r32;
                const bf16x8 bfr = *(const LAS bf16x8*)(WL + p * 256 + (((2 * ks + hi) ^ (p & 15)) << 4));
                acc[nt] = __builtin_amdgcn_mfma_f32_32x32x16_bf16(af, bfr, acc[nt], 0, 0, 0);
            }
        }
        if (has_next) { unsigned so = soff; asm volatile("" : "+v"(so));
            const f32x4* sp = (const f32x4*)((const char*)stats + (size_t)nn * 128 * 256 + so); spre[0] = sp[0] + sp[2]; spre[1] = sp[1] + sp[3]; }
        __syncthreads();
#pragma unroll
        for (int nt = 0; nt < 4; ++nt) {
            const int p = 32 * nt + r32; const float tp = TP[p], bp = bs[g * 128 + p];
#pragma unroll
            for (int gq = 0; gq < 4; ++gq) {
                const int c = 32 * w + 8 * gq + 4 * hi; const f32x4 gnv = *(const f32x4*)(gain + g * 256 + c);
                float o[4];
#pragma unroll
                for (int j = 0; j < 4; ++j) o[j] = gnv[j] * (acc[nt][4 * gq + j] - tp) + bp;
                const int cb = c * 2;
                *(LAS u32x2*)(VT + p * 512 + ((((cb >> 4) ^ (p & 15))) << 4) + (cb & 15)) = (u32x2){pk2(o[0], o[1]), pk2(o[2], o[3])};
            }
        }
        if (has_next) {
            float s1 = (spre[0].x + spre[0].z) + (spre[1].x + spre[1].z), s2 = (spre[0].y + spre[0].w) + (spre[1].y + spre[1].w);
            s1 += __shfl_xor(s1, 1); s1 += __shfl_xor(s1, 2); s2 += __shfl_xor(s2, 1); s2 += __shfl_xor(s2, 2);
            const float mu = s1 * (1.0f / GH), var = fmaxf(s2 * (1.0f / GH) - mu * mu, 0.f);
            if (qp == 0) { MUb[(par ^ 1) * 128 + p_] = mu; RSb[(par ^ 1) * 128 + p_] = 1.0f / sqrtf(var + EPS); }
        }
        __syncthreads();
#pragma unroll
        for (int pass = 0; pass < 8; ++pass) {
            const int idx = pass * NTHR + F.tid, p = idx >> 5, c16 = idx & 31;
            const u32x4 vs = *(const LAS u32x4*)(VT + p * 512 + ((c16 ^ (p & 15)) << 4));
            const u32x4 uv = ureg[pass]; u32x4 o;
            o.x = pk2(bflo(uv.x) * bflo(vs.x), bfhi(uv.x) * bfhi(vs.x)); o.y = pk2(bflo(uv.y) * bflo(vs.y), bfhi(uv.y) * bfhi(vs.y));
            o.z = pk2(bflo(uv.z) * bflo(vs.z), bfhi(uv.z) * bfhi(vs.z)); o.w = pk2(bflo(uv.w) * bflo(vs.w), bfhi(uv.w) * bfhi(vs.w));
            *(u32x4*)((char*)Uout + ((size_t)n * 128 * GH + g * 256) * 2 + pass * PSTEP + toff) = o;
        }
        __syncthreads();
    }
}

__global__ void __launch_bounds__(NTHR, 2) mk_fwd(Args args) {
    extern __shared__ __attribute__((aligned(16))) unsigned char lds_[];
    Ctx F;
    F.lds = (LAS unsigned char*)lds_;
    F.wave = __builtin_amdgcn_readfirstlane((int)threadIdx.x >> 6); F.G = gridDim.x; F.bx = blockIdx.x;
#define REFRESH() do { F.lane = lane_now(); F.tid = F.wave * 64 + F.lane; } while (0)
    REFRESH();
    F.out = args.out; F.ws = args.ws;
    unsigned char* ws = args.ws;
    volatile LAS unsigned* MISC = (volatile LAS unsigned*)(F.lds + MISC_OFF);
    for (int u = F.tid; u < (LDS_BYTES - LDSCTL_OFF) / 4; u += NTHR) ((LAS unsigned*)(F.lds + LDSCTL_OFF))[u] = 0u;
    __syncthreads();
    const int lo = args.ph_lo, hi = args.ph_hi;
#if MK_PER_PHASE
#define GRID_BAR(k) do {} while (0)
#else
    cg::grid_group grid = cg::this_grid();
    XcdBarrier bar = xcd_barrier_post((unsigned*)(ws + WS_CTL) + CW_BAR, MISC + 8, F.wave);
    if (lo < 0) grid.sync();
#define GRID_BAR(k) do { xcd_barrier2(bar); REFRESH(); } while (0)
#endif
#define IN(k) (lo <= (k) && (k) < hi)
#ifndef PROBE_REP
#define PROBE_REP -1
#endif
#define NREP(k) (PROBE_REP == (k) ? 2 : 1)
#ifndef PROBE_A
#define PROBE_A -1
#endif
#ifndef PROBE_B
#define PROBE_B -1
#endif
#if PROBE_A >= 0
    unsigned long long* tsb = (unsigned long long*)(ws + WS_CTL + 512 * 1024);
    if (F.bx == 0 && F.tid == 0) tsb[0] = __builtin_amdgcn_s_memrealtime();
#define STAMP(k) do { if (F.bx == 0 && F.tid == 0) tsb[(k) + 1] = __builtin_amdgcn_s_memrealtime(); } while (0)
#else
#define STAMP(k) do {} while (0)
#endif
#define SEAM(k) do { if (IN(k) && IN((k) + 1)) { GRID_BAR(k); STAMP(k); } } while (0)
#define SEAM2(k) do { if (IN(k) && IN((k) + 2)) { GRID_BAR(k); STAMP(k); } } while (0)
    const float* mod = (const float*)(ws + WS_MOD);
    bf16_t* H = (bf16_t*)(ws + WS_H);
    float* XR = args.out;

    if (IN(0)) { for (int rep = 0; rep < NREP(0); ++rep) { p0_prep(F, args); __syncthreads(); } } SEAM(0);
#if !MK_PER_PHASE
    if (PROBE_REP == 100) { for (int i = 0; i < 10; ++i) xcd_barrier2(bar); }
#endif
    if (IN(1)) { for (int rep = 0; rep < NREP(1); ++rep) norm_rows<false>(F, args.in[I_X], args.in[I_NMIX], mod + 0 * D, mod + 1 * D, H); route_prep(F, args.in[I_NFFN]); } SEAM(1);
    if (IN(2)) {
        pg8::DenseOrder S; S.init(H, ws + WS_WQKV, T, NQKVP, D, F.G, F.bx);
        EpiQKV E{(bf16_t*)(ws + WS_Q), (bf16_t*)(ws + WS_K), (bf16_t*)(ws + WS_V), (const float*)(ws + WS_ROPE)};
        for (int rep = 0; rep < NREP(2); ++rep) pg8::gemm_phase<EpiQKV, pg8::DenseOrder>(F.lds, D, S, E, F.wave);
    } SEAM(2);
    if (IN(3)) { for (int rep = 0; rep < NREP(3); ++rep) attn_phase(F); } SEAM(3);
    if (IN(4)) { combine_phase(F); } SEAM(4);
    if (IN(5)) {
        pg8::DenseOrder S; S.init(ws + WS_O, ws + WS_WO, T, D, D, F.G, F.bx);
        EpiY E{(bf16_t*)(ws + WS_Y1), mod + 2 * D};
        for (int rep = 0; rep < NREP(5); ++rep) pg8::gemm_phase<EpiY, pg8::DenseOrder>(F.lds, D, S, E, F.wave);
    } SEAM(5);
#define MOE_LAYER(layer, pb) do { \
        const float* modl = mod + (layer) * 2 * 6144; \
        if (IN(pb)) { route_phase<(layer) == 1>(F, layer, args.in[I_NFFN], (layer) == 0 ? (const void*)args.in[I_X] : (const void*)(ws + WS_XRB), (const bf16_t*)(ws + ((layer) == 0 ? WS_Y1 : WS_Y3))); } SEAM2(pb); \
        if (IN((pb) + 2)) { \
            moe_tab_build(F.lds, (const unsigned*)(ws + WS_CTL) + CW_CNT + (layer) * 32, F.tid); \
            const MoeTab tab = moe_tab(F.lds); \
            MoeOrder S{(const char*)(ws + WS_H), (size_t)0, (const char*)(ws + WS_BGU), 0, layer, tab, tab.ntiles * 4, F.G, F.bx}; \
            S.fill_tokl((const int*)(ws + WS_LIST), F.tid); \
            EpiAct E{(bf16_t*)(ws + WS_ACT), (const float*)(ws + WS_LIST + 3 * MiB), (const float*)(ws + WS_LIST + 6 * MiB), tab}; \
            for (int rep = 0; rep < NREP((pb) + 2); ++rep) pg8::gemm_phase<EpiAct, MoeOrder>(F.lds, D, S, E, F.wave); \
            if ((layer) == 0) { const int lo_ = S.tail_lo();     \
                __syncthreads(); if (F.bx >= lo_) expert_items(F, args, 1, (F.bx - lo_) * NWAVES + F.wave, (F.G - lo_) * NWAVES); } \
        } SEAM((pb) + 2); \
        if (IN((pb) + 3)) { \
            moe_tab_build(F.lds, (const unsigned*)(ws + WS_CTL) + CW_CNT + (layer) * 32, F.tid); \
            const MoeTab tab = moe_tab(F.lds); \
            MoeOrder S{(const char*)(ws + WS_ACT), (size_t)256 * 512 * 2, (const char*)(ws + WS_BDP), 1, layer, tab, tab.ntiles * 4, F.G, F.bx}; \
            EpiDown E{(bf16_t*)(ws + ((layer) == 0 ? WS_Y : WS_Y4)), modl + 5 * D, (const int*)(ws + WS_LIST), tab}; \
            for (int rep = 0; rep < NREP((pb) + 3); ++rep) pg8::gemm_phase<EpiDown, MoeOrder>(F.lds, 512, S, E, F.wave); \
            if ((layer) == 0) { const int lo_ = S.tail_lo();     \
                __syncthreads(); if (F.bx >= lo_) gmlp_items(F, args, (F.bx - lo_) * NWAVES + F.wave, (F.G - lo_) * NWAVES); } \
        } SEAM((pb) + 3); \
    } while (0)
    MOE_LAYER(0, 6);
    if (IN(10)) { norm_rows<true>(F, args.in[I_X], args.in[I_NMIX] + D, mod + 2 * 6144 + 0 * D, mod + 2 * 6144 + 1 * D, H, (const bf16_t*)(ws + WS_Y1), (const bf16_t*)(ws + WS_Y), (bf16_t*)(ws + WS_XRB)); } SEAM(10);
    if (IN(11)) {
        pg8::DenseOrder S; S.init(H, ws + WS_WIN, T, FF, D, F.G, F.bx);
        EpiGelu<0> E{(bf16_t*)(ws + WS_U), (bf16_t*)(ws + WS_VV), (float*)(ws + WS_STATS)};
        if (PROBE_REP == 111) { EpiGelu<1> E1{(bf16_t*)(ws + WS_U), (bf16_t*)(ws + WS_VV), (float*)(ws + WS_STATS)}; pg8::gemm_phase<EpiGelu<1>, pg8::DenseOrder>(F.lds, D, S, E1, F.wave); }
        if (PROBE_REP == 112) { EpiGelu<2> E2{(bf16_t*)(ws + WS_U), (bf16_t*)(ws + WS_VV), (float*)(ws + WS_STATS)}; pg8::gemm_phase<EpiGelu<2>, pg8::DenseOrder>(F.lds, D, S, E2, F.wave); }
        for (int rep = 0; rep < NREP(11); ++rep) pg8::gemm_phase<EpiGelu<0>, pg8::DenseOrder>(F.lds, D, S, E, F.wave);
    } SEAM(11);
    if (IN(12)) {
        for (int rep = 0; rep < NREP(12); ++rep) gating_phase(F, (bf16_t*)(ws + WS_U), (bf16_t*)(ws + (rep == 0 ? WS_U : WS_VV)), (const bf16_t*)(ws + WS_VV), (const float*)(ws + WS_STATS), args.in[I_WS], args.in[I_VGAIN], args.in[I_BS]);
    } SEAM(12);
    if (IN(13)) {
        pg8::DenseOrder S; S.init(ws + WS_U, ws + WS_WO2, T, D, GH, F.G, F.bx);
        EpiY E{(bf16_t*)(ws + WS_Y3), mod + 2 * 6144 + 2 * D};
        for (int rep = 0; rep < NREP(13); ++rep) pg8::gemm_phase<EpiY, pg8::DenseOrder>(F.lds, GH, S, E, F.wave);
    } SEAM(13);
    MOE_LAYER(1, 14);
    if (IN(18)) { final_norm(F, (const bf16_t*)(ws + WS_XRB), XR, args.in[I_FNORM], 1.0f, (const bf16_t*)(ws + WS_Y3), (const bf16_t*)(ws + WS_Y4)); }
}

extern "C" void kernel_launch(void* const* d_in, const int* in_sizes, int n_in, void* d_out, int out_size, void* d_ws, size_t ws_size, hipStream_t stream) {
    static int grid = 0;
    if (grid == 0) {
        if (n_in != 21 || in_sizes[0] != T * D || out_size != T * D || ws_size < WS_END) { fprintf(stderr, "kernel_launch: unexpected problem (n_in %d, in0 %d, out %d, ws %zu)\n", n_in, n_in > 0 ? in_sizes[0] : -1, out_size, ws_size); grid = -1; return; }
        int dev = 0, cus = 0, per_cu = 0;
        (void)hipGetDevice(&dev);
        (void)hipDeviceGetAttribute(&cus, hipDeviceAttributeMultiprocessorCount, dev);
        (void)hipFuncSetAttribute((const void*)mk_fwd, hipFuncAttributeMaxDynamicSharedMemorySize, LDS_BYTES);
        (void)hipOccupancyMaxActiveBlocksPerMultiprocessor(&per_cu, (const void*)mk_fwd, NTHR, LDS_BYTES);
        if (per_cu < 1) { fprintf(stderr, "kernel_launch: occupancy query says %d blocks per CU\n", per_cu); grid = -1; return; }
        grid = cus;
        if (grid % 8 != 0) { fprintf(stderr, "kernel_launch: this kernel needs a CU count that is a multiple of 8 (got %d)\n", grid); grid = -1; return; }
    }
    if (grid < 0) return;
    (void)hipMemsetAsync((char*)d_ws + WS_CTL, 0, CTL_ZERO_BYTES, stream);
    Args a{};
    for (int i = 0; i < 21; ++i) a.in[i] = (const float*)d_in[i];
    a.out = (float*)d_out; a.ws = (unsigned char*)d_ws;
#if MK_PER_PHASE
    for (int p = 0; p < NPHASE; ++p) { a.ph_lo = p; a.ph_hi = p + 1; hipLaunchKernelGGL(mk_fwd, dim3(grid), dim3(NTHR), LDS_BYTES, stream, a); }
#else
    a.ph_lo = 0; a.ph_hi = NPHASE;
    void* kargs[] = {&a};
    hipError_t e = hipLaunchCooperativeKernel((const void*)mk_fwd, dim3(grid), dim3(NTHR), kargs, LDS_BYTES, stream);
    if (e != hipSuccess) fprintf(stderr, "cooperative launch failed: %s (grid %d)\n", hipGetErrorString(e), grid);
#endif
}
```

```cpp
#include <hip/hip_runtime.h>
#include <hip/hip_cooperative_groups.h>
#include <cstdio>
#include <cstdint>
namespace cg = cooperative_groups;

#ifndef MK_PER_PHASE
#define MK_PER_PHASE 0
#endif

#define GAS __attribute__((address_space(1)))
#define LAS __attribute__((address_space(3)))
typedef unsigned short bf16_t;
typedef short bf16x8 __attribute__((ext_vector_type(8)));
typedef short s16x4 __attribute__((ext_vector_type(4)));
typedef float f32x2 __attribute__((ext_vector_type(2)));
typedef float f32x4 __attribute__((ext_vector_type(4)));
typedef float f32x16 __attribute__((ext_vector_type(16)));
typedef unsigned u32x2 __attribute__((ext_vector_type(2)));
typedef unsigned u32x4 __attribute__((ext_vector_type(4)));

constexpr int NWAVES = 8, NTHR = 512;
constexpr int BATCH = 2, SEQ = 16384, T = BATCH * SEQ, D = 1024;
constexpr int NH = 15, HD = 64, AW = 960, NQKV = 2880, NQKVP = 3072;
constexpr int GH = 2048, FF = 4096, CHUNK = 128, NGRP = 8;
constexpr int NEXP = 16, DE = 256, NBUCK = 24, MAXTILES = 152;
constexpr float EPS = 1e-6f;
constexpr float C2 = 0.125f * 1.4426950408889634f;
constexpr int NPHASE = 19;

constexpr size_t MiB = 1u << 20;
constexpr size_t WS_CTL = 0, CTL_ZERO_BYTES = 1 * MiB;
constexpr size_t WS_MOD = 1 * MiB;
constexpr size_t WS_ROPE = 2 * MiB;
constexpr size_t WS_WR = 3 * MiB;
constexpr size_t WS_WQKV = 4 * MiB;
constexpr size_t WS_WO = 10 * MiB;
constexpr size_t WS_WIN = 12 * MiB;
constexpr size_t WS_WO2 = 20 * MiB;
constexpr size_t WS_BGU = 24 * MiB;
constexpr size_t WS_BDP = 56 * MiB;
constexpr size_t WS_H = 104 * MiB;
constexpr size_t WS_LIST = 168 * MiB;
constexpr size_t WS_WF = 177 * MiB;
constexpr size_t WS_STATS = 178 * MiB;
constexpr size_t WS_LSE = 186 * MiB;
constexpr size_t WS_BIG = 192 * MiB;
constexpr size_t WS_Q = WS_BIG, WS_K = WS_BIG + 60 * MiB, WS_V = WS_BIG + 120 * MiB, WS_O = WS_BIG + 180 * MiB;
constexpr size_t WS_HP = WS_BIG, WS_ACT = WS_BIG + 80 * MiB, WS_Y = WS_BIG + 120 * MiB, WS_Y1 = WS_BIG, WS_Y3 = WS_BIG + 128 * MiB, WS_Y4 = WS_BIG;
constexpr size_t WS_U = WS_BIG, WS_VV = WS_BIG + 128 * MiB;
constexpr size_t WS_XRB = 448 * MiB;
constexpr size_t WS_END = 512 * MiB;
constexpr int CW_BAR = 4096;
constexpr int CW_CNT = 16384;

constexpr int RING_BYTES = 131072;
constexpr int LDSCTL_OFF = RING_BYTES, MISC_OFF = LDSCTL_OFF + 320, TAB_OFF = LDSCTL_OFF + 1024;
constexpr int LDS_BYTES = 147456;

__device__ __forceinline__ unsigned f2bf(float f) { unsigned u = __builtin_bit_cast(unsigned, f); return (u + 0x7fffu + ((u >> 16) & 1u)) >> 16; }
__device__ __forceinline__ unsigned pk2(float lo, float hi) { return f2bf(lo) | (f2bf(hi) << 16); }
__device__ __forceinline__ float bf2f(unsigned short v) { return __builtin_bit_cast(float, (unsigned)v << 16); }
__device__ __forceinline__ float bflo(unsigned w) { return __builtin_bit_cast(float, w << 16); }
__device__ __forceinline__ float bfhi(unsigned w) { return __builtin_bit_cast(float, w & 0xffff0000u); }
__device__ __forceinline__ float wave_sum(float v) {
#pragma unroll
    for (int o = 1; o < 64; o <<= 1) v += __shfl_xor(v, o);
    return v;
}
__device__ __forceinline__ float sum16(float v) {
#pragma unroll
    for (int o = 1; o < 16; o <<= 1) v += __shfl_xor(v, o);
    return v;
}
#define LDS_WAIT() asm volatile("s_waitcnt lgkmcnt(0)" ::: "memory")
__device__ __forceinline__ int lane_now() { int l = (int)__builtin_amdgcn_mbcnt_hi(~0u, __builtin_amdgcn_mbcnt_lo(~0u, 0u)); asm volatile("" : "+v"(l)); return l; }

__device__ __forceinline__ int crow(int r, int hi) { return (r & 3) + 8 * (r >> 2) + 4 * hi; }
#define XB_TMO      128
#define XB_XCNT(j)  (256  + 64 * (j))
#define XB_XSUB(j)  (1280 + 64 * (j))
#define XB_XGEN(j)  (2304 + 64 * (j))
#define XB_TOP      3328
#define XB_TOPGEN   3392
#define XCD_BAR_WORDS 3456
#define XB_SPIN_CAP (1u << 22)
__device__ __forceinline__ unsigned xb_ld(unsigned* p)              { return __hip_atomic_load(p, __ATOMIC_RELAXED, __HIP_MEMORY_SCOPE_AGENT); }
__device__ __forceinline__ unsigned xb_add(unsigned* p, unsigned v) { return __hip_atomic_fetch_add(p, v, __ATOMIC_RELAXED, __HIP_MEMORY_SCOPE_AGENT); }
__device__ __forceinline__ unsigned xb_xcc_id() { return (unsigned)__builtin_amdgcn_s_getreg((3 << 11) | 20) & 0xFu; }
#define XB_SPIN(cond, bar) do { unsigned _sp = 0; while (cond) { __builtin_amdgcn_s_sleep(6); \
    if ((++_sp & 255u) == 0u) { if (xb_ld(&(bar)[XB_TMO])) break; if (_sp > XB_SPIN_CAP) { atomicAdd(&(bar)[XB_TMO], 1u); break; } } } } while (0)
struct XcdBarrier { unsigned* bar; unsigned x; volatile LAS unsigned* st; int wave; };
__device__ __forceinline__ XcdBarrier xcd_barrier_post(unsigned* bar, volatile LAS unsigned* st, int wave) {
    XcdBarrier b; b.bar = bar; b.x = xb_xcc_id(); b.st = st; b.wave = wave;
    if (wave == 0 && lane_now() == 0) (void)xb_add(&bar[XB_XCNT(b.x)], 1u);
    return b;
}
__device__ __forceinline__ void xcd_barrier_complete(unsigned* bar, unsigned x, unsigned& nloc, unsigned& nx) {
    const unsigned G = gridDim.x * gridDim.y * gridDim.z;
    unsigned sum, cnt, mine, sp = 0u;
    for (;;) {
        sum = 0u; cnt = 0u; mine = 0u;
#pragma unroll
        for (unsigned j = 0; j < 16; ++j) { const unsigned c = xb_ld(&bar[XB_XCNT(j)]); sum += c; cnt += (c > 0u) ? 1u : 0u; mine = (j == x) ? c : mine; }
        if (sum == G) break;
        __builtin_amdgcn_s_sleep(1);
        if ((++sp & 255u) == 0u) { if (xb_ld(&bar[XB_TMO])) break; if (sp > XB_SPIN_CAP) { atomicAdd(&bar[XB_TMO], 1u); break; } }
    }
    nloc = mine > 0u ? mine : 1u; nx = cnt > 0u ? cnt : 1u;
}
__device__ __forceinline__ void xcd_barrier2(const XcdBarrier& b) {
    asm volatile("s_waitcnt vmcnt(0)" ::: "memory");
    __syncthreads();
    if (b.wave == 0 && lane_now() == 0) {
        unsigned* bar = b.bar;
        __builtin_amdgcn_s_waitcnt(0);
        unsigned nloc = b.st[0], nx = b.st[1];
        if (nloc == 0u) { xcd_barrier_complete(bar, b.x, nloc, nx); b.st[0] = nloc; b.st[1] = nx; }
        const unsigned old = xb_add(&bar[XB_XSUB(b.x)], 1u);
        const unsigned gen = old / nloc;
        __builtin_amdgcn_fence(__ATOMIC_ACQUIRE, "agent");
        if (old + 1u == (gen + 1u) * nloc) {
            __builtin_amdgcn_fence(__ATOMIC_RELEASE, "agent");
            asm volatile("s_waitcnt vmcnt(0)" ::: "memory");
            (void)xb_add(&bar[XB_TOP], 1u);
        }
        XB_SPIN(xb_ld(&bar[XB_TOP]) < (gen + 1u) * nx, bar);
        asm volatile("s_waitcnt vmcnt(0)" ::: "memory");
    }
    __syncthreads();
}

namespace pg8 {
constexpr int BM = 256, BK = 64, HALF = 128, HTB = HALF * BK * 2, NXCD = 8, WGM = 4;
__host__ __device__ __forceinline__ int lds_byte(int r, int c) { const int st = (r >> 4) * 2 + (c >> 5), rr = r & 15, cc = c & 31, ob = rr * 64 + cc * 2; return st * 1024 + (ob ^ (((ob >> 9) & 1) << 5)); }
__host__ __device__ __forceinline__ void stage_rc(int b, int& R, int& C) { const int st = b / 1024, sb = b % 1024, swz = sb ^ (((sb >> 9) & 1) << 5); R = (st >> 1) * 16 + swz / 64; C = (st & 1) * 32 + (swz % 64) / 2; }
__host__ __device__ __forceinline__ int perm32(int rho) { const int n = rho >> 4, i = rho & 15; return 8 * (i >> 2) + 4 * n + (i & 3); }
struct Unit { int pm, pn, h; };
__device__ __forceinline__ int xcd_remap(int L, int nwg) { const int q = nwg / NXCD, r = nwg % NXCD, xcd = L % NXCD, off = L / NXCD; return (xcd < r ? xcd * (q + 1) : r * (q + 1) + (xcd - r) * q) + off; }

struct DenseOrder {
    static constexpr bool HALFCAP = false;
    const char* A; const char* Bt; size_t tstep; int nM, nN, nwg, G, c;
    __device__ void init(const void* A_, const void* Bt_, int M, int N, int K, int G_, int c_) { A = (const char*)A_; Bt = (const char*)Bt_; tstep = (size_t)BM * K * 2; nM = M / BM; nN = N / BM; nwg = nM * nN; G = G_; c = c_; }
    __device__ bool next(int i, Unit& u) const {
        const long L = (long)i * G + c; if (L >= nwg) return false;
        const int wgid = xcd_remap((int)L, nwg);
        const int nig = WGM * nN, gid = wgid / nig, fm = gid * WGM, gsz = (nM - fm) < WGM ? (nM - fm) : WGM;
        u.pm = fm + ((wgid % nig) % gsz); u.pn = (wgid % nig) / gsz; u.h = 0; return true;
    }
    __device__ __forceinline__ const char* abase(const Unit& u) const { return A + (size_t)u.pm * tstep; }
    __device__ __forceinline__ const char* bptr(const Unit& u) const { return Bt + (size_t)u.pn * tstep; }
    __device__ __forceinline__ int ldb(int K) const { return K; }
    __device__ __forceinline__ int kjump(const Unit&) const { return 0; }
    __device__ __forceinline__ void aoffs(const Unit&, int, const int (&R)[2], const int (&C)[2], int K, unsigned& v00, unsigned& v01, unsigned& v10, unsigned& v11) const {
        v00 = (unsigned)(R[0] * K + C[0]) * 2u; v01 = (unsigned)(R[1] * K + C[1]) * 2u; v10 = v00 + (unsigned)(HALF * K * 2); v11 = v01 + (unsigned)(HALF * K * 2); }
};

__device__ __forceinline__ unsigned cvt_pk_bf16(float lo, float hi) { unsigned r; asm volatile("v_cvt_pk_bf16_f32 %0, %1, %2" : "=v"(r) : "v"(lo), "v"(hi)); return r; }
__device__ __forceinline__ f32x2 gelu_pk(f32x2 v) {
    const float six = 6.0f; f32x2 x, m;
    asm("v_min_f32_e64 %0, |%1|, %2" : "=v"(x.x) : "v"(v.x), "s"(six)); asm("v_min_f32_e64 %0, |%1|, %2" : "=v"(x.y) : "v"(v.y), "s"(six));
    f32x2 p = x * 3.309498500e-05f + (-7.692387091e-04f); p = p * x + 8.080778804e-03f; p = p * x + (-5.341219989e-02f); p = p * x + (-4.587709027e-01f); p = p * x + (-1.151201725e+00f); p = p * x + (-9.999930587e-01f);
    f32x2 e; e.x = __builtin_amdgcn_exp2f(p.x); e.y = __builtin_amdgcn_exp2f(p.y);
    asm("v_max_f32_e32 %0, 0, %1" : "=v"(m.x) : "v"(v.x)); asm("v_max_f32_e32 %0, 0, %1" : "=v"(m.y) : "v"(v.y));
    return m - x * e;
}

template <class Epi, class Sched, bool ALIGN_EPI = true>
__device__ __forceinline__ void gemm_phase(LAS unsigned char* lds, const int K, const Sched& S, const Epi& E, const int wave) {
    const int lane = lane_now(), wid = wave, tid = wave * 64 + lane, wr = wid >> 2, wc = wid & 3, fr = lane & 15, fq = lane >> 4;
    const int nt = K / BK;
    int RA[2], CA[2]; unsigned voffB[2];
#pragma unroll
    for (int i = 0; i < 2; ++i) { int R, C; stage_rc(tid * 16 + i * 8192, R, C);
        const int Rb = Epi::BMAP ? ((R >> 5) * 64 + perm32(R & 31)) : (Epi::PERM ? ((R & ~31) + perm32(R & 31)) : R);
        RA[i] = R; CA[i] = C; voffB[i] = (unsigned)(Rb * S.ldb(K) + C) * 2u; }
    const size_t kstep = (size_t)(BK * 2);
    const size_t hstep = (size_t)(Epi::BMAP ? 32 : HALF) * S.ldb(K) * 2;
    const unsigned ldsw = (unsigned)wid * 1024u;
    const int aoff = lds_byte(wr * 64 + fr, fq * 8), boff = lds_byte(wc * 32 + fr, fq * 8);
#define PG8_SA(b, h) (((b) * 2 + (h)) * HTB)
#define PG8_SB(b, h) ((4 + (b) * 2 + (h)) * HTB)
#define PG8_STAGE(bufoff, gbase, v0, v1) do { \
        __builtin_amdgcn_global_load_lds((const unsigned*)((const char*)(gbase) + (v0)), (LAS unsigned*)(lds + (bufoff) + ldsw), 16, 0, 0); \
        __builtin_amdgcn_global_load_lds((const unsigned*)((const char*)(gbase) + (v1)), (LAS unsigned*)(lds + (bufoff) + ldsw + 8192), 16, 0, 0); } while (0)
#define PG8_STB(bufoff, gbase) PG8_STAGE(bufoff, gbase, voffB[0], voffB[1])
#define PG8_LDA(dst, b, h) do { _Pragma("unroll") for (int m = 0; m < 4; ++m) _Pragma("unroll") for (int k = 0; k < 2; ++k) dst[m][k] = *(const LAS bf16x8*)(lds + PG8_SA(b, h) + aoff + m * 2048 + k * 1024); } while (0)
#define PG8_LDB(dst, b, h) do { _Pragma("unroll") for (int n = 0; n < 2; ++n) _Pragma("unroll") for (int k = 0; k < 2; ++k) dst[n][k] = *(const LAS bf16x8*)(lds + PG8_SB(b, h) + boff + n * 2048 + k * 1024); } while (0)
#define PG8_MMA(ai, bj, At, Bt) do { __builtin_amdgcn_s_setprio(1); _Pragma("unroll") for (int m = 0; m < 4; ++m) _Pragma("unroll") for (int n = 0; n < 2; ++n) _Pragma("unroll") for (int k = 0; k < 2; ++k) \
        acc[ai][bj][m][n] = __builtin_amdgcn_mfma_f32_16x16x32_bf16(Bt[n][k], At[m][k], acc[ai][bj][m][n], 0, 0, 0); __builtin_amdgcn_s_setprio(0); } while (0)
#define PG8_WAIT_V(n) asm volatile("s_waitcnt vmcnt(" #n ")" ::: "memory")
#define PG8_WAIT_L(n) asm volatile("s_waitcnt lgkmcnt(" #n ")" ::: "memory")
#define PG8_BAR __builtin_amdgcn_s_barrier()
#define PG8_SCHED __builtin_amdgcn_sched_barrier(0)
    Unit cur, nxt; int ui = 0;
    if (!S.next(0, cur)) return;
    f32x4 acc[2][2][4][2];
#pragma unroll
    for (int a = 0; a < 2; ++a)
#pragma unroll
        for (int b = 0; b < 2; ++b)
#pragma unroll
            for (int m = 0; m < 4; ++m)
#pragma unroll
                for (int n = 0; n < 2; ++n) acc[a][b][m][n] = (f32x4){0.f, 0.f, 0.f, 0.f};
    bf16x8 At[4][2], B0[2][2], B1[2][2];
    const char* cA = S.abase(cur); const char* cB = S.bptr(cur);
    unsigned vA00, vA01, vA10, vA11;
    S.aoffs(cur, 0, RA, CA, K, vA00, vA01, vA10, vA11);
    {
        PG8_STB(PG8_SB(0, 0), cB); PG8_STB(PG8_SB(0, 1), cB + hstep); PG8_STAGE(PG8_SA(0, 0), cA, vA00, vA01); PG8_STAGE(PG8_SA(0, 1), cA, vA10, vA11);
        if (wr == 1) PG8_BAR;
        PG8_WAIT_V(2); PG8_BAR;
        PG8_STB(PG8_SB(1, 0), cB + kstep); PG8_STAGE(PG8_SA(1, 0), cA + kstep, vA00, vA01); PG8_STB(PG8_SB(1, 1), cB + hstep + kstep);
        PG8_WAIT_V(6); PG8_BAR;
    }
    for (;;) {
        const bool has_next = S.next(ui + 1, nxt);
        const char* nA = has_next ? S.abase(nxt) : cA; const char* nB = has_next ? S.bptr(nxt) : cB;
        unsigned nA00 = vA00, nA01 = vA01, nA10 = vA10, nA11 = vA11;
        if (has_next) S.aoffs(nxt, ui + 1, RA, CA, K, nA00, nA01, nA10, nA11);
        const bool full = !Sched::HALFCAP || cur.h == 0;
        const long cj = S.kjump(cur);
        for (int t = 0; t < nt; t += 2) {
            const bool last = (t == nt - 2);
            const char* a1 = cA + (size_t)(t + 1) * kstep;
            const char* a2 = last ? nA : cA + (size_t)(t + 2) * kstep; const char* b2 = last ? nB : cB + (size_t)(t + 2) * kstep + (2 * (t + 2) >= nt ? cj : 0);
            const char* a3 = a2 + kstep; const char* b3 = b2 + kstep;
            const unsigned w00 = last ? nA00 : vA00, w01 = last ? nA01 : vA01, w10 = last ? nA10 : vA10, w11 = last ? nA11 : vA11;
            PG8_LDB(B0, 0, 0); PG8_LDB(B1, 0, 1); PG8_SCHED; PG8_LDA(At, 0, 0); PG8_STAGE(PG8_SA(1, 1), a1, vA10, vA11);
            PG8_WAIT_V(8); PG8_WAIT_L(0); PG8_BAR; PG8_MMA(0, 0, At, B0); PG8_MMA(0, 1, At, B1); PG8_BAR; PG8_SCHED;
            if (full) PG8_LDA(At, 0, 1); PG8_STB(PG8_SB(0, 0), b2); PG8_STB(PG8_SB(0, 1), b2 + hstep); PG8_STAGE(PG8_SA(0, 0), a2, w00, w01);
            PG8_WAIT_V(8); PG8_WAIT_L(0); PG8_BAR; if (full) { PG8_MMA(1, 0, At, B0); PG8_MMA(1, 1, At, B1); } PG8_BAR; PG8_SCHED;
            PG8_LDB(B0, 1, 0); PG8_LDB(B1, 1, 1); PG8_SCHED; PG8_LDA(At, 1, 0); PG8_STAGE(PG8_SA(0, 1), a2, w10, w11);
            PG8_WAIT_V(8); PG8_WAIT_L(0); PG8_BAR; PG8_MMA(0, 0, At, B0); PG8_MMA(0, 1, At, B1); PG8_BAR; PG8_SCHED;
            if (full) PG8_LDA(At, 1, 1); PG8_STB(PG8_SB(1, 0), b3); PG8_STB(PG8_SB(1, 1), b3 + hstep); PG8_STAGE(PG8_SA(1, 0), a3, w00, w01);
            PG8_WAIT_V(8); PG8_WAIT_L(0); PG8_BAR; if (full) { PG8_MMA(1, 0, At, B0); PG8_MMA(1, 1, At, B1); } PG8_BAR; PG8_SCHED;
        }
        if constexpr (ALIGN_EPI) { if (wr == 0) PG8_BAR; }
        E(acc, cur, wr, wc, fr, fq);
        if (!has_next) break;
#pragma unroll
        for (int a = 0; a < 2; ++a)
#pragma unroll
            for (int b = 0; b < 2; ++b)
#pragma unroll
                for (int m = 0; m < 4; ++m)
#pragma unroll
                    for (int n = 0; n < 2; ++n) acc[a][b][m][n] = (f32x4){0.f, 0.f, 0.f, 0.f};
        cur = nxt; cA = nA; cB = nB; ++ui; vA00 = nA00; vA01 = nA01; vA10 = nA10; vA11 = nA11;
        if constexpr (ALIGN_EPI) { if (wr == 1) PG8_BAR; }
    }
    PG8_WAIT_V(0);
    if constexpr (!ALIGN_EPI) { if (wr == 0) PG8_BAR; }
    PG8_BAR;
#undef PG8_SA
#undef PG8_SB
#undef PG8_STAGE
#undef PG8_STB
#undef PG8_LDA
#undef PG8_LDB
#undef PG8_MMA
#undef PG8_WAIT_V
#undef PG8_WAIT_L
#undef PG8_BAR
#undef PG8_SCHED
}
}
using pg8::Unit;
using pg8::cvt_pk_bf16;


struct EpiQKV {
    static constexpr bool PERM = true; static constexpr int BMAP = 1;
    bf16_t* Q; bf16_t* Kk; bf16_t* V; const float* rope;
    __device__ __forceinline__ void operator()(const f32x4 (&acc)[2][2][4][2], const Unit& u, int wr, int wc, int fr, int fq) const {
#pragma unroll
        for (int bj = 0; bj < 2; ++bj) {
            const int colbase = u.pn * 256 + wc * 64 + bj * 32;
            const int hs = colbase >> 6, half = (colbase >> 5) & 1;
            const int type = hs / NH, head = hs - type * NH;
            if (type >= 3) continue;
            const int grp = head / 5, shift = 2 * grp, L = SEQ >> shift, dmask = (1 << shift) - 1;
            bf16_t* dst = Q + (size_t)type * (60u * 1024u * 1024u / 2u);
            const bool do_rope = (type < 2) && (half == 0) && (fq < 2);
            const float sc = (type == 0) ? C2 : 1.0f;
#pragma unroll
            for (int ai = 0; ai < 2; ++ai) {
                f32x4 cs0[4], cs1[4];
#pragma unroll
                for (int m = 0; m < 4; ++m) {
                    const int s = (u.pm * 256 + ai * 128 + wr * 64 + m * 16 + fr) & (SEQ - 1);
                    if (do_rope) { cs0[m] = *(const f32x4*)(rope + (size_t)s * 16 + fq * 8); cs1[m] = *(const f32x4*)(rope + (size_t)s * 16 + fq * 8 + 4); }
                    else { cs0[m] = (f32x4){1.f, 0.f, 1.f, 0.f}; cs1[m] = cs0[m]; }
                }
#pragma unroll
                for (int m = 0; m < 4; ++m) {
                    const int row = u.pm * 256 + ai * 128 + wr * 64 + m * 16 + fr;
                    const int b = row >> 14, s = row & (SEQ - 1);
                    const int r = s & dmask, i = s >> shift;
                    const size_t drow = (size_t)(b * NH + head) * SEQ + (size_t)r * L + i;
                    f32x4 v0 = acc[ai][bj][m][0], v1 = acc[ai][bj][m][1];
                    const f32x4 c = (f32x4){cs0[m][0], cs0[m][2], cs1[m][0], cs1[m][2]}, sn = (f32x4){cs0[m][1], cs0[m][3], cs1[m][1], cs1[m][3]};
                    const f32x4 lo = v0 * c - v1 * sn, hi = v1 * c + v0 * sn;
                    v0 = lo * sc; v1 = hi * sc;
                    u32x4 w; w.x = cvt_pk_bf16(v0[0], v0[1]); w.y = cvt_pk_bf16(v0[2], v0[3]); w.z = cvt_pk_bf16(v1[0], v1[1]); w.w = cvt_pk_bf16(v1[2], v1[3]);
                    *(u32x4*)(dst + drow * 64 + half * 32 + fq * 8) = w;
                }
            }
        }
    }
};

struct EpiResid {
    static constexpr bool PERM = false; static constexpr int BMAP = 0;
    const float* base; float* out; const float* gate;
    __device__ __forceinline__ void operator()(const f32x4 (&acc)[2][2][4][2], const Unit& u, int wr, int wc, int fr, int fq) const {
        const int row0 = u.pm * 256 + wr * 64 + fr, col0 = u.pn * 256 + wc * 32 + 4 * fq;
        const int b = (u.pm * 256) >> 14;
        f32x4 gv[2][2];
#pragma unroll
        for (int bj = 0; bj < 2; ++bj)
#pragma unroll
            for (int n = 0; n < 2; ++n) gv[bj][n] = *(const f32x4*)(gate + b * 6144 + col0 + bj * 128 + n * 16);
#pragma unroll
        for (int ai = 0; ai < 2; ++ai) {
            f32x4 pre[4][2][2];
#pragma unroll
            for (int m = 0; m < 4; ++m) { const size_t off = (size_t)(row0 + ai * 128 + m * 16) * D + col0;
#pragma unroll
                for (int bj = 0; bj < 2; ++bj)
#pragma unroll
                    for (int n = 0; n < 2; ++n) pre[m][bj][n] = *(const f32x4*)(base + off + bj * 128 + n * 16); }
#pragma unroll
            for (int m = 0; m < 4; ++m) { const size_t off = (size_t)(row0 + ai * 128 + m * 16) * D + col0;
#pragma unroll
                for (int bj = 0; bj < 2; ++bj)
#pragma unroll
                    for (int n = 0; n < 2; ++n) *(f32x4*)(out + off + bj * 128 + n * 16) = pre[m][bj][n] + gv[bj][n] * acc[ai][bj][m][n]; }
        }
    }
};

struct EpiY {
    static constexpr bool PERM = true; static constexpr int BMAP = 1;
    bf16_t* Y; const float* gate;
    __device__ __forceinline__ void operator()(const f32x4 (&acc)[2][2][4][2], const Unit& u, int wr, int wc, int fr, int fq) const {
        const int row0 = u.pm * 256 + wr * 64 + fr, col0 = u.pn * 256 + wc * 64 + 8 * fq;
        const int b = (u.pm * 256) >> 14;
        f32x4 gv[2][2];
#pragma unroll
        for (int bj = 0; bj < 2; ++bj)
#pragma unroll
            for (int n = 0; n < 2; ++n) gv[bj][n] = *(const f32x4*)(gate + b * 6144 + col0 + bj * 32 + n * 4);
#pragma unroll
        for (int ai = 0; ai < 2; ++ai)
#pragma unroll
            for (int m = 0; m < 4; ++m) { bf16_t* yp = Y + (size_t)(row0 + ai * 128 + m * 16) * D + col0;
#pragma unroll
                for (int bj = 0; bj < 2; ++bj) { const f32x4 y0 = gv[bj][0] * acc[ai][bj][m][0], y1 = gv[bj][1] * acc[ai][bj][m][1];
                    *(u32x4*)(yp + bj * 32) = (u32x4){cvt_pk_bf16(y0[0], y0[1]), cvt_pk_bf16(y0[2], y0[3]), cvt_pk_bf16(y1[0], y1[1]), cvt_pk_bf16(y1[2], y1[3])}; } }
    }
};

template <int MODE = 0> struct EpiGelu {
    static constexpr bool PERM = true; static constexpr int BMAP = 1;
    bf16_t* U; bf16_t* V; float* stats;
    template <bool ISV> __device__ __forceinline__ void run(const f32x4 (&acc)[2][2][4][2], const Unit& u, int wr, int wc, int fr, int fq) const {
        bf16_t* dst = ISV ? V : U;
        const int colt = (ISV ? u.pn - 8 : u.pn) * 256 + wc * 64 + 8 * fq;
#pragma unroll
        for (int ai = 0; ai < 2; ++ai)
#pragma unroll
            for (int m = 0; m < 4; ++m) {
                const int row = u.pm * 256 + ai * 128 + wr * 64 + m * 16 + fr;
                f32x2 s1v = {0.f, 0.f}, s2v = {0.f, 0.f};
#pragma unroll
                for (int bj = 0; bj < 2; ++bj) {
                    const f32x4 v0 = acc[ai][bj][m][0], v1 = acc[ai][bj][m][1];
                    if constexpr (MODE == 2) { asm volatile("" :: "v"(v0), "v"(v1)); continue; }
                    const f32x2 a = pg8::gelu_pk((f32x2){v0[0], v0[1]}), bq = pg8::gelu_pk((f32x2){v0[2], v0[3]}), c = pg8::gelu_pk((f32x2){v1[0], v1[1]}), d = pg8::gelu_pk((f32x2){v1[2], v1[3]});
                    if constexpr (ISV) { s1v += (a + bq) + (c + d); s2v = a * a + s2v; s2v = bq * bq + s2v; s2v = c * c + s2v; s2v = d * d + s2v; }
                    u32x4 w; w.x = cvt_pk_bf16(a.x, a.y); w.y = cvt_pk_bf16(bq.x, bq.y); w.z = cvt_pk_bf16(c.x, c.y); w.w = cvt_pk_bf16(d.x, d.y);
                    if constexpr (MODE == 0) __builtin_nontemporal_store(w, (u32x4*)(dst + (size_t)row * GH + colt + bj * 32)); else asm volatile("" :: "v"(w));
                }
                if constexpr (ISV && MODE == 0) {
                    float s1 = s1v.x + s1v.y, s2 = s2v.x + s2v.y;
                    s1 += __shfl_xor(s1, 16); s1 += __shfl_xor(s1, 32); s2 += __shfl_xor(s2, 16); s2 += __shfl_xor(s2, 32);
                    if (fq == 0) *(f32x2*)(stats + ((size_t)row * 32 + (u.pn - 8) * 4 + wc) * 2) = (f32x2){s1, s2};
                }
            }
    }
    __device__ __forceinline__ void operator()(const f32x4 (&acc)[2][2][4][2], const Unit& u, int wr, int wc, int fr, int fq) const {
        if (u.pn >= 8) run<true>(acc, u, wr, wc, fr, fq); else run<false>(acc, u, wr, wc, fr, fq);
    }
};

struct MoeTab { LAS unsigned char* lds; int ntiles;
    __device__ __forceinline__ int cnt(int b) const { return __builtin_amdgcn_readfirstlane(((const LAS int*)(lds + TAB_OFF))[b]); }
    __device__ __forceinline__ int tpre(int b) const { return __builtin_amdgcn_readfirstlane(((const LAS int*)(lds + TAB_OFF + 128))[b]); }
    __device__ __forceinline__ int tileb(int t) const { return __builtin_amdgcn_readfirstlane((int)((const LAS unsigned char*)(lds + TAB_OFF + 256))[t]); }
};
__device__ __forceinline__ MoeTab moe_tab(LAS unsigned char* lds) {
    MoeTab t; t.lds = lds; t.ntiles = __builtin_amdgcn_readfirstlane(((const LAS int*)(lds + TAB_OFF + 128))[24]); return t;
}
__device__ __forceinline__ void moe_tab_build(LAS unsigned char* lds, const unsigned* gcnt, const int t) {
    LAS int* cnt = (LAS int*)(lds + TAB_OFF); LAS int* tpre = (LAS int*)(lds + TAB_OFF + 128); LAS unsigned char* tileb = (LAS unsigned char*)(lds + TAB_OFF + 256);
    __syncthreads();
    if (t < 64) {
        const int c = t < NBUCK ? (int)__hip_atomic_load(gcnt + t, __ATOMIC_RELAXED, __HIP_MEMORY_SCOPE_AGENT) : 0;
        const int nt = (c + 255) >> 8;
        int x = nt;
#pragma unroll
        for (int d = 1; d < 32; d <<= 1) { const int y = __shfl_up(x, d); if (t >= d) x += y; }
        const int pre = x - nt;
        if (t < NBUCK) { cnt[t] = c; tpre[t] = pre;
#pragma unroll 1
            for (int k = 0; k < nt; ++k) tileb[pre + k] = (unsigned char)t; }
        if (t == NBUCK - 1) tpre[NBUCK] = x;
    }
    __syncthreads();
}
__device__ __forceinline__ int pair_a(int p) { return p < 3 ? 0 : (p < 5 ? 1 : 2); }
__device__ __forceinline__ int pair_b(int p) { return p == 0 ? 1 : ((p == 1 || p == 3) ? 2 : 3); }

constexpr int TOKL_OFF = LDSCTL_OFF + 2048;
struct MoeOrder {
    static constexpr bool HALFCAP = true;
    const char* A; size_t tstepA; const char* B; int mode; int layer; MoeTab tab; int nwg, G, c;
    __device__ __forceinline__ bool split() const { return true; }
    __device__ __forceinline__ int tail_lo() const { const int R = nwg / G, rem = nwg - R * G; const int lo = (split() && 2 * rem <= G) ? 2 * ((rem + 7) & ~7) : rem; return (G - lo >= G / 2) ? lo : 0; }
    __device__ bool next(int i, Unit& u) const {
        const int R = nwg / G, rem = nwg - R * G;
        int L; u.h = 0;
        if (i < R) L = i * G + c;
        else if (i > R) return false;
        else if (!split() || 2 * rem > G) { if (c >= rem) return false; L = R * G + c; }
        else { const int x = c & 7, o = c >> 3, Lt = 8 * (o >> 1) + x; if (Lt >= rem) return false; L = R * G + Lt; u.h = 1 + (o & 1); }
        const int wgid = pg8::xcd_remap(L, nwg); u.pm = wgid >> 2; u.pn = wgid & 3;
        if (u.h == 2) { const int bk = tab.tileb(u.pm); if ((u.pm - tab.tpre(bk)) * 256 + 128 >= tab.cnt(bk)) return false; }
        return true;
    }
    __device__ __forceinline__ const char* abase(const Unit& u) const { return mode == 0 ? A : A + (size_t)u.pm * tstepA; }
    __device__ __forceinline__ const char* bptr(const Unit& u) const {
        const int bk = tab.tileb(u.pm);
        if (mode == 0) { const int g = bk / 6, p = bk - g * 6; const int e = 4 * g + ((u.pn >> 1) ? pair_b(p) : pair_a(p));
            return B + ((size_t)((layer * NEXP + e) * 512 + (u.pn & 1) * 256)) * 1024 * 2; }
        { const int g = bk / 6, p = bk - g * 6;
          return B + ((size_t)((layer * 4 + g) * 1024 + u.pn * 256)) * 1024 * 2 + pair_a(p) * 256 * 2; }
    }
    __device__ __forceinline__ int ldb(int K) const { return mode == 0 ? K : 1024; }
    __device__ __forceinline__ int kjump(const Unit& u) const { if (mode == 0) return 0; const int bk = tab.tileb(u.pm), p = bk % 6; return (pair_b(p) - pair_a(p) - 1) * 256 * 2; }
    __device__ __forceinline__ void aoffs(const Unit& u, int ui, const int (&R)[2], const int (&C)[2], int K, unsigned& v00, unsigned& v01, unsigned& v10, unsigned& v11) const {
        if (mode == 0) { const LAS int* tl = (const LAS int*)(tab.lds + TOKL_OFF) + ui * 256;
            v00 = (unsigned)(tl[R[0]] * K + C[0]) * 2u; v01 = (unsigned)(tl[R[1]] * K + C[1]) * 2u; v10 = (unsigned)(tl[128 + R[0]] * K + C[0]) * 2u; v11 = (unsigned)(tl[128 + R[1]] * K + C[1]) * 2u; }
        else { const unsigned ro = u.h == 2 ? (unsigned)(128 * K * 2) : 0u;
            v00 = (unsigned)(R[0] * K + C[0]) * 2u + ro; v01 = (unsigned)(R[1] * K + C[1]) * 2u + ro; v10 = u.h ? v00 : v00 + (unsigned)(128 * K * 2); v11 = u.h ? v01 : v01 + (unsigned)(128 * K * 2); }
    }
    __device__ __forceinline__ void fill_tokl(const int* ltok, const int tid) const {
        LAS int* tl = (LAS int*)(tab.lds + TOKL_OFF); Unit u;
        for (int i = 0; i < 4 && next(i, u); ++i) {
            const int bk = tab.tileb(u.pm), idx0 = (u.pm - tab.tpre(bk)) * 256, cnt = tab.cnt(bk);
            if (tid < 256) { int idx = idx0 + (u.h ? (tid & 127) + 128 * (u.h - 1) : tid); idx = idx < cnt ? idx : cnt - 1; tl[i * 256 + tid] = ltok[(size_t)bk * T + idx]; }
        }
        __syncthreads();
    }
};

struct EpiAct {
    static constexpr bool PERM = true; static constexpr int BMAP = 0;
    bf16_t* ACT; const float* lwa; const float* lwb; MoeTab tab;
    __device__ __forceinline__ void operator()(const f32x4 (&acc)[2][2][4][2], const Unit& u, int wr, int wc, int fr, int fq) const {
        const int bk = tab.tileb(u.pm), idx0 = (u.pm - tab.tpre(bk)) * 256, cnt = tab.cnt(bk);
        const float* lw = ((u.pn >> 1) ? lwb : lwa) + (size_t)bk * T;
        const int col = u.pn * 128 + wc * 32 + 8 * fq;
        const int roff = u.h == 2 ? 128 : 0;
        float wrow[2][4];
#pragma unroll
        for (int ai = 0; ai < 2; ++ai)
#pragma unroll
            for (int m = 0; m < 4; ++m) { const int idx = idx0 + roff + ai * 128 + wr * 64 + m * 16 + fr; wrow[ai][m] = idx < cnt ? lw[idx] : 0.f; }
#pragma unroll
        for (int ai = 0; ai < 2; ++ai) {
            if (ai == 1 && u.h != 0) continue;
#pragma unroll
            for (int m = 0; m < 4; ++m) {
                const int rl = roff + ai * 128 + wr * 64 + m * 16 + fr;
                const float w = wrow[ai][m];
                float o[8];
#pragma unroll
                for (int n = 0; n < 2; ++n)
#pragma unroll
                    for (int j = 0; j < 4; ++j) { const float g = acc[ai][0][m][n][j], up = acc[ai][1][m][n][j];
                        const float sg = g * __builtin_amdgcn_rcpf(1.0f + __builtin_amdgcn_exp2f(-1.4426950408889634f * g));
                        o[n * 4 + j] = sg * up * w; }
                u32x4 pw; pw.x = cvt_pk_bf16(o[0], o[1]); pw.y = cvt_pk_bf16(o[2], o[3]); pw.z = cvt_pk_bf16(o[4], o[5]); pw.w = cvt_pk_bf16(o[6], o[7]);
                *(u32x4*)(ACT + (size_t)(u.pm * 256 + rl) * 512 + col) = pw;
            }
        }
    }
};

struct EpiDown {
    static constexpr bool PERM = true; static constexpr int BMAP = 1;
    bf16_t* Y; const float* gate; const int* ltok; MoeTab tab;
    __device__ __forceinline__ void operator()(const f32x4 (&acc)[2][2][4][2], const Unit& u, int wr, int wc, int fr, int fq) const {
        const int bk = tab.tileb(u.pm), idx0 = (u.pm - tab.tpre(bk)) * 256, cnt = tab.cnt(bk);
        const int* lt = ltok + (size_t)bk * T;
        const int col0 = u.pn * 256 + wc * 64 + 8 * fq;
        const int roff = u.h == 2 ? 128 : 0;
        int tokr[2][4];
#pragma unroll
        for (int ai = 0; ai < 2; ++ai)
#pragma unroll
            for (int m = 0; m < 4; ++m) { const int idx = idx0 + roff + ai * 128 + wr * 64 + m * 16 + fr; tokr[ai][m] = (idx < cnt && (ai == 0 || u.h == 0)) ? lt[idx] : -1; }
        f32x4 g0[2][2], g1[2][2];
#pragma unroll
        for (int bj = 0; bj < 2; ++bj)
#pragma unroll
            for (int n = 0; n < 2; ++n) { g0[bj][n] = *(const f32x4*)(gate + col0 + bj * 32 + n * 4); g1[bj][n] = *(const f32x4*)(gate + 6144 + col0 + bj * 32 + n * 4); }
#pragma unroll
        for (int ai = 0; ai < 2; ++ai)
#pragma unroll
            for (int m = 0; m < 4; ++m) {
                const int tok = tokr[ai][m];
                if (tok >= 0) {
                    const bool b1 = tok >= SEQ;
#pragma unroll
                    for (int bj = 0; bj < 2; ++bj) {
                        const f32x4 ga = b1 ? g1[bj][0] : g0[bj][0], gb = b1 ? g1[bj][1] : g0[bj][1];
                        const f32x4 y0 = ga * acc[ai][bj][m][0], y1 = gb * acc[ai][bj][m][1];
                        *(u32x4*)(Y + (size_t)tok * D + col0 + bj * 32) = (u32x4){cvt_pk_bf16(y0[0], y0[1]), cvt_pk_bf16(y0[2], y0[3]), cvt_pk_bf16(y1[0], y1[1]), cvt_pk_bf16(y1[2], y1[3])};
                    }
                }
            }
    }
};

struct Args { const float* in[21]; float* out; unsigned char* ws; int ph_lo, ph_hi; };
struct Ctx {
    LAS unsigned char* lds; int tid, lane, wave, G, bx;
    float* out; unsigned char* ws;
};
enum { I_X = 0, I_C, I_NMIX, I_NFFN, I_WADA, I_BADA, I_WQKV, I_AWO, I_WIN, I_VGAIN, I_WS, I_BS, I_BWO, I_RWG, I_RBG, I_RWE, I_RBE, I_EWG, I_EWU, I_EWD, I_FNORM };

__device__ __forceinline__ void tr_load(const float* W, int ldw, int k0, int n0, LAS float* scr, int lane) {
#pragma unroll 8
    for (int i = 0; i < 32; ++i) { const int kk = 2 * i + (lane >> 5); scr[kk * 33 + (lane & 31)] = __builtin_nontemporal_load(W + (size_t)(k0 + kk) * ldw + n0 + (lane & 31)); }
    LDS_WAIT(); asm volatile("" ::: "memory");
}
template <class RowFn> __device__ __forceinline__ void tr_store(LAS float* scr, int lane, RowFn rowfn) {
    const int c = lane & 7;
#pragma unroll
    for (int j = 0; j < 4; ++j) { const int n = (lane >> 3) + 8 * j; const LAS float* s = scr + (8 * c) * 33 + n;
        u32x4 o; o.x = pk2(s[0 * 33], s[1 * 33]); o.y = pk2(s[2 * 33], s[3 * 33]); o.z = pk2(s[4 * 33], s[5 * 33]); o.w = pk2(s[6 * 33], s[7 * 33]);
        bf16_t* p = rowfn(n); if (p) *(u32x4*)(p + 8 * c) = o; }
    LDS_WAIT(); asm volatile("" ::: "memory");
}
__device__ __forceinline__ int qk_perm_row(int n) {
    if (n >= 2 * AW) return n;
    const int d = n & 63; if (d >= 16) return n;
    const int b = d >> 3, rem = d & 7, a = rem >> 2, c = rem & 3;
    return (n & ~63) + 8 * a + 4 * b + c;
}

__device__ __forceinline__ void expert_items(Ctx& F, const Args& A, int layer, int widx, int nw) {
    unsigned char* ws = F.ws;
    LAS float* scr = (LAS float*)(F.lds + F.wave * 16384);
    bf16_t* Bgu = (bf16_t*)(ws + WS_BGU); bf16_t* Bdp = (bf16_t*)(ws + WS_BDP);
    constexpr int I_E = 16 * 16 * 8, I_G = 16 * 4 * 32;
    for (int it = widx; it < 2 * I_E + I_G; it += nw) {
        int r = it;
        if (r < 2 * I_E) { const bool up = r >= I_E; if (up) r -= I_E;
            const int le = layer * 16 + r / 128, q = r % 128, kb = q / 8, nb = q % 8, k0 = kb * 64, n0 = nb * 32;
            tr_load(A.in[up ? I_EWU : I_EWG] + (size_t)le * D * DE, DE, k0, n0, scr, F.lane);
            tr_store(scr, F.lane, [&](int n) { const int j = n0 + n; return Bgu + ((size_t)le * 512 + (j >> 7) * 256 + (up ? 128 : 0) + (j & 127)) * D + k0; }); continue; } r -= 2 * I_E;
        { const int le = layer * 16 + r / 128, q = r % 128, kb = q / 32, nb = q % 32, k0 = kb * 64, n0 = nb * 32;
            const int l = le >> 4, e = le & 15, g = e >> 2, li = e & 3;
            tr_load(A.in[I_EWD] + (size_t)le * DE * D, D, k0, n0, scr, F.lane);
            { bf16_t* base = Bdp + ((size_t)(l * 4 + g) * D) * 1024 + li * 256 + k0;
                const int c = F.lane & 7;
#pragma unroll
                for (int j = 0; j < 4; ++j) { const int n = (F.lane >> 3) + 8 * j; const LAS float* s = scr + (8 * c) * 33 + n;
                    u32x4 o; o.x = pk2(s[0 * 33], s[1 * 33]); o.y = pk2(s[2 * 33], s[3 * 33]); o.z = pk2(s[4 * 33], s[5 * 33]); o.w = pk2(s[6 * 33], s[7 * 33]);
                    *(u32x4*)(base + (size_t)(n0 + n) * 1024 + 8 * c) = o; }
            }
            LDS_WAIT(); asm volatile("" ::: "memory");
        }
    }
}

__device__ __forceinline__ void gmlp_items(Ctx& F, const Args& A, int widx, int nw) {
    unsigned char* ws = F.ws;
    LAS float* scr = (LAS float*)(F.lds + F.wave * 16384);
    bf16_t* Win = (bf16_t*)(ws + WS_WIN); bf16_t* Wo2 = (bf16_t*)(ws + WS_WO2);
    constexpr int I_C2 = 16 * 128, I_D = 32 * 32;
    for (int it = widx; it < I_C2 + I_D; it += nw) {
        int r = it;
        if (r < I_C2) { const int kb = r / 128, nb = r % 128, k0 = kb * 64, n0 = nb * 32; tr_load(A.in[I_WIN], FF, k0, n0, scr, F.lane);
            tr_store(scr, F.lane, [&](int n) { return Win + (size_t)(n0 + n) * D + k0; }); continue; } r -= I_C2;
        { const int kb = r / 32, nb = r % 32, k0 = kb * 64, n0 = nb * 32; tr_load(A.in[I_BWO], D, k0, n0, scr, F.lane);
            tr_store(scr, F.lane, [&](int n) { return Wo2 + (size_t)(n0 + n) * GH + k0; }); }
    }
}
__device__ __forceinline__ void p0_prep(Ctx& F, const Args& A) {
    unsigned char* ws = F.ws;
    {
        LAS float* CA = (LAS float*)F.lds;
        LAS float* RED = (LAS float*)(F.lds + 8192);
        for (int i = F.tid; i < 2 * D; i += NTHR) { const float v = A.in[I_C][i]; CA[i] = v / (1.0f + __expf(-v)); }
        __syncthreads();
        float* mod = (float*)(ws + WS_MOD);
        for (int task = F.bx; task < 192; task += F.G) {
            const int l = task / 96, j0 = (task % 96) * 64;
            const float* W = A.in[I_WADA] + (size_t)l * D * 6144 + j0 + F.lane;
            float a0 = 0.f, a1 = 0.f;
#pragma unroll 1
            for (int k0 = F.wave * 128; k0 < F.wave * 128 + 128; k0 += 32) {
                float wv[32];
#pragma unroll
                for (int j = 0; j < 32; ++j) wv[j] = __builtin_nontemporal_load(W + (size_t)(k0 + j) * 6144);
#pragma unroll
                for (int j = 0; j < 32; ++j) { a0 += CA[k0 + j] * wv[j]; a1 += CA[D + k0 + j] * wv[j]; }
            }
            RED[(F.wave * 2 + 0) * 64 + F.lane] = a0; RED[(F.wave * 2 + 1) * 64 + F.lane] = a1;
            __syncthreads();
            if (F.wave < 2) { float s = 0.f;
#pragma unroll
                for (int w = 0; w < 8; ++w) s += RED[(w * 2 + F.wave) * 64 + F.lane];
                mod[(l * 2 + F.wave) * 6144 + j0 + F.lane] = s + A.in[I_BADA][l * 6144 + j0 + F.lane]; }
            __syncthreads();
        }
    }
    {
        LAS float* scr = (LAS float*)(F.lds + F.wave * 16384);
        const int gw = F.bx * NWAVES + F.wave, NGW = F.G * NWAVES;
        constexpr int I_A = 16 * 90, I_B = 15 * 32;
        constexpr int NITEMS = I_A + I_B;
        bf16_t* Wqkv = (bf16_t*)(ws + WS_WQKV); bf16_t* Wo = (bf16_t*)(ws + WS_WO); bf16_t* Win = (bf16_t*)(ws + WS_WIN); bf16_t* Wo2 = (bf16_t*)(ws + WS_WO2);
        bf16_t* Bgu = (bf16_t*)(ws + WS_BGU); bf16_t* Bdp = (bf16_t*)(ws + WS_BDP);
        for (int it = gw; it < NITEMS; it += NGW) {
            int r = it;
            if (r < I_A) { const int kb = r / 90, nb = r % 90, k0 = kb * 64, n0 = nb * 32; tr_load(A.in[I_WQKV], NQKV, k0, n0, scr, F.lane);
                tr_store(scr, F.lane, [&](int n) { return Wqkv + (size_t)qk_perm_row(n0 + n) * D + k0; }); continue; } r -= I_A;
            if (r < I_B) { const int kb = r / 32, nb = r % 32, k0 = kb * 64, n0 = nb * 32; tr_load(A.in[I_AWO], D, k0, n0, scr, F.lane);
                tr_store(scr, F.lane, [&](int n) { return Wo + (size_t)(n0 + n) * D + k0; }); continue; } r -= I_B;
        }
        expert_items(F, A, 0, gw, NGW);
        const int gt = F.bx * NTHR + F.tid, NGT = F.G * NTHR;
        for (int i = gt; i < 192 * 128; i += NGT) *(u32x4*)(Wqkv + (size_t)NQKV * D + (size_t)i * 8) = (u32x4){0u, 0u, 0u, 0u};
        for (int i = gt; i < 1024 * 8; i += NGT) *(u32x4*)(Wo + (size_t)(i >> 3) * D + AW + (i & 7) * 8) = (u32x4){0u, 0u, 0u, 0u};
        float* rope = (float*)(ws + WS_ROPE);
        for (int i = gt; i < SEQ * 8; i += NGT) { const int pos = i >> 3, j = i & 7; const double inv = pow(500000.0, -(double)j / 8.0); const double ang = (double)pos * inv;
            rope[i * 2] = (float)cos(ang); rope[i * 2 + 1] = (float)sin(ang); }
        float* WR = (float*)(ws + WS_WR); float* WRB = (float*)(ws + WS_WR + 512 * 1024);
        for (int i = gt; i < 2 * D * 20; i += NGT) { const int l = i / (D * 20), rem = i % (D * 20), k = rem / 20, j = rem % 20;
            WR[i] = j < 4 ? A.in[I_RWG][((size_t)l * D + k) * 4 + j] : A.in[I_RWE][(((size_t)l * 4 + ((j - 4) >> 2)) * D + k) * 4 + ((j - 4) & 3)]; }
        for (int i = gt; i < 2 * 20; i += NGT) { const int l = i / 20, j = i % 20; WRB[l * 32 + j] = j < 4 ? A.in[I_RBG][l * 4 + j] : A.in[I_RBE][l * 16 + (j - 4)]; }
    }
}


__device__ __forceinline__ void route_prep(Ctx& F, const float* norm_ffn) {
    const float* mod = (const float*)(F.ws + WS_MOD);
    const float* WR = (const float*)(F.ws + WS_WR); const float* WRB = (const float*)(F.ws + WS_WR + 512 * 1024);
    bf16_t* WF = (bf16_t*)(F.ws + WS_WF); float* B2 = (float*)(F.ws + WS_WF + 768 * 1024);
    const int gt = F.bx * NTHR + F.tid, NGT = F.G * NTHR;
    for (int i = gt; i < 2 * 2 * 64 * 64; i += NGT) {
        const int lane = i & 63, ks = (i >> 6) & 63, b = (i >> 12) & 1, l = i >> 13;
        const int n = lane & 31, k0 = 16 * ks + 8 * (lane >> 5);
        unsigned hiw[4], low[4];
#pragma unroll
        for (int j2 = 0; j2 < 4; ++j2) {
            float v[2];
#pragma unroll
            for (int e = 0; e < 2; ++e) { const int k = k0 + 2 * j2 + e;
                const float gs = norm_ffn[l * D + k] * (1.0f + mod[(l * 2 + b) * 6144 + 4 * D + k]);
                v[e] = n < 20 ? gs * WR[((size_t)l * D + k) * 20 + n] : 0.f; }
            const unsigned h0 = f2bf(v[0]), h1 = f2bf(v[1]);
            hiw[j2] = h0 | (h1 << 16);
            low[j2] = pk2(v[0] - bf2f((unsigned short)h0), v[1] - bf2f((unsigned short)h1));
        }
        const size_t o = ((size_t)((l * 2 + b) * 2) * 64 + ks) * 64 + lane;
        *(u32x4*)(WF + o * 8) = (u32x4){hiw[0], hiw[1], hiw[2], hiw[3]};
        *(u32x4*)(WF + (o + 64 * 64) * 8) = (u32x4){low[0], low[1], low[2], low[3]};
    }
    const int gw = F.bx * NWAVES + F.wave, NGW = F.G * NWAVES;
    for (int i = gw; i < 2 * 2 * 20; i += NGW) {
        const int n = i % 20, lb = i / 20, l = lb >> 1; float s = 0.f;
        for (int k = F.lane; k < D; k += 64) s += mod[lb * 6144 + 3 * D + k] * WR[((size_t)l * D + k) * 20 + n];
        s = wave_sum(s);
        if (F.lane == 0) B2[lb * 32 + n] = s + WRB[l * 32 + n];
    }
}

template <bool ADDY, bool SRCBF = false, bool WRX = false> __device__ __forceinline__ void norm_rows(Ctx& F, const float* src, const float* gamma, const float* sh, const float* sc, bf16_t* dst, const bf16_t* Y = nullptr, const bf16_t* Yb = nullptr, bf16_t* xwb = nullptr) {
    const int gw = F.bx * NWAVES + F.wave, NGW = F.G * NWAVES;
    f32x4 gs[4], shv[4]; int curb = -1;
    for (int m = gw; m < T; m += NGW) {
        const int b = m >> 14;
        if (b != curb) { curb = b;
#pragma unroll
            for (int j = 0; j < 4; ++j) { const int k = 4 * F.lane + 256 * j; const f32x4 g = *(const f32x4*)(gamma + k), s = *(const f32x4*)(sc + b * 6144 + k); gs[j] = g * (s + 1.0f); shv[j] = *(const f32x4*)(sh + b * 6144 + k); } }
        const f32x4* xr = (const f32x4*)(src + (size_t)m * D) + F.lane;
        f32x4 v[4]; float ss = 0.f;
        u32x2 yv[4], y2v[4];
#pragma unroll
        for (int j = 0; j < 4; ++j) {
            if constexpr (SRCBF) { const u32x2 xb = __builtin_nontemporal_load((const u32x2*)((const bf16_t*)src + (size_t)m * D) + F.lane + 64 * j); v[j] = (f32x4){bflo(xb.x), bfhi(xb.x), bflo(xb.y), bfhi(xb.y)}; }
            else v[j] = __builtin_nontemporal_load(xr + 64 * j);
            if constexpr (ADDY) { yv[j] = __builtin_nontemporal_load((const u32x2*)(Y + (size_t)m * D) + F.lane + 64 * j); y2v[j] = __builtin_nontemporal_load((const u32x2*)(Yb + (size_t)m * D) + F.lane + 64 * j); } }
#pragma unroll
        for (int j = 0; j < 4; ++j) {
            if constexpr (ADDY) { const u32x2 y = yv[j], y2 = y2v[j];
                v[j] = (v[j] + (f32x4){bflo(y.x), bfhi(y.x), bflo(y.y), bfhi(y.y)}) + (f32x4){bflo(y2.x), bfhi(y2.x), bflo(y2.y), bfhi(y2.y)}; }
            if constexpr (ADDY || WRX) __builtin_nontemporal_store((u32x2){pk2(v[j].x, v[j].y), pk2(v[j].z, v[j].w)}, (u32x2*)(xwb + (size_t)m * D) + F.lane + 64 * j);
            ss += (v[j].x * v[j].x + v[j].y * v[j].y) + (v[j].z * v[j].z + v[j].w * v[j].w); }
        const float r = 1.0f / sqrtf(wave_sum(ss) * (1.0f / D) + EPS);
        u32x2* o8 = (u32x2*)(dst + (size_t)m * D) + F.lane;
#pragma unroll
        for (int j = 0; j < 4; ++j) { const f32x4 h = v[j] * r * gs[j] + shv[j]; o8[64 * j] = (u32x2){pk2(h.x, h.y), pk2(h.z, h.w)}; }
    }
}
__device__ __forceinline__ void final_norm(Ctx& F, const bf16_t* xr_, float* dst_, const float* gamma, const float oscale, const bf16_t* Y, const bf16_t* Yb) {
    const int gw = F.bx * NWAVES + F.wave, NGW = F.G * NWAVES;
    f32x4 gs[4];
#pragma unroll
    for (int j = 0; j < 4; ++j) gs[j] = *(const f32x4*)(gamma + 4 * F.lane + 256 * j) * oscale;
    for (int m = gw; m < T; m += NGW) {
        const u32x2* xr = (const u32x2*)(xr_ + (size_t)m * D) + F.lane;
        f32x4 v[4]; float ss = 0.f;
#pragma unroll
        for (int j = 0; j < 4; ++j) { { const u32x2 xb = __builtin_nontemporal_load(xr + 64 * j); v[j] = (f32x4){bflo(xb.x), bfhi(xb.x), bflo(xb.y), bfhi(xb.y)}; } const u32x2 y = __builtin_nontemporal_load((const u32x2*)(Y + (size_t)m * D) + F.lane + 64 * j), y2 = __builtin_nontemporal_load((const u32x2*)(Yb + (size_t)m * D) + F.lane + 64 * j);
            v[j] = (v[j] + (f32x4){bflo(y.x), bfhi(y.x), bflo(y.y), bfhi(y.y)}) + (f32x4){bflo(y2.x), bfhi(y2.x), bflo(y2.y), bfhi(y2.y)};
            ss += (v[j].x * v[j].x + v[j].y * v[j].y) + (v[j].z * v[j].z + v[j].w * v[j].w); }
        const float r = 1.0f / sqrtf(wave_sum(ss) * (1.0f / D) + EPS);
        f32x4* dr = (f32x4*)(dst_ + (size_t)m * D) + F.lane;
#pragma unroll
        for (int j = 0; j < 4; ++j) __builtin_nontemporal_store(v[j] * r * gs[j], dr + 64 * j);
    }
}

__device__ __forceinline__ s16x4 vtr(const LAS unsigned char* p) { typedef short v4i16_t __attribute__((ext_vector_type(4))); return __builtin_bit_cast(s16x4, __builtin_amdgcn_ds_read_tr16_b64_v4i16((LAS v4i16_t*)p)); }
__device__ __forceinline__ void attn_load(Ctx& F, int bh, int blk, const bf16_t* Q, const bf16_t* Kk, const bf16_t* V, u32x4 (&kpre)[6], u32x4 (&vpre)[6], bool second) {
    const int head = bh % NH, grp = head / 5, shift = 2 * grp, L = SEQ >> shift;
    const int row0 = blk * 256, seg = row0 / L, i0 = row0 - seg * L;
    const size_t hbase = ((size_t)bh * SEQ + (size_t)seg * L) * 64;
    const bf16_t* Kh = Kk + hbase; const bf16_t* Vh = V + hbase;
#pragma unroll
    for (int pass = 0; pass < 6; ++pass) {
        if (pass < 2 && second) continue;
        const int idx = pass * NTHR + F.tid, row = idx >> 3, ch = idx & 7;
        int i = i0 - 64 + row; i = i < 0 ? 0 : (i > L - 1 ? L - 1 : i);
        kpre[pass] = __builtin_nontemporal_load((const u32x4*)(Kh + (size_t)i * 64 + ch * 8)); vpre[pass] = __builtin_nontemporal_load((const u32x4*)(Vh + (size_t)i * 64 + ch * 8));
    }
}
__device__ __forceinline__ void attn_loadq(Ctx& F, int bh, int blk, const bf16_t* Q, bf16x8 (&qf)[4]) {
    const int head = bh % NH, grp = head / 5, shift = 2 * grp, L = SEQ >> shift;
    const int row0 = blk * 256, seg = row0 / L, i0 = row0 - seg * L;
    const bf16_t* Qh = Q + ((size_t)bh * SEQ + (size_t)seg * L) * 64;
    const int qi = i0 + 32 * F.wave + (F.lane & 31);
#pragma unroll
    for (int ks = 0; ks < 4; ++ks) qf[ks] = *(const bf16x8*)(Qh + (size_t)qi * 64 + 16 * ks + 8 * (F.lane >> 5));
}
__device__ __forceinline__ void attn_stage(Ctx& F, const u32x4 (&kpre)[6], const u32x4 (&vpre)[6], bool second) {
    LAS unsigned char* KL = F.lds; LAS unsigned char* VL = F.lds + 49152;
    if (second) {
        u32x4 ck[2], cv[2];
#pragma unroll
        for (int j = 0; j < 2; ++j) { const int o = (F.tid + j * NTHR) * 16; ck[j] = *(const LAS u32x4*)(KL + 256 * 128 + o); cv[j] = *(const LAS u32x4*)(VL + 256 * 128 + o); }
        __syncthreads();
#pragma unroll
        for (int j = 0; j < 2; ++j) { const int o = (F.tid + j * NTHR) * 16; *(LAS u32x4*)(KL + o) = ck[j]; *(LAS u32x4*)(VL + o) = cv[j]; }
    }
#pragma unroll
    for (int pass = 0; pass < 6; ++pass) {
        if (pass < 2 && second) continue;
        const int idx = pass * NTHR + F.tid, row = idx >> 3, ch = idx & 7;
        *(LAS u32x4*)(KL + row * 128 + ((ch ^ ((row >> 1) & 7)) << 4)) = kpre[pass];
        *(LAS u32x4*)(VL + row * 128 + ((((ch >> 2) ^ ((row >> 1) & 1))) << 6) + (ch & 3) * 16) = vpre[pass];
    }
}
__device__ __forceinline__ void attn_compute(Ctx& F, int bh, int blk, bf16x8 (&qf)[4], bf16_t* O, float* LSE, const bf16_t* Q, int bhn, int blkn) {
    const int head = bh % NH, b = bh / NH, grp = head / 5, shift = 2 * grp, L = SEQ >> shift;
    const int row0 = blk * 256, seg = row0 / L, i0 = row0 - seg * L;
    LAS unsigned char* KL = F.lds; LAS unsigned char* VL = F.lds + 49152;
    const int w = F.wave, r32 = F.lane & 31, hi = F.lane >> 5;
    const int qi = i0 + 32 * w + r32;
    f32x16 st[5];
#pragma unroll
    for (int j = 0; j < 5; ++j) {
        st[j] = (f32x16){0.f, 0.f, 0.f, 0.f, 0.f, 0.f, 0.f, 0.f, 0.f, 0.f, 0.f, 0.f, 0.f, 0.f, 0.f, 0.f};
        const int row = 32 * w + 32 * j + r32;
#pragma unroll
        for (int ks = 0; ks < 4; ++ks) {
            const bf16x8 kf = *(const LAS bf16x8*)(KL + row * 128 + (((2 * ks + hi) ^ ((row >> 1) & 7)) << 4));
            st[j] = __builtin_amdgcn_mfma_f32_32x32x16_bf16(kf, qf[ks], st[j], 0, 0, 0);
        }
    }
    float mx = -INFINITY;
    if ((i0 < 64) | (i0 + 320 > L)) {
#pragma unroll
        for (int j = 0; j < 5; ++j)
#pragma unroll
            for (int r = 0; r < 16; ++r) {
                const int cr = crow(r, hi), ki = i0 + 32 * w - 64 + 32 * j + cr;
                bool ok = (ki >= 0) && (ki < L);
                if (j == 0) ok = ok && (cr >= r32);
                if (j == 4) ok = ok && (cr <= r32);
                st[j][r] = ok ? st[j][r] : -INFINITY;
            }
    } else {
#pragma unroll
        for (int r = 0; r < 16; ++r) { const int cr = crow(r, hi); st[0][r] = (cr >= r32) ? st[0][r] : -INFINITY; st[4][r] = (cr <= r32) ? st[4][r] : -INFINITY; }
    }
#pragma unroll
    for (int j = 0; j < 5; ++j)
#pragma unroll
        for (int r = 0; r < 16; ++r) mx = fmaxf(mx, st[j][r]);
    mx = fmaxf(mx, __shfl_xor(mx, 32));
    float sum = 0.f;
#pragma unroll
    for (int j = 0; j < 5; ++j)
#pragma unroll
        for (int r = 0; r < 16; ++r) { const float p = __builtin_amdgcn_exp2f(st[j][r] - mx); st[j][r] = p; sum += p; }
    sum += __shfl_xor(sum, 32);
    f32x16 o[2];
    o[0] = (f32x16){0.f, 0.f, 0.f, 0.f, 0.f, 0.f, 0.f, 0.f, 0.f, 0.f, 0.f, 0.f, 0.f, 0.f, 0.f, 0.f}; o[1] = o[0];
    const int G4 = F.lane >> 4, li = F.lane & 15, qq = li >> 2, pp = li & 3;
#pragma unroll
    for (int j = 0; j < 5; ++j)
#pragma unroll
        for (int s = 0; s < 2; ++s) {
            u32x4 pw; pw.x = cvt_pk_bf16(st[j][8 * s + 0], st[j][8 * s + 1]); pw.y = cvt_pk_bf16(st[j][8 * s + 2], st[j][8 * s + 3]);
            pw.z = cvt_pk_bf16(st[j][8 * s + 4], st[j][8 * s + 5]); pw.w = cvt_pk_bf16(st[j][8 * s + 6], st[j][8 * s + 7]);
            const bf16x8 pf = __builtin_bit_cast(bf16x8, pw);
#pragma unroll
            for (int dt = 0; dt < 2; ++dt) {
                const int rowA = 32 * w + 32 * j + 16 * s + 4 * hi + qq, rowB = rowA + 8;
                const int cb = (16 * (G4 & 1) + 4 * pp) * 2;
                const s16x4 lo = vtr(VL + rowA * 128 + ((dt ^ ((rowA >> 1) & 1)) << 6) + cb);
                const s16x4 hh = vtr(VL + rowB * 128 + ((dt ^ ((rowB >> 1) & 1)) << 6) + cb);
                const bf16x8 vf = (bf16x8){lo[0], lo[1], lo[2], lo[3], hh[0], hh[1], hh[2], hh[3]};
                o[dt] = __builtin_amdgcn_mfma_f32_32x32x16_bf16(vf, pf, o[dt], 0, 0, 0);
            }
        }
    attn_loadq(F, bhn, blkn, Q, qf);
    const float inv = 1.0f / sum;
    const size_t tok = (size_t)b * SEQ + ((size_t)qi << shift) + seg;
    LAS unsigned char* stg = F.lds + 98304 + w * 4096;
#pragma unroll
    for (int dt = 0; dt < 2; ++dt)
#pragma unroll
        for (int g = 0; g < 4; ++g) {
            u32x2 w2; w2.x = cvt_pk_bf16(o[dt][4 * g + 0] * inv, o[dt][4 * g + 1] * inv); w2.y = cvt_pk_bf16(o[dt][4 * g + 2] * inv, o[dt][4 * g + 3] * inv);
            *(LAS u32x2*)(stg + r32 * 128 + (((4 * dt + g) ^ (r32 & 7)) << 4) + 8 * hi) = w2;
        }
#pragma unroll
    for (int i = 0; i < 4; ++i) {
        const int row = i * 8 + (F.lane >> 3), c16 = F.lane & 7;
        const u32x4 v = *(const LAS u32x4*)(stg + row * 128 + ((c16 ^ (row & 7)) << 4));
        const unsigned tk = (unsigned)(b * SEQ + ((i0 + 32 * w + row) << shift) + seg);
        *(u32x4*)((char*)O + (size_t)(head * 128) + (tk * (unsigned)(D * 2) + (unsigned)(c16 * 16))) = v;
    }
    if (hi == 0) LSE[tok * 16 + head] = (mx + __builtin_amdgcn_logf(sum)) * 0.6931471805599453f;
}
__device__ __forceinline__ void attn_phase(Ctx& F) {
    const bf16_t* Q = (const bf16_t*)(F.ws + WS_Q); const bf16_t* Kk = (const bf16_t*)(F.ws + WS_K); const bf16_t* V = (const bf16_t*)(F.ws + WS_V);
    bf16_t* O = (bf16_t*)(F.ws + WS_O); float* LSE = (float*)(F.ws + WS_LSE);
    const int nunits = BATCH * NH * 64;
    u32x4 kpre[6], vpre[6]; bf16x8 qf[4];
    const int npairs = nunits / 2, full = npairs / F.G, r = npairs - full * F.G, x = 2 * r - F.G;
    const bool bal = (2 * r >= F.G) && (r <= F.G);
    auto seq = [&](int i, int& uu, bool& second) -> bool {
        if (i < 2 * full) { uu = 2 * (F.bx + (i >> 1) * F.G) + (i & 1); second = (i & 1) != 0; return true; }
        const int j = i - 2 * full;
        if (!bal) { if (j >= 2 || F.bx >= r) return false; uu = 2 * (full * F.G + F.bx) + j; second = j != 0; return true; }
        if (F.bx < x) { if (j >= 2) return false; uu = 2 * (full * F.G + F.bx) + j; second = j != 0; return true; }
        if (j >= 1) return false; uu = 2 * (full * F.G + x) + (F.bx - x); second = false; return true; };
    int u = 0, un = 0; bool sec = false, secn = false;
    bool ok = seq(0, u, sec);
    if (ok) { attn_load(F, u >> 6, u & 63, Q, Kk, V, kpre, vpre, false); attn_loadq(F, u >> 6, u & 63, Q, qf); }
    for (int i = 0; ok; ++i) {
        const bool has_next = seq(i + 1, un, secn); if (!has_next) un = u;
        __syncthreads();
        attn_stage(F, kpre, vpre, sec);
        __syncthreads();
        if (has_next) attn_load(F, un >> 6, un & 63, Q, Kk, V, kpre, vpre, secn);
        attn_compute(F, u >> 6, u & 63, qf, O, LSE, Q, un >> 6, un & 63);
        u = un; sec = secn; ok = has_next;
    }
    const int gt = F.bx * NTHR + F.tid, NGT = F.G * NTHR;
    for (int i = gt; i < T * 8; i += NGT) *(u32x4*)(O + (size_t)(i >> 3) * D + AW + (i & 7) * 8) = (u32x4){0u, 0u, 0u, 0u};
}
__device__ __forceinline__ void combine_phase(Ctx& F) {
    bf16_t* O = (bf16_t*)(F.ws + WS_O); const float* LSE = (const float*)(F.ws + WS_LSE);
    const int gt = F.bx * NTHR + F.tid, NGT = F.G * NTHR;
    for (int i = gt; i < T * 120; i += NGT) {
        const int tok = i / 120, rem = i - tok * 120, head = rem >> 3, ch = rem & 7, hg = head % 5;
        const float l0 = LSE[tok * 16 + hg], l1 = LSE[tok * 16 + hg + 5], l2 = LSE[tok * 16 + hg + 10], lm = LSE[tok * 16 + head];
        const float mx = fmaxf(l0, fmaxf(l1, l2));
        const float a = __expf(lm - mx) / (__expf(l0 - mx) + __expf(l1 - mx) + __expf(l2 - mx));
        u32x4* p = (u32x4*)(O + (size_t)tok * D + head * 64 + ch * 8);
        u32x4 v = *p;
        v.x = pk2(bflo(v.x) * a, bfhi(v.x) * a); v.y = pk2(bflo(v.y) * a, bfhi(v.y) * a); v.z = pk2(bflo(v.z) * a, bfhi(v.z) * a); v.w = pk2(bflo(v.w) * a, bfhi(v.w) * a);
        *p = v;
    }
}

template <bool XBF> __device__ __forceinline__ void route_phase(Ctx& F, int layer, const float* gamma_all, const void* XRv, const bf16_t* Yadd, int alias = 0) {
    const float* XR = (const float*)XRv; const bf16_t* XRb = (const bf16_t*)XRv;
    bf16_t* H = (bf16_t*)(F.ws + WS_H);
    const float* mod = (const float*)(F.ws + WS_MOD) + layer * 2 * 6144;
    const float* gamma = gamma_all + layer * D;
    unsigned* gcnt = (unsigned*)(F.ws + WS_CTL) + CW_CNT + layer * 32 + alias * 64;
    const size_t lbase = alias ? (WS_BIG + 244 * MiB) : WS_LIST;
    int* ltok = (int*)(F.ws + lbase); float* lwa = (float*)(F.ws + lbase + 3 * MiB); float* lwb = (float*)(F.ws + lbase + 6 * MiB);
    LAS float* PL = (LAS float*)F.lds;
    LAS float* PS = (LAS float*)(F.lds + 34816);
    LAS float* GS = (LAS float*)(F.lds + 36864); LAS float* SH = (LAS float*)(F.lds + 40960);
    LAS int* TB = (LAS int*)(F.lds + 45056); LAS float* TWA = (LAS float*)(F.lds + 45568); LAS float* TWB = (LAS float*)(F.lds + 46080);
    LAS int* TRK = (LAS int*)(F.lds + 46592); LAS int* CNT = (LAS int*)(F.lds + 47104); LAS int* BASE = (LAS int*)(F.lds + 47232);
    const int w = F.wave, r32 = F.lane & 31, hi = F.lane >> 5;
    for (int rb = F.bx; rb < T / 128; rb += F.G) {
        const int b = (rb * 128) >> 14;
        __syncthreads();
        for (int k = F.tid; k < D; k += NTHR) { GS[k] = gamma[k] * (1.0f + mod[b * 6144 + 4 * D + k]); SH[k] = mod[b * 6144 + 3 * D + k]; }
        if (F.tid < 32) CNT[F.tid] = 0;
        const bf16_t* WFp = (const bf16_t*)(F.ws + WS_WF) + ((size_t)((layer * 2 + b) * 2) * 64 + 8 * w) * 64 * 8 + F.lane * 8;
        const float* B2 = (const float*)(F.ws + WS_WF + 768 * 1024) + (layer * 2 + b) * 32;
        bf16x8 wfh[8], wfl[8];
#pragma unroll
        for (int ks = 0; ks < 8; ++ks) { wfh[ks] = *(const bf16x8*)(WFp + (size_t)ks * 64 * 8); wfl[ks] = *(const bf16x8*)(WFp + (size_t)(64 + ks) * 64 * 8); }
        for (int it = 0; it < 4; ++it) {
            const int row = rb * 128 + it * 32 + r32;
            const float* xp = XR + (size_t)row * D + 128 * w + 8 * hi;
            f32x4 xv[8][2]; float ss = 0.f;
            const bf16_t* yp = Yadd + (size_t)row * D + 128 * w + 8 * hi;
#pragma unroll
            for (int ks = 0; ks < 8; ++ks) { const u32x4 y = *(const u32x4*)(yp + 16 * ks);
                if constexpr (XBF) { const u32x4 xb = *(const u32x4*)(XRb + (size_t)row * D + 128 * w + 8 * hi + 16 * ks);
                    xv[ks][0] = (f32x4){bflo(xb.x), bfhi(xb.x), bflo(xb.y), bfhi(xb.y)} + (f32x4){bflo(y.x), bfhi(y.x), bflo(y.y), bfhi(y.y)}; xv[ks][1] = (f32x4){bflo(xb.z), bfhi(xb.z), bflo(xb.w), bfhi(xb.w)} + (f32x4){bflo(y.z), bfhi(y.z), bflo(y.w), bfhi(y.w)}; }
                else { xv[ks][0] = *(const f32x4*)(xp + 16 * ks) + (f32x4){bflo(y.x), bfhi(y.x), bflo(y.y), bfhi(y.y)}; xv[ks][1] = *(const f32x4*)(xp + 16 * ks + 4) + (f32x4){bflo(y.z), bfhi(y.z), bflo(y.w), bfhi(y.w)}; } }
            f32x16 acc = (f32x16){0.f, 0.f, 0.f, 0.f, 0.f, 0.f, 0.f, 0.f, 0.f, 0.f, 0.f, 0.f, 0.f, 0.f, 0.f, 0.f};
#pragma unroll
            for (int ks = 0; ks < 8; ++ks) {
                unsigned hw[4], lw[4];
#pragma unroll
                for (int q = 0; q < 2; ++q)
#pragma unroll
                    for (int e = 0; e < 2; ++e) { const float v0 = xv[ks][q][2 * e], v1 = xv[ks][q][2 * e + 1];
                        ss += v0 * v0 + v1 * v1;
                        const unsigned h0 = f2bf(v0), h1 = f2bf(v1);
                        hw[q * 2 + e] = h0 | (h1 << 16);
                        lw[q * 2 + e] = pk2(v0 - __builtin_bit_cast(float, h0 << 16), v1 - __builtin_bit_cast(float, h1 << 16)); }
                const bf16x8 ah = __builtin_bit_cast(bf16x8, (u32x4){hw[0], hw[1], hw[2], hw[3]}), al = __builtin_bit_cast(bf16x8, (u32x4){lw[0], lw[1], lw[2], lw[3]});
                acc = __builtin_amdgcn_mfma_f32_32x32x16_bf16(ah, wfh[ks], acc, 0, 0, 0);
                acc = __builtin_amdgcn_mfma_f32_32x32x16_bf16(al, wfh[ks], acc, 0, 0, 0);
                acc = __builtin_amdgcn_mfma_f32_32x32x16_bf16(ah, wfl[ks], acc, 0, 0, 0);
            }
            ss += __shfl_xor(ss, 32);
            if (hi == 0) PS[w * 32 + r32] = ss;
#pragma unroll
            for (int r = 0; r < 16; ++r) PL[(w * 32 + crow(r, hi)) * 33 + r32] = acc[r];
            __syncthreads();
            float st = 0.f;
#pragma unroll
            for (int ww = 0; ww < 8; ++ww) st += PS[ww * 32 + r32];
            const float r = 1.0f / sqrtf(st * (1.0f / D) + EPS);
            bf16_t* hp = H + (size_t)row * D + 128 * w + 8 * hi;
#pragma unroll
            for (int ks = 0; ks < 8; ++ks) {
                const int k = 128 * w + 16 * ks + 8 * hi;
                const f32x4 g0 = *(const LAS f32x4*)(GS + k), g1 = *(const LAS f32x4*)(GS + k + 4), s0 = *(const LAS f32x4*)(SH + k), s1 = *(const LAS f32x4*)(SH + k + 4);
                const f32x4 h0 = xv[ks][0] * r * g0 + s0, h1 = xv[ks][1] * r * g1 + s1;
                *(u32x4*)(hp + 16 * ks) = (u32x4){pk2(h0[0], h0[1]), pk2(h0[2], h0[3]), pk2(h1[0], h1[1]), pk2(h1[2], h1[3])};
            }
            if (F.tid < 32) {
                float a[20];
#pragma unroll
                for (int j = 0; j < 20; ++j) { float s = 0.f;
#pragma unroll
                    for (int ww = 0; ww < 8; ++ww) s += PL[(ww * 32 + F.tid) * 33 + j];
                    a[j] = r * s + B2[j]; }
                int g = 0; float gm = a[0];
#pragma unroll
                for (int j = 1; j < 4; ++j) if (a[j] > gm) { gm = a[j]; g = j; }
                float den = 0.f;
#pragma unroll
                for (int j = 0; j < 4; ++j) den += __expf(a[j] - gm);
                const float gval = 1.0f / den;
                float el[4];
#pragma unroll
                for (int e = 0; e < 4; ++e) el[e] = g == 0 ? a[4 + e] : (g == 1 ? a[8 + e] : (g == 2 ? a[12 + e] : a[16 + e]));
                int i1 = 0; float v1 = el[0];
#pragma unroll
                for (int e = 1; e < 4; ++e) if (el[e] > v1) { v1 = el[e]; i1 = e; }
                int i2 = -1; float v2 = -INFINITY;
#pragma unroll
                for (int e = 0; e < 4; ++e) if (e != i1 && el[e] > v2) { v2 = el[e]; i2 = e; }
                const float p1 = 1.0f / (1.0f + __expf(v2 - v1)), p2 = 1.0f - p1;
                const float w1 = gval * p1, w2 = gval * p2;
                const int pa = i1 < i2 ? i1 : i2, pb = i1 < i2 ? i2 : i1;
                const int pair = pa == 0 ? pb - 1 : (pa == 1 ? pb + 1 : 5);
                const int lrow = it * 32 + F.tid;
                TB[lrow] = g * 6 + pair; TWA[lrow] = (i1 == pa) ? w1 : w2; TWB[lrow] = (i1 == pa) ? w2 : w1;
            }
            __syncthreads();
        }
        if (F.tid < 128) TRK[F.tid] = atomicAdd((int*)(CNT + TB[F.tid]), 1);
        __syncthreads();
        if (F.tid < NBUCK) BASE[F.tid] = (int)__hip_atomic_fetch_add(gcnt + F.tid, (unsigned)CNT[F.tid], __ATOMIC_RELAXED, __HIP_MEMORY_SCOPE_AGENT);
        __syncthreads();
        if (F.tid < 128) { const int bk = TB[F.tid], pos = BASE[bk] + TRK[F.tid]; const size_t o = (size_t)bk * T + pos;
            ltok[o] = rb * 128 + F.tid; lwa[o] = TWA[F.tid]; lwb[o] = TWB[F.tid]; }
    }
}
__device__ __forceinline__ void gather_phase(Ctx& F, int layer) {
    moe_tab_build(F.lds, (const unsigned*)(F.ws + WS_CTL) + CW_CNT + layer * 32, F.tid);
    const MoeTab tab = moe_tab(F.lds);
    const bf16_t* H = (const bf16_t*)(F.ws + WS_H); bf16_t* HP = (bf16_t*)(F.ws + WS_HP); const int* ltok = (const int*)(F.ws + WS_LIST);
    const int gw = F.bx * NWAVES + F.wave, NGW = F.G * NWAVES, nrows = tab.ntiles * 256;
    for (int row = gw; row < nrows; row += NGW) {
        const int t = row >> 8, bk = tab.tileb(t), cnt = tab.cnt(bk); int idx = (t - tab.tpre(bk)) * 256 + (row & 255); idx = idx < cnt ? idx : cnt - 1;
        const int tok = ltok[(size_t)bk * T + idx];
        const u32x4* s = (const u32x4*)(H + (size_t)tok * D) + F.lane; u32x4* d = (u32x4*)(HP + (size_t)row * D) + F.lane;
        const u32x4 a = s[0], c = s[64]; d[0] = a; d[64] = c;
    }
}

__device__ __forceinline__ void gating_phase(Ctx& F, bf16_t* U, bf16_t* Uout, const bf16_t* V, const float* stats, const float* Ws, const float* gain, const float* bs) {
    LAS unsigned char* VT = F.lds; LAS unsigned char* WL = F.lds + 65536;
    LAS unsigned char* WSL = F.lds + 98304;
    LAS float* MUb = (LAS float*)(F.lds + TOKL_OFF);
    LAS float* RSb = (LAS float*)(F.lds + TOKL_OFF + 1024); LAS float* TP = (LAS float*)(F.lds + TOKL_OFF + 2048);
    const int nunits = 256 * NGRP, g = F.bx & 7;
    const int w = F.wave, r32 = F.lane & 31, hi = F.lane >> 5, G4 = F.lane >> 4, li = F.lane & 15, qq = li >> 2, pp = li & 3;
    const int p_ = F.tid >> 2, qp = F.tid & 3;
    { const f32x4* wp = (const f32x4*)(Ws + ((size_t)g * 128 + p_) * 128 + 32 * qp);
#pragma unroll
      for (int i = 0; i < 4; ++i) { const f32x4 w0 = wp[2 * i], w1 = wp[2 * i + 1];
          *(LAS u32x4*)(WSL + p_ * 256 + (((4 * qp + i) ^ (p_ & 15)) << 4)) = (u32x4){pk2(w0[0], w0[1]), pk2(w0[2], w0[3]), pk2(w1[0], w1[1]), pk2(w1[2], w1[3])}; } }
    const unsigned toff = (unsigned)(((F.tid >> 5) * GH + (F.tid & 31) * 8) * 2);
    constexpr size_t PSTEP = (size_t)16 * GH * 2;
    const unsigned soff = (unsigned)((p_ * 64 + 16 * qp) * 4);
    u32x4 vpre[8], ureg[8]; f32x4 spre[2];
    int u = F.bx;
    __syncthreads();
    if (u < nunits) { const int n = u >> 3;
        { const char* Vb = (const char*)V + ((size_t)n * 128 * GH + g * 256) * 2;
#pragma unroll
          for (int pass = 0; pass < 8; ++pass) vpre[pass] = __builtin_nontemporal_load((const u32x4*)(Vb + pass * PSTEP + toff)); }
        { const char* Ub = (const char*)U + ((size_t)n * 128 * GH + g * 256) * 2;
#pragma unroll
          for (int pass = 0; pass < 8; ++pass) ureg[pass] = __builtin_nontemporal_load((const u32x4*)(Ub + pass * PSTEP + toff)); }
        const f32x4* sp = (const f32x4*)((const char*)stats + (size_t)n * 128 * 256 + soff);
        spre[0] = sp[0] + sp[2]; spre[1] = sp[1] + sp[3];
        float s1 = (spre[0].x + spre[0].z) + (spre[1].x + spre[1].z), s2 = (spre[0].y + spre[0].w) + (spre[1].y + spre[1].w);
        s1 += __shfl_xor(s1, 1); s1 += __shfl_xor(s1, 2); s2 += __shfl_xor(s2, 1); s2 += __shfl_xor(s2, 2);
        const float mu = s1 * (1.0f / GH), var = fmaxf(s2 * (1.0f / GH) - mu * mu, 0.f);
        if (qp == 0) { MUb[p_] = mu; RSb[p_] = 1.0f / sqrtf(var + EPS); }
    }
    int par = 0;
    for (; u < nunits; u += F.G, par ^= 1) {
        const int n = u >> 3; const bool has_next = (u + F.G) < nunits; const int nn = (u + F.G) >> 3;
        LAS float* MU = MUb + par * 128; LAS float* RS = RSb + par * 128;
#pragma unroll
        for (int pass = 0; pass < 8; ++pass) { const int idx = pass * NTHR + F.tid, q = idx >> 5, c16 = idx & 31;
            *(LAS u32x4*)(VT + q * 512 + ((((c16 >> 2) ^ (q & 3))) << 6) + (c16 & 3) * 16) = vpre[pass]; }
        __syncthreads();
        { float t = 0.f;
#pragma unroll
          for (int i = 0; i < 4; ++i) {
              const int q0 = 32 * qp + 8 * i;
              const u32x4 wq = *(const LAS u32x4*)(WSL + p_ * 256 + (((4 * qp + i) ^ (p_ & 15)) << 4));
              float wv[8];
              wv[0] = bflo(wq.x) * RS[q0 + 0]; wv[1] = bfhi(wq.x) * RS[q0 + 1]; wv[2] = bflo(wq.y) * RS[q0 + 2]; wv[3] = bfhi(wq.y) * RS[q0 + 3];
              wv[4] = bflo(wq.z) * RS[q0 + 4]; wv[5] = bfhi(wq.z) * RS[q0 + 5]; wv[6] = bflo(wq.w) * RS[q0 + 6]; wv[7] = bfhi(wq.w) * RS[q0 + 7];
#pragma unroll
              for (int j = 0; j < 8; ++j) t += wv[j] * MU[q0 + j];
              const int c = 4 * qp + i;
              *(LAS u32x4*)(WL + p_ * 256 + ((c ^ (p_ & 15)) << 4)) = (u32x4){pk2(wv[0], wv[1]), pk2(wv[2], wv[3]), pk2(wv[4], wv[5]), pk2(wv[6], wv[7])};
          }
          t += __shfl_xor(t, 1); t += __shfl_xor(t, 2);
          if (qp == 0) TP[p_] = t; }
        if (has_next) {
            { const char* Vb = (const char*)V + ((size_t)nn * 128 * GH + g * 256) * 2;
#pragma unroll
              for (int pass = 0; pass < 8; ++pass) vpre[pass] = __builtin_nontemporal_load((const u32x4*)(Vb + pass * PSTEP + toff)); }
        }
        __syncthreads();
        f32x16 acc[4];
#pragma unroll
        for (int nt = 0; nt < 4; ++nt) acc[nt] = (f32x16){0.f, 0.f, 0.f, 0.f, 0.f, 0.f, 0.f, 0.f, 0.f, 0.f, 0.f, 0.f, 0.f, 0.f, 0.f, 0.f};
#pragma unroll
        for (int ks = 0; ks < 8; ++ks) {
            const int cbyte = (32 * w + 16 * (G4 & 1) + 4 * pp) * 2;
            const int rA = 16 * ks + 8 * hi + qq, rB = rA + 4;
            const s16x4 lo = vtr(VT + rA * 512 + ((((cbyte >> 6) ^ (rA & 3))) << 6) + (cbyte & 63));
            const s16x4 hh = vtr(VT + rB * 512 + ((((cbyte >> 6) ^ (rB & 3))) << 6) + (cbyte & 63));
            const bf16x8 af = (bf16x8){lo[0], lo[1], lo[2], lo[3], hh[0], hh[1], hh[2], hh[3]};
#pragma unroll
            for (int nt = 0; nt < 4; ++nt) {
                const int p = 32 * nt + r32;
                const bf16x8 bfr = *(const LAS bf16x8*)(WL + p * 256 + (((2 * ks + hi) ^ (p & 15)) << 4));
                acc[nt] = __builtin_amdgcn_mfma_f32_32x32x16_bf16(af, bfr, acc[nt], 0, 0, 0);
            }
        }
        if (has_next) { unsigned so = soff; asm volatile("" : "+v"(so));
            const f32x4* sp = (const f32x4*)((const char*)stats + (size_t)nn * 128 * 256 + so); spre[0] = sp[0] + sp[2]; spre[1] = sp[1] + sp[3]; }
        __syncthreads();
#pragma unroll
        for (int nt = 0; nt < 4; ++nt) {
            const int p = 32 * nt + r32; const float tp = TP[p], bp = bs[g * 128 + p];
#pragma unroll
            for (int gq = 0; gq < 4; ++gq) {
                const int c = 32 * w + 8 * gq + 4 * hi; const f32x4 gnv = *(const f32x4*)(gain + g * 256 + c);
                float o[4];
#pragma unroll
                for (int j = 0; j < 4; ++j) o[j] = gnv[j] * (acc[nt][4 * gq + j] - tp) + bp;
                const int cb = c * 2;
                *(LAS u32x2*)(VT + p * 512 + ((((cb >> 4) ^ (p & 15))) << 4) + (cb & 15)) = (u32x2){pk2(o[0], o[1]), pk2(o[2], o[3])};
            }
        }
        if (has_next) {
            float s1 = (spre[0].x + spre[0].z) + (spre[1].x + spre[1].z), s2 = (spre[0].y + spre[0].w) + (spre[1].y + spre[1].w);
            s1 += __shfl_xor(s1, 1); s1 += __shfl_xor(s1, 2); s2 += __shfl_xor(s2, 1); s2 += __shfl_xor(s2, 2);
            const float mu = s1 * (1.0f / GH), var = fmaxf(s2 * (1.0f / GH) - mu * mu, 0.f);
            if (qp == 0) { MUb[(par ^ 1) * 128 + p_] = mu; RSb[(par ^ 1) * 128 + p_] = 1.0f / sqrtf(var + EPS); }
        }
        __syncthreads();
#pragma unroll
        for (int pass = 0; pass < 8; ++pass) {
            const int idx = pass * NTHR + F.tid, p = idx >> 5, c16 = idx & 31;
            const u32x4 vs = *(const LAS u32x4*)(VT + p * 512 + ((c16 ^ (p & 15)) << 4));
            const u32x4 uv = ureg[pass]; u32x4 o;
            o.x = pk2(bflo(uv.x) * bflo(vs.x), bfhi(uv.x) * bfhi(vs.x)); o.y = pk2(bflo(uv.y) * bflo(vs.y), bfhi(uv.y) * bfhi(vs.y));
            o.z = pk2(bflo(uv.z) * bflo(vs.z), bfhi(uv.z) * bfhi(vs.z)); o.w = pk2(bflo(uv.w) * bflo(vs.w), bfhi(uv.w) * bfhi(vs.w));
            *(u32x4*)((char*)Uout + ((size_t)n * 128 * GH + g * 256) * 2 + pass * PSTEP + toff) = o;
        }
        if (has_next) { const char* Ub = (const char*)U + ((size_t)nn * 128 * GH + g * 256) * 2;
#pragma unroll
            for (int pass = 0; pass < 8; ++pass) ureg[pass] = __builtin_nontemporal_load((const u32x4*)(Ub + pass * PSTEP + toff)); }
        __syncthreads();
    }
}

__global__ void __launch_bounds__(NTHR, 2) mk_fwd(Args args) {
    extern __shared__ __attribute__((aligned(16))) unsigned char lds_[];
    Ctx F;
    F.lds = (LAS unsigned char*)lds_;
    F.wave = __builtin_amdgcn_readfirstlane((int)threadIdx.x >> 6); F.G = gridDim.x; F.bx = blockIdx.x;
#define REFRESH() do { F.lane = lane_now(); F.tid = F.wave * 64 + F.lane; } while (0)
    REFRESH();
    F.out = args.out; F.ws = args.ws;
    unsigned char* ws = args.ws;
    volatile LAS unsigned* MISC = (volatile LAS unsigned*)(F.lds + MISC_OFF);
    for (int u = F.tid; u < (LDS_BYTES - LDSCTL_OFF) / 4; u += NTHR) ((LAS unsigned*)(F.lds + LDSCTL_OFF))[u] = 0u;
    __syncthreads();
    const int lo = args.ph_lo, hi = args.ph_hi;
#if MK_PER_PHASE
#define GRID_BAR(k) do {} while (0)
#else
    cg::grid_group grid = cg::this_grid();
    XcdBarrier bar = xcd_barrier_post((unsigned*)(ws + WS_CTL) + CW_BAR, MISC + 8, F.wave);
    if (lo < 0) grid.sync();
#define GRID_BAR(k) do { xcd_barrier2(bar); REFRESH(); } while (0)
#endif
#define IN(k) (lo <= (k) && (k) < hi)
#ifndef PROBE_REP
#define PROBE_REP -1
#endif
#define NREP(k) (PROBE_REP == (k) ? 2 : 1)
#ifndef PROBE_A
#define PROBE_A -1
#endif
#ifndef PROBE_B
#define PROBE_B -1
#endif
#if PROBE_A >= 0
    unsigned long long* tsb = (unsigned long long*)(ws + WS_CTL + 512 * 1024);
    if (F.bx == 0 && F.tid == 0) tsb[0] = __builtin_amdgcn_s_memrealtime();
#define STAMP(k) do { if (F.bx == 0 && F.tid == 0) tsb[(k) + 1] = __builtin_amdgcn_s_memrealtime(); } while (0)
#else
#define STAMP(k) do {} while (0)
#endif
#define SEAM(k) do { if (IN(k) && IN((k) + 1)) { GRID_BAR(k); STAMP(k); } } while (0)
#define SEAM2(k) do { if (IN(k) && IN((k) + 2)) { GRID_BAR(k); STAMP(k); } } while (0)
    const float* mod = (const float*)(ws + WS_MOD);
    bf16_t* H = (bf16_t*)(ws + WS_H);
    float* XR = args.out;

    if (IN(0)) { for (int rep = 0; rep < NREP(0); ++rep) { p0_prep(F, args); __syncthreads(); } } SEAM(0);
#if !MK_PER_PHASE
    if (PROBE_REP == 100) { for (int i = 0; i < 10; ++i) xcd_barrier2(bar); }
#endif
    if (IN(1)) { for (int rep = 0; rep < NREP(1); ++rep) norm_rows<false, false, true>(F, args.in[I_X], args.in[I_NMIX], mod + 0 * D, mod + 1 * D, H, nullptr, nullptr, (bf16_t*)(ws + WS_XRB)); route_prep(F, args.in[I_NFFN]); } SEAM(1);
    if (IN(2)) {
        pg8::DenseOrder S; S.init(H, ws + WS_WQKV, T, NQKVP, D, F.G, F.bx);
        EpiQKV E{(bf16_t*)(ws + WS_Q), (bf16_t*)(ws + WS_K), (bf16_t*)(ws + WS_V), (const float*)(ws + WS_ROPE)};
        for (int rep = 0; rep < NREP(2); ++rep) pg8::gemm_phase<EpiQKV, pg8::DenseOrder>(F.lds, D, S, E, F.wave);
    } SEAM(2);
    if (IN(3)) { for (int rep = 0; rep < NREP(3); ++rep) attn_phase(F); } SEAM(3);
    if (IN(4)) { combine_phase(F); } SEAM(4);
    if (IN(5)) {
        pg8::DenseOrder S; S.init(ws + WS_O, ws + WS_WO, T, D, D, F.G, F.bx);
        EpiY E{(bf16_t*)(ws + WS_Y1), mod + 2 * D};
        for (int rep = 0; rep < NREP(5); ++rep) pg8::gemm_phase<EpiY, pg8::DenseOrder>(F.lds, D, S, E, F.wave);
    } SEAM(5);
#define MOE_LAYER(layer, pb) do { \
        const float* modl = mod + (layer) * 2 * 6144; \
        if (IN(pb)) { route_phase<true>(F, layer, args.in[I_NFFN], (const void*)(ws + WS_XRB), (const bf16_t*)(ws + ((layer) == 0 ? WS_Y1 : WS_Y3))); } SEAM2(pb); \
        if (IN((pb) + 2)) { \
            moe_tab_build(F.lds, (const unsigned*)(ws + WS_CTL) + CW_CNT + (layer) * 32, F.tid); \
            const MoeTab tab = moe_tab(F.lds); \
            MoeOrder S{(const char*)(ws + WS_H), (size_t)0, (const char*)(ws + WS_BGU), 0, layer, tab, tab.ntiles * 4, F.G, F.bx}; \
            S.fill_tokl((const int*)(ws + WS_LIST), F.tid); \
            EpiAct E{(bf16_t*)(ws + WS_ACT), (const float*)(ws + WS_LIST + 3 * MiB), (const float*)(ws + WS_LIST + 6 * MiB), tab}; \
            for (int rep = 0; rep < NREP((pb) + 2); ++rep) pg8::gemm_phase<EpiAct, MoeOrder>(F.lds, D, S, E, F.wave); \
            if ((layer) == 0) { const int lo_ = S.tail_lo();     \
                __syncthreads(); if (F.bx >= lo_) expert_items(F, args, 1, (F.bx - lo_) * NWAVES + F.wave, (F.G - lo_) * NWAVES); } \
        } SEAM((pb) + 2); \
        if (IN((pb) + 3)) { \
            moe_tab_build(F.lds, (const unsigned*)(ws + WS_CTL) + CW_CNT + (layer) * 32, F.tid); \
            const MoeTab tab = moe_tab(F.lds); \
            MoeOrder S{(const char*)(ws + WS_ACT), (size_t)256 * 512 * 2, (const char*)(ws + WS_BDP), 1, layer, tab, tab.ntiles * 4, F.G, F.bx}; \
            EpiDown E{(bf16_t*)(ws + ((layer) == 0 ? WS_Y : WS_Y4)), modl + 5 * D, (const int*)(ws + WS_LIST), tab}; \
            for (int rep = 0; rep < NREP((pb) + 3); ++rep) pg8::gemm_phase<EpiDown, MoeOrder>(F.lds, 512, S, E, F.wave); \
            if ((layer) == 0) { const int lo_ = S.tail_lo();     \
                __syncthreads(); if (F.bx >= lo_) gmlp_items(F, args, (F.bx - lo_) * NWAVES + F.wave, (F.G - lo_) * NWAVES); } \
        } SEAM((pb) + 3); \
    } while (0)
    MOE_LAYER(0, 6);
    if (IN(10)) { norm_rows<true, true>(F, (const float*)(ws + WS_XRB), args.in[I_NMIX] + D, mod + 2 * 6144 + 0 * D, mod + 2 * 6144 + 1 * D, H, (const bf16_t*)(ws + WS_Y1), (const bf16_t*)(ws + WS_Y), (bf16_t*)(ws + WS_XRB)); } SEAM(10);
    if (IN(11)) {
        pg8::DenseOrder S; S.init(H, ws + WS_WIN, T, FF, D, F.G, F.bx);
        EpiGelu<0> E{(bf16_t*)(ws + WS_U), (bf16_t*)(ws + WS_VV), (float*)(ws + WS_STATS)};
        if (PROBE_REP == 111) { EpiGelu<1> E1{(bf16_t*)(ws + WS_U), (bf16_t*)(ws + WS_VV), (float*)(ws + WS_STATS)}; pg8::gemm_phase<EpiGelu<1>, pg8::DenseOrder>(F.lds, D, S, E1, F.wave); }
        if (PROBE_REP == 112) { EpiGelu<2> E2{(bf16_t*)(ws + WS_U), (bf16_t*)(ws + WS_VV), (float*)(ws + WS_STATS)}; pg8::gemm_phase<EpiGelu<2>, pg8::DenseOrder>(F.lds, D, S, E2, F.wave); }
        for (int rep = 0; rep < NREP(11); ++rep) pg8::gemm_phase<EpiGelu<0>, pg8::DenseOrder>(F.lds, D, S, E, F.wave);
    } SEAM(11);
    if (IN(12)) {
        for (int rep = 0; rep < NREP(12); ++rep) gating_phase(F, (bf16_t*)(ws + WS_U), (bf16_t*)(ws + (rep == 0 ? WS_U : WS_VV)), (const bf16_t*)(ws + WS_VV), (const float*)(ws + WS_STATS), args.in[I_WS], args.in[I_VGAIN], args.in[I_BS]);
    } SEAM(12);
    if (IN(13)) {
        pg8::DenseOrder S; S.init(ws + WS_U, ws + WS_WO2, T, D, GH, F.G, F.bx);
        EpiY E{(bf16_t*)(ws + WS_Y3), mod + 2 * 6144 + 2 * D};
        for (int rep = 0; rep < NREP(13); ++rep) pg8::gemm_phase<EpiY, pg8::DenseOrder>(F.lds, GH, S, E, F.wave);
    } SEAM(13);
    MOE_LAYER(1, 14);
    if (IN(18)) { final_norm(F, (const bf16_t*)(ws + WS_XRB), XR, args.in[I_FNORM], 1.0f, (const bf16_t*)(ws + WS_Y3), (const bf16_t*)(ws + WS_Y4)); }
}

extern "C" void kernel_launch(void* const* d_in, const int* in_sizes, int n_in, void* d_out, int out_size, void* d_ws, size_t ws_size, hipStream_t stream) {
    static int grid = 0;
    if (grid == 0) {
        if (n_in != 21 || in_sizes[0] != T * D || out_size != T * D || ws_size < WS_END) { fprintf(stderr, "kernel_launch: unexpected problem (n_in %d, in0 %d, out %d, ws %zu)\n", n_in, n_in > 0 ? in_sizes[0] : -1, out_size, ws_size); grid = -1; return; }
        int dev = 0, cus = 0, per_cu = 0;
        (void)hipGetDevice(&dev);
        (void)hipDeviceGetAttribute(&cus, hipDeviceAttributeMultiprocessorCount, dev);
        (void)hipFuncSetAttribute((const void*)mk_fwd, hipFuncAttributeMaxDynamicSharedMemorySize, LDS_BYTES);
        (void)hipOccupancyMaxActiveBlocksPerMultiprocessor(&per_cu, (const void*)mk_fwd, NTHR, LDS_BYTES);
        if (per_cu < 1) { fprintf(stderr, "kernel_launch: occupancy query says %d blocks per CU\n", per_cu); grid = -1; return; }
        grid = cus;
        if (grid % 8 != 0) { fprintf(stderr, "kernel_launch: this kernel needs a CU count that is a multiple of 8 (got %d)\n", grid); grid = -1; return; }
    }
    if (grid < 0) return;
    (void)hipMemsetAsync((char*)d_ws + WS_CTL, 0, CTL_ZERO_BYTES, stream);
    Args a{};
    for (int i = 0; i < 21; ++i) a.in[i] = (const float*)d_in[i];
    a.out = (float*)d_out; a.ws = (unsigned char*)d_ws;
#if MK_PER_PHASE
    for (int p = 0; p < NPHASE; ++p) { a.ph_lo = p; a.ph_hi = p + 1; hipLaunchKernelGGL(mk_fwd, dim3(grid), dim3(NTHR), LDS_BYTES, stream, a); }
#else
    a.ph_lo = 0; a.ph_hi = NPHASE;
    void* kargs[] = {&a};
    hipError_t e = hipLaunchCooperativeKernel((const void*)mk_fwd, dim3(grid), dim3(NTHR), kargs, LDS_BYTES, stream);
    if (e != hipSuccess) fprintf(stderr, "cooperative launch failed: %s (grid %d)\n", hipGetErrorString(e), grid);
#endif
}
```
